# Optimizing an MI355X kernel written in HIP

```python
import math
import numpy as np
import jax
import jax.numpy as jnp
from jax import lax

D_MODEL = 1024
BATCH = 8
SEQ = 4096
DEPTH = 1

HEAD_DIM = 64
ROPE_THETA = 10000.0
NORM_EPS = 1e-6
NEG_INF = -1e30

DIFF_HEADS = 4
DIFF_V_DIM = 2 * HEAD_DIM
DIFF_WIDTH = DIFF_HEADS * DIFF_V_DIM
Q_BLOCK = 128

NSA_HEADS = 8
NSA_KV_GROUPS = 2
NSA_HEADS_PER_GROUP = NSA_HEADS // NSA_KV_GROUPS
NSA_WIDTH = NSA_HEADS * HEAD_DIM
KV_COLS = NSA_KV_GROUPS * HEAD_DIM
CMP_BLOCK = 32
CMP_STRIDE = 16
CMP_HIDDEN = 4 * HEAD_DIM
SLC_BLOCK = 64
SLC_TOPK = 16
WINDOW = 512
NSA_Q_BLOCK = 64
N_BRANCHES = 3

MIX_WIDTH = DIFF_WIDTH + NSA_WIDTH
IN_COLS = 2 * DIFF_HEADS * 2 * HEAD_DIM + DIFF_WIDTH + NSA_WIDTH + 6 * KV_COLS + NSA_HEADS * N_BRANCHES
D_FF = ((8 * D_MODEL + 3 * 256 - 1) // (3 * 256)) * 256

kernel_name = 'hybrid_diffattn_nsa_block'


def rms_norm(x, g):
    xf = x.astype(jnp.float32)
    y = xf * lax.rsqrt(jnp.mean(xf * xf, axis=-1, keepdims=True) + NORM_EPS)
    return (y * g.astype(jnp.float32)).astype(x.dtype)


def rope_tables(S):
    inv = 1.0 / (ROPE_THETA ** (jnp.arange(0, HEAD_DIM, 2, dtype=jnp.float32) / HEAD_DIM))
    ang = jnp.arange(S, dtype=jnp.float32)[:, None] * inv[None, :]
    return jnp.cos(ang), jnp.sin(ang)


def apply_rope(x, cos, sin):
    x1, x2 = jnp.split(x, 2, axis=-1)
    c = cos.astype(x.dtype)
    s = sin.astype(x.dtype)
    return jnp.concatenate([x1 * c - x2 * s, x1 * s + x2 * c], axis=-1)


def masked_softmax(s, mask):
    p = jax.nn.softmax(jnp.where(mask, s, NEG_INF), axis=-1)
    return jnp.where(mask, p, 0.0)


def diff_attention(q, k, v, lam):
    B, H, _, S, d = q.shape
    scale = d ** -0.5
    kpos = jnp.arange(S)

    def block(i):
        s0 = i * Q_BLOCK
        qb = lax.dynamic_slice_in_dim(q, s0, Q_BLOCK, axis=3)
        s = jnp.einsum('bhmqd,bhmkd->bhmqk', qb, k).astype(jnp.float32) * scale
        qpos = s0 + jnp.arange(Q_BLOCK)
        mask = kpos[None, :] <= qpos[:, None]
        p = jax.nn.softmax(jnp.where(mask, s, NEG_INF), axis=-1)
        a = p[:, :, 0] - lam * p[:, :, 1]
        return jnp.einsum('bhqk,bhke->bhqe', a.astype(v.dtype), v)

    o = lax.map(block, jnp.arange(S // Q_BLOCK))
    return o.transpose(1, 0, 3, 2, 4).reshape(B, S, H, v.shape[-1])


def compress_tokens(t, tok_idx, pos, w1, w2):
    blocks = t[:, :, tok_idx] + pos.astype(t.dtype)
    flat = blocks.reshape(blocks.shape[0], blocks.shape[1], blocks.shape[2], -1)
    return jax.nn.silu(flat @ w1) @ w2


def selection_overlap(n_cmp, n_sel):
    c0 = np.arange(n_cmp)[:, None] * CMP_STRIDE
    s0 = np.arange(n_sel)[None, :] * SLC_BLOCK
    ov = np.clip(np.minimum(c0 + CMP_BLOCK, s0 + SLC_BLOCK) - np.maximum(c0, s0), 0, None)
    return (ov / CMP_BLOCK).astype(np.float32)


def nsa_attention(q, kc_tok, vc_tok, ks, vs, kw, vw, gates,
                  k_pos, k_w1, k_w2, v_pos, v_w1, v_w2):
    B, G, Hg, S, d = q.shape
    dt = q.dtype
    scale = d ** -0.5
    QB = NSA_Q_BLOCK
    n_cmp = (S - CMP_BLOCK) // CMP_STRIDE + 1
    n_sel = S // SLC_BLOCK
    top_n = min(SLC_TOPK, n_sel)

    tok_idx = np.arange(n_cmp)[:, None] * CMP_STRIDE + np.arange(CMP_BLOCK)[None, :]
    kc = compress_tokens(kc_tok, tok_idx, k_pos, k_w1, k_w2)
    vc = compress_tokens(vc_tok, tok_idx, v_pos, v_w1, v_w2)
    cmp_end = jnp.asarray(tok_idx[:, -1])
    overlap = jnp.asarray(selection_overlap(n_cmp, n_sel))

    ks_blk = ks.reshape(B, G, n_sel, SLC_BLOCK, d)
    vs_blk = vs.reshape(B, G, n_sel, SLC_BLOCK, d)
    kw_pad = jnp.pad(kw, ((0, 0), (0, 0), (WINDOW, 0), (0, 0)))
    vw_pad = jnp.pad(vw, ((0, 0), (0, 0), (WINDOW, 0), (0, 0)))
    gather_blocks = jax.vmap(jax.vmap(lambda t, i: t[i]))
    blk = jnp.arange(n_sel)

    def block(i):
        s0 = i * QB
        qb = lax.dynamic_slice_in_dim(q, s0, QB, axis=3)
        gb = lax.dynamic_slice_in_dim(gates, s0, QB, axis=3)
        qpos = s0 + jnp.arange(QB)

        sc = jnp.einsum('bghqd,bgnd->bghqn', qb, kc).astype(jnp.float32) * scale
        pc = masked_softmax(sc, cmp_end[None, :] <= qpos[:, None])
        o_cmp = jnp.einsum('bghqn,bgnd->bghqd', pc.astype(dt), vc)

        imp = jnp.einsum('bghqn,nj->bgqj', pc, overlap)
        cur = qpos // SLC_BLOCK
        valid = blk[None, :] * SLC_BLOCK <= qpos[:, None]
        forced = (blk[None, :] == 0) | (blk[None, :] == cur[:, None]) | (blk[None, :] == cur[:, None] - 1)
        imp = jnp.where(forced, jnp.inf, jnp.where(valid, imp, -jnp.inf))
        _, sel = lax.top_k(imp, top_n)
        kg = gather_blocks(ks_blk, sel)
        vg = gather_blocks(vs_blk, sel)
        tpos = sel[..., None] * SLC_BLOCK + jnp.arange(SLC_BLOCK)
        smask = (tpos <= qpos[:, None, None]).reshape(B, G, 1, QB, top_n * SLC_BLOCK)
        ss = jnp.einsum('bghqd,bgqnld->bghqnl', qb, kg).astype(jnp.float32) * scale
        ps = masked_softmax(ss.reshape(B, G, Hg, QB, top_n * SLC_BLOCK), smask)
        o_slc = jnp.einsum('bghqm,bgqmd->bghqd', ps.astype(dt),
                           vg.reshape(B, G, QB, top_n * SLC_BLOCK, d))

        kwb = lax.dynamic_slice_in_dim(kw_pad, s0, WINDOW + QB, axis=2)
        vwb = lax.dynamic_slice_in_dim(vw_pad, s0, WINDOW + QB, axis=2)
        wpos = s0 - WINDOW + jnp.arange(WINDOW + QB)
        wmask = (wpos[None, :] <= qpos[:, None]) & (wpos[None, :] > qpos[:, None] - WINDOW) & (wpos[None, :] >= 0)
        sw = jnp.einsum('bghqd,bgkd->bghqk', qb, kwb).astype(jnp.float32) * scale
        pw = masked_softmax(sw, wmask)
        o_win = jnp.einsum('bghqk,bgkd->bghqd', pw.astype(dt), vwb)

        return gb[..., 0:1] * o_cmp + gb[..., 1:2] * o_slc + gb[..., 2:3] * o_win

    o = lax.map(block, jnp.arange(S // QB))
    return o.transpose(1, 0, 4, 2, 3, 5).reshape(B, S, G * Hg * d)


def hybrid_mixer(h, layer, w_in, lambda_q1, lambda_k1, lambda_q2, lambda_k2, diff_subln,
                 k_cmp_pos, k_cmp_w1, k_cmp_w2, v_cmp_pos, v_cmp_w1, v_cmp_w2, w_out):
    B, S, _ = h.shape
    cos, sin = rope_tables(S)
    proj = h @ w_in
    sizes = [DIFF_HEADS * 2 * HEAD_DIM, DIFF_HEADS * 2 * HEAD_DIM, DIFF_WIDTH, NSA_WIDTH,
             KV_COLS, KV_COLS, KV_COLS, KV_COLS, KV_COLS, KV_COLS, NSA_HEADS * N_BRANCHES]
    dq, dk, dv, nq, kc, vc, ks, vs, kw, vw, gt = jnp.split(
        proj, np.cumsum(sizes)[:-1].tolist(), axis=-1)

    dq = apply_rope(dq.reshape(B, S, DIFF_HEADS, 2, HEAD_DIM).transpose(0, 2, 3, 1, 4), cos, sin)
    dk = apply_rope(dk.reshape(B, S, DIFF_HEADS, 2, HEAD_DIM).transpose(0, 2, 3, 1, 4), cos, sin)
    dv = dv.reshape(B, S, DIFF_HEADS, DIFF_V_DIM).transpose(0, 2, 1, 3)
    lam_init = 0.8 - 0.6 * math.exp(-0.3 * layer)
    f32 = jnp.float32
    lam = (jnp.exp(jnp.sum(lambda_q1.astype(f32) * lambda_k1.astype(f32)))
           - jnp.exp(jnp.sum(lambda_q2.astype(f32) * lambda_k2.astype(f32))) + lam_init)
    o_diff = diff_attention(dq, dk, dv, lam)
    o_diff = (rms_norm(o_diff, diff_subln) * (1.0 - lam_init)).reshape(B, S, DIFF_WIDTH)

    def q_heads(t):
        return t.reshape(B, S, NSA_KV_GROUPS, NSA_HEADS_PER_GROUP, HEAD_DIM).transpose(0, 2, 3, 1, 4)

    def kv_heads(t):
        return t.reshape(B, S, NSA_KV_GROUPS, HEAD_DIM).transpose(0, 2, 1, 3)

    nq = apply_rope(q_heads(nq), cos, sin)
    kc = apply_rope(kv_heads(kc), cos, sin)
    ks = apply_rope(kv_heads(ks), cos, sin)
    kw = apply_rope(kv_heads(kw), cos, sin)
    gates = jax.nn.sigmoid(gt.reshape(B, S, NSA_KV_GROUPS, NSA_HEADS_PER_GROUP, N_BRANCHES)
                           .transpose(0, 2, 3, 1, 4))
    o_nsa = nsa_attention(nq, kc, kv_heads(vc), ks, kv_heads(vs), kw, kv_heads(vw), gates,
                          k_cmp_pos, k_cmp_w1, k_cmp_w2, v_cmp_pos, v_cmp_w1, v_cmp_w2)

    return jnp.concatenate([o_diff, o_nsa], axis=-1) @ w_out


def setup_inputs(seed: int = 0) -> dict:
    key = jax.random.key(seed)
    k = jax.random.split(key, 24)
    L = DEPTH

    def nrm(kk, shape, scale):
        return jax.random.normal(kk, shape, jnp.float32) * scale

    def gain(kk, n):
        return 1.0 + 0.05 * jax.random.normal(kk, (L, n), jnp.float32)

    cmp_in = CMP_BLOCK * HEAD_DIM
    return {
        'x': nrm(k[0], (BATCH, SEQ, D_MODEL), 1.0),
        'attn_pre_norm': gain(k[1], D_MODEL),
        'w_in': nrm(k[2], (L, D_MODEL, IN_COLS), D_MODEL ** -0.5),
        'lambda_q1': nrm(k[3], (L, HEAD_DIM), 0.1),
        'lambda_k1': nrm(k[4], (L, HEAD_DIM), 0.1),
        'lambda_q2': nrm(k[5], (L, HEAD_DIM), 0.1),
        'lambda_k2': nrm(k[6], (L, HEAD_DIM), 0.1),
        'diff_subln': gain(k[7], DIFF_V_DIM),
        'k_cmp_pos': nrm(k[8], (L, CMP_BLOCK, HEAD_DIM), 0.1),
        'k_cmp_w1': nrm(k[9], (L, cmp_in, CMP_HIDDEN), cmp_in ** -0.5),
        'k_cmp_w2': nrm(k[10], (L, CMP_HIDDEN, HEAD_DIM), CMP_HIDDEN ** -0.5),
        'v_cmp_pos': nrm(k[11], (L, CMP_BLOCK, HEAD_DIM), 0.1),
        'v_cmp_w1': nrm(k[12], (L, cmp_in, CMP_HIDDEN), cmp_in ** -0.5),
        'v_cmp_w2': nrm(k[13], (L, CMP_HIDDEN, HEAD_DIM), CMP_HIDDEN ** -0.5),
        'w_out': nrm(k[14], (L, MIX_WIDTH, D_MODEL), MIX_WIDTH ** -0.5),
        'attn_post_norm': gain(k[15], D_MODEL),
        'ffn_pre_norm': gain(k[16], D_MODEL),
        'w_gate': nrm(k[17], (L, D_MODEL, D_FF), D_MODEL ** -0.5),
        'w_up': nrm(k[18], (L, D_MODEL, D_FF), D_MODEL ** -0.5),
        'w_down': nrm(k[19], (L, D_FF, D_MODEL), D_FF ** -0.5),
        'ffn_post_norm': gain(k[20], D_MODEL),
    }


def reference(x, attn_pre_norm, w_in, lambda_q1, lambda_k1, lambda_q2, lambda_k2, diff_subln,
              k_cmp_pos, k_cmp_w1, k_cmp_w2, v_cmp_pos, v_cmp_w1, v_cmp_w2, w_out,
              attn_post_norm, ffn_pre_norm, w_gate, w_up, w_down, ffn_post_norm):
    for l in range(DEPTH):
        h = rms_norm(x, attn_pre_norm[l])
        mix = hybrid_mixer(h, l, w_in[l], lambda_q1[l], lambda_k1[l], lambda_q2[l], lambda_k2[l],
                           diff_subln[l], k_cmp_pos[l], k_cmp_w1[l], k_cmp_w2[l],
                           v_cmp_pos[l], v_cmp_w1[l], v_cmp_w2[l], w_out[l])
        x = x + rms_norm(mix, attn_post_norm[l])
        h = rms_norm(x, ffn_pre_norm[l])
        f = (jax.nn.silu(h @ w_gate[l]) * (h @ w_up[l])) @ w_down[l]
        x = x + rms_norm(f, ffn_post_norm[l])
    return x
```

```cpp
#include <hip/hip_runtime.h>
#include <hip/hip_cooperative_groups.h>
#include <cstdio>
#include <cstdint>
namespace cg = cooperative_groups;

#ifndef MULTI_LAUNCH
#define MULTI_LAUNCH 0
#endif
#ifndef PROBE_MODE
#define PROBE_MODE 0
#endif

typedef unsigned short bf16_t;
typedef short bf16x8 __attribute__((ext_vector_type(8)));
typedef short s16x4 __attribute__((ext_vector_type(4)));
typedef float f32x16 __attribute__((ext_vector_type(16)));
typedef float f32x4 __attribute__((ext_vector_type(4)));
typedef float f32x2 __attribute__((ext_vector_type(2)));
typedef unsigned u32x4 __attribute__((ext_vector_type(4)));
typedef unsigned u32x2 __attribute__((ext_vector_type(2)));
typedef __bf16 bf16v2 __attribute__((ext_vector_type(2)));
typedef unsigned long long u64;

#define DI __device__ __forceinline__
#define MFMA(a, b, c) __builtin_amdgcn_mfma_f32_32x32x16_bf16((a), (b), (c), 0, 0, 0)

constexpr int T = 32768, S = 4096, DM = 1024;
constexpr int INC = 2840, INP = 3072, DFF = 2816;
constexpr int NPH = 10;
constexpr int HALF_LDS = 73728;
constexpr int LDS_BYTES = 2 * HALF_LDS + 256;
#define VTID ((int)(threadIdx.x & 255))
#define VHALF ((int)(threadIdx.x >> 8))
#define VBLK ((int)(blockIdx.x * 2 + (threadIdx.x >> 8)))
#define VGRID ((int)(gridDim.x * 2))
constexpr float NORM_EPS = 1e-6f;

constexpr size_t al256(size_t x) { return (x + 255) & ~(size_t)255; }
constexpr size_t OFF_CTL = 0;
constexpr size_t OFF_XB = 4096;
constexpr size_t OFF_WINT = 4096 + 16384;
constexpr size_t OFF_WOUTT = OFF_WINT + (size_t)INP * 1024 * 2;
constexpr size_t OFF_WGUT = OFF_WOUTT + (size_t)1024 * 1024 * 2;
constexpr size_t OFF_WDT = OFF_WGUT + (size_t)2 * DFF * 1024 * 2;
constexpr size_t OFF_W1T = OFF_WDT + (size_t)1024 * DFF * 2;
constexpr size_t OFF_W2T = OFF_W1T + (size_t)2 * 256 * 2048 * 2;
constexpr size_t OFF_B1 = OFF_W2T + (size_t)2 * 128 * 256 * 2;
constexpr size_t OFF_ROPE = OFF_B1 + 2 * 256 * 4;
constexpr size_t OFF_H = al256(OFF_ROPE + (size_t)4096 * 32 * 8);
constexpr size_t OFF_O = OFF_H + (size_t)T * 1024 * 2;
constexpr size_t OFF_MIX = OFF_O + (size_t)T * 1024 * 2;
constexpr size_t OFF_QKV = OFF_MIX + (size_t)T * 1024 * 2;
constexpr size_t SZ_H8 = (size_t)8 * 8 * 4096 * 64 * 2;
constexpr size_t SZ_G2 = (size_t)8 * 2 * 4096 * 64 * 2;
constexpr size_t OFF_QD = OFF_QKV;
constexpr size_t OFF_KD = OFF_QD + SZ_H8;
constexpr size_t OFF_VDT = OFF_KD + SZ_H8;
constexpr size_t OFF_QN = OFF_VDT + SZ_H8;
constexpr size_t OFF_KCT = OFF_QN + SZ_H8;
constexpr size_t OFF_VCT = OFF_KCT + SZ_G2;
constexpr size_t OFF_KS = OFF_VCT + SZ_G2;
constexpr size_t OFF_VST = OFF_KS + SZ_G2;
constexpr size_t OFF_KW = OFF_VST + SZ_G2;
constexpr size_t OFF_VWT = OFF_KW + SZ_G2;
constexpr size_t OFF_GATES = OFF_VWT + SZ_G2;
constexpr size_t OFF_HID = OFF_GATES + (size_t)T * 24 * 4;
constexpr size_t OFF_KCMP = OFF_HID + (size_t)2 * 16 * 256 * 256 * 2;
constexpr size_t OFF_VCMPT = OFF_KCMP + (size_t)16 * 256 * 64 * 2;
constexpr size_t OFF_QKV_END = OFF_VCMPT + (size_t)16 * 256 * 64 * 2;
constexpr size_t OFF_ACT = OFF_QKV;
constexpr size_t OFF_ACT_END = OFF_ACT + (size_t)T * DFF * 2;
constexpr size_t WS_END = OFF_ACT_END > OFF_QKV_END ? OFF_ACT_END : OFF_QKV_END;

struct Params {
    const float* in[21];
    float* out;
    unsigned char* ws;
    int ph_lo, ph_hi;
};

DI unsigned pk_bf16(float a, float b) { f32x2 v = {a, b}; return __builtin_bit_cast(unsigned, __builtin_convertvector(v, bf16v2)); }
DI bf16_t f2bf(float a) { return (bf16_t)(pk_bf16(a, 0.f) & 0xffffu); }
DI float bflo(unsigned u) { return __uint_as_float(u << 16); }
DI float bfhi(unsigned u) { return __uint_as_float(u & 0xffff0000u); }
DI u32x4 pk8(const float (&v)[8]);
DI int crow(int i, int h) { return (i & 3) + 8 * (i >> 2) + 4 * h; }
DI float wave_sum(float v) {
    v += __shfl_xor(v, 32); v += __shfl_xor(v, 16); v += __shfl_xor(v, 8);
    v += __shfl_xor(v, 4); v += __shfl_xor(v, 2); v += __shfl_xor(v, 1);
    return v;
}
DI float fast_exp2(float x) { return __builtin_amdgcn_exp2f(x); }
DI float xhalf_max(float x) { auto rr = __builtin_amdgcn_permlane32_swap(__float_as_uint(x), __float_as_uint(x), false, false); return fmaxf(__uint_as_float(rr[0]), __uint_as_float(rr[1])); }
DI float xhalf_sum(float x) { auto rr = __builtin_amdgcn_permlane32_swap(__float_as_uint(x), __float_as_uint(x), false, false); return __uint_as_float(rr[0]) + __uint_as_float(rr[1]); }
DI float sigmoidf(float x) { return 1.f / (1.f + __expf(-x)); }


#define XB_TMO      128
#define XB_XCNT(j)  (256  + 64 * (j))
#define XB_XSUB(j)  (1280 + 64 * (j))
#define XB_XGEN(j)  (2304 + 64 * (j))
#define XB_TOP      3328
#define XB_TOPGEN   3392
#define XCD_BAR_WORDS 3456
#define XB_SPIN_CAP (1u << 18)
#define LAS __attribute__((address_space(3)))
DI unsigned xb_ld(unsigned* p) { return __hip_atomic_load(p, __ATOMIC_RELAXED, __HIP_MEMORY_SCOPE_AGENT); }
DI unsigned xb_add(unsigned* p, unsigned v) { return __hip_atomic_fetch_add(p, v, __ATOMIC_RELAXED, __HIP_MEMORY_SCOPE_AGENT); }
DI unsigned xb_xcc_id() { return (unsigned)__builtin_amdgcn_s_getreg((3 << 11) | 20) & 0xFu; }
#define XB_SPIN(cond, bar) do { unsigned _sp = 0; while (cond) { __builtin_amdgcn_s_sleep(1); \
    if ((++_sp & 255u) == 0u) { if (xb_ld(&(bar)[XB_TMO])) break; if (_sp > XB_SPIN_CAP) { atomicAdd(&(bar)[XB_TMO], 1u); break; } } } } while (0)
struct XcdBarrier { unsigned* bar; unsigned x; volatile LAS unsigned* st; };
DI XcdBarrier xcd_barrier_post(unsigned* bar, volatile LAS unsigned* st) {
    XcdBarrier b; b.bar = bar; b.x = xb_xcc_id(); b.st = st;
    if (threadIdx.x == 0) (void)xb_add(&bar[XB_XCNT(b.x)], 1u);
    return b;
}
DI void xcd_barrier_complete(unsigned* bar, unsigned x, unsigned& nloc, unsigned& nx) {
    const unsigned G = gridDim.x * gridDim.y * gridDim.z;
    unsigned sum, cnt, mine, sp = 0u;
    for (;;) {
        sum = 0u; cnt = 0u; mine = 0u;
#pragma unroll
        for (unsigned j = 0; j < 16; ++j) { const unsigned c = xb_ld(&bar[XB_XCNT(j)]); sum += c; cnt += (c > 0u) ? 1u : 0u; mine = (j == x) ? c : mine; }
        if (sum == G) break;
        __builtin_amdgcn_s_sleep(1);
        if ((++sp & 255u) == 0u) { if (xb_ld(&bar[XB_TMO])) break; if (sp > XB_SPIN_CAP) { atomicAdd(&bar[XB_TMO], 1u); break; } }
    }
    nloc = mine > 0u ? mine : 1u; nx = cnt > 0u ? cnt : 1u;
}
DI void xcd_barrier(const XcdBarrier& b) {
    asm volatile("s_waitcnt vmcnt(0)" ::: "memory");
    __syncthreads();
    if (threadIdx.x == 0) {
        unsigned* bar = b.bar;
        __builtin_amdgcn_s_waitcnt(0);
        unsigned nloc = b.st[0], nx = b.st[1];
        if (nloc == 0u) { xcd_barrier_complete(bar, b.x, nloc, nx); b.st[0] = nloc; b.st[1] = nx; }
        const unsigned old = xb_add(&bar[XB_XSUB(b.x)], 1u);
        const unsigned gen = old / nloc;
        if (old + 1u == (gen + 1u) * nloc) {
            __builtin_amdgcn_fence(__ATOMIC_RELEASE, "agent");
            asm volatile("s_waitcnt vmcnt(0)" ::: "memory");
            const unsigned og = xb_add(&bar[XB_TOP], 1u);
            const unsigned tg = og / nx;
            if (og + 1u == (tg + 1u) * nx) xb_add(&bar[XB_TOPGEN], 1u);
            else XB_SPIN(xb_ld(&bar[XB_TOPGEN]) == tg, bar);
            __builtin_amdgcn_fence(__ATOMIC_ACQUIRE, "agent");
            xb_add(&bar[XB_XGEN(b.x)], 1u);
            asm volatile("s_waitcnt vmcnt(0)" ::: "memory");
        } else {
            XB_SPIN(xb_ld(&bar[XB_XGEN(b.x)]) == gen, bar);
            __builtin_amdgcn_fence(__ATOMIC_ACQUIRE, "agent");
            asm volatile("s_waitcnt vmcnt(0)" ::: "memory");
        }
    }
    __syncthreads();
}
constexpr int LDS_XB = 2 * 73728;

DI int wdst_row(int n, int mode) {
    int dr = n;
    if (mode == 1 || mode == 2) dr = (n >> 2) * 8 + (n & 3) + (mode == 2 ? 4 : 0);
    else if (mode == 3) {
        const bool rope = (n < 1024) || (n >= 1536 && n < 2176) || (n >= 2304 && n < 2432) || (n >= 2560 && n < 2688);
        if (rope) { const int d = n & 63; dr = (n & ~63) + 8 * ((d & 31) >> 2) + (d & 3) + 4 * (d >> 5); }
    }
    return dr;
}
DI void transpose_tile(const float* __restrict__ src, int K, int N, bf16_t* __restrict__ dst, int ldd, int mode, int tile, float* tl, bool valid) {
    const int nbN = (N + 63) >> 6;
    const int kb = tile / nbN, nb = tile - kb * nbN;
    const int t = VTID;
    if (valid) {
#pragma unroll
        for (int i = 0; i < 4; ++i) {
            const int row = (t >> 4) + 16 * i, c4 = (t & 15) * 4, n = nb * 64 + c4;
            f32x4 v = {0.f, 0.f, 0.f, 0.f};
            if (n < N) v = *(const f32x4*)(src + (size_t)(kb * 64 + row) * N + n);
            float* q = tl + row * 65 + c4;
            q[0] = v[0]; q[1] = v[1]; q[2] = v[2]; q[3] = v[3];
        }
    }
    __syncthreads();
    if (valid) {
        const int nl = t >> 2, kc = (t & 3) * 16, n = nb * 64 + nl;
        if (n < N) {
            float a[8], b[8];
#pragma unroll
            for (int k = 0; k < 8; ++k) { a[k] = tl[(kc + k) * 65 + nl]; b[k] = tl[(kc + 8 + k) * 65 + nl]; }
            bf16_t* d = dst + (size_t)wdst_row(n, mode) * ldd + kb * 64 + kc;
            *(u32x4*)d = pk8(a); *(u32x4*)(d + 8) = pk8(b);
        }
    }
    __syncthreads();
}

DI void phase0(const Params& p, unsigned char* lds) {
    const int tid = VTID, lane = tid & 63, w = tid >> 6;
    const int G = VGRID;
    unsigned char* ws = p.ws;
    float* tl = (float*)(lds + VHALF * HALF_LDS);
    if (VBLK == 0) {
        if (tid < 64) {
            float a = p.in[3][lane] * p.in[4][lane];
            float b = p.in[5][lane] * p.in[6][lane];
            a = wave_sum(a); b = wave_sum(b);
            if (lane == 0) {
                ((float*)(ws + OFF_CTL))[16] = expf(a) - expf(b) + 0.2f;
                ((unsigned*)(ws + OFF_CTL))[0] = 0u; ((unsigned*)(ws + OFF_CTL))[1] = 0u; ((unsigned*)(ws + OFF_CTL))[2] = 0u; ((unsigned*)(ws + OFF_CTL))[3] = 0u;
            }
        }
    }
    {
        const int c0 = 720, c1 = c0 + 256, c2 = c1 + 704, c3 = c2 + 704, c4 = c3 + 704, c5 = c4 + 128, c6 = c5 + 128, c7 = c6 + 4, c8 = c7 + 4;
        for (int tb = 0; tb < c8; tb += G) {
            const bool valid = tb + VBLK < c8; const int t = valid ? tb + VBLK : c8 - 1;
            if (t < c0) transpose_tile(p.in[2], 1024, INC, (bf16_t*)(ws + OFF_WINT), 1024, 3, t, tl, valid);
            else if (t < c1) transpose_tile(p.in[14], 1024, 1024, (bf16_t*)(ws + OFF_WOUTT), 1024, 0, t - c0, tl, valid);
            else if (t < c2) transpose_tile(p.in[17], 1024, DFF, (bf16_t*)(ws + OFF_WGUT), 1024, 1, t - c1, tl, valid);
            else if (t < c3) transpose_tile(p.in[18], 1024, DFF, (bf16_t*)(ws + OFF_WGUT), 1024, 2, t - c2, tl, valid);
            else if (t < c4) transpose_tile(p.in[19], DFF, 1024, (bf16_t*)(ws + OFF_WDT), DFF, 0, t - c3, tl, valid);
            else if (t < c5) transpose_tile(p.in[9], 2048, 256, (bf16_t*)(ws + OFF_W1T), 2048, 0, t - c4, tl, valid);
            else if (t < c6) transpose_tile(p.in[12], 2048, 256, (bf16_t*)(ws + OFF_W1T) + 256 * 2048, 2048, 0, t - c5, tl, valid);
            else if (t < c7) transpose_tile(p.in[10], 256, 64, (bf16_t*)(ws + OFF_W2T), 256, 0, t - c6, tl, valid);
            else transpose_tile(p.in[13], 256, 64, (bf16_t*)(ws + OFF_W2T) + 128 * 256, 256, 0, t - c7, tl, valid);
        }
    }
    for (int t = VBLK; t < 8; t += G) {
        const int kv = t >> 2, cgp = t & 3;
        const float* pos = p.in[kv ? 11 : 8];
        const float* w1 = p.in[kv ? 12 : 9];
        const int c = cgp * 64 + (tid & 63), part = tid >> 6;
        float acc = 0.f;
        for (int k = part * 512; k < part * 512 + 512; ++k) acc += pos[k] * w1[(size_t)k * 256 + c];
        __syncthreads();
        tl[part * 64 + (tid & 63)] = acc;
        __syncthreads();
        if (tid < 64) ((float*)(ws + OFF_B1))[kv * 256 + c] = (tl[tid] + tl[64 + tid]) + (tl[128 + tid] + tl[192 + tid]);
        __syncthreads();
    }
    {
        f32x2* tab = (f32x2*)(ws + OFF_ROPE);
        for (int i = VBLK * 256 + tid; i < 4096 * 32; i += G * 256) {
            const int pos = i >> 5, j = i & 31;
            const float inv = 1.0f / powf(10000.f, (float)(2 * j) / 64.f);
            const float ang = (float)pos * inv;
            f32x2 cs; cs.x = cosf(ang); cs.y = sinf(ang);
            tab[i] = cs;
        }
    }
    {
        const float* x = p.in[0]; const float* g = p.in[1];
        bf16_t* H = (bf16_t*)(ws + OFF_H);
        for (int row = VBLK * 4 + w; row < T; row += G * 4) {
            const float* xr = x + (size_t)row * 1024;
            f32x4 v[4]; float ss = 0.f;
#pragma unroll
            for (int i = 0; i < 4; ++i) { v[i] = *(const f32x4*)(xr + i * 256 + lane * 4); ss += v[i][0] * v[i][0] + v[i][1] * v[i][1] + v[i][2] * v[i][2] + v[i][3] * v[i][3]; }
            ss = wave_sum(ss);
            const float rstd = rsqrtf(ss * (1.f / 1024.f) + NORM_EPS);
#pragma unroll
            for (int i = 0; i < 4; ++i) {
                const f32x4 gg = *(const f32x4*)(g + i * 256 + lane * 4);
                u32x2 o; o.x = pk_bf16(v[i][0] * rstd * gg[0], v[i][1] * rstd * gg[1]); o.y = pk_bf16(v[i][2] * rstd * gg[2], v[i][3] * rstd * gg[3]);
                *(u32x2*)(H + (size_t)row * 1024 + i * 256 + lane * 4) = o;
            }
        }
    }
}

constexpr int GP = 144;
constexpr int GT = 128 * GP;
constexpr int DT = 16384;
constexpr int DSTAGE = 2 * DT;
#define LAS3 __attribute__((address_space(3)))
template <bool SWAP>
DI void gemm_compute(const unsigned char* base, const int (&ao)[4], const int (&bo)[4], f32x16 (&acc)[2][2]) {
#pragma unroll
    for (int s = 0; s < 4; ++s) {
        const bf16x8 a0 = *(const bf16x8*)(base + ao[s]), a1 = *(const bf16x8*)(base + ao[s] + 32 * 128);
        const bf16x8 b0 = *(const bf16x8*)(base + DT + bo[s]), b1 = *(const bf16x8*)(base + DT + bo[s] + 32 * 128);
        if (SWAP) {
            acc[0][0] = MFMA(b0, a0, acc[0][0]); acc[0][1] = MFMA(b1, a0, acc[0][1]);
            acc[1][0] = MFMA(b0, a1, acc[1][0]); acc[1][1] = MFMA(b1, a1, acc[1][1]);
        } else {
            acc[0][0] = MFMA(a0, b0, acc[0][0]); acc[0][1] = MFMA(a0, b1, acc[0][1]);
            acc[1][0] = MFMA(a1, b0, acc[1][0]); acc[1][1] = MFMA(a1, b1, acc[1][1]);
        }
    }
}
DI void gemm_dma(const bf16_t* ga, const bf16_t* gb, int lda, int ldb, int k0, unsigned char* stage_w) {
#pragma unroll
    for (int i = 0; i < 4; ++i) {
        __builtin_amdgcn_global_load_lds((const unsigned*)(ga + (size_t)(32 * i) * lda + k0), (LAS3 unsigned*)(stage_w + i * 4096), 16, 0, 0);
        __builtin_amdgcn_global_load_lds((const unsigned*)(gb + (size_t)(32 * i) * ldb + k0), (LAS3 unsigned*)(stage_w + DT + i * 4096), 16, 0, 0);
    }
}
template <bool SWAP>
DI void gemm_main(const bf16_t* __restrict__ Ag, int lda, const bf16_t* __restrict__ Bg, int ldb, int K, f32x16 (&acc)[2][2], unsigned char* lds, int probe = 0) {
    const int tid = VTID, lane = tid & 63, w = __builtin_amdgcn_readfirstlane(tid >> 6), wr = w >> 1, wc = w & 1, r = lane & 31, h = lane >> 5;
    const int row0 = 8 * w + (lane >> 3), kch = (lane & 7) ^ ((row0 >> 1) & 7);
    const bf16_t* ga = Ag + (size_t)row0 * lda + kch * 8;
    const bf16_t* gb = Bg + (size_t)row0 * ldb + kch * 8;
    unsigned char* st0 = lds + w * 1024;
    unsigned char* st1 = lds + DSTAGE + w * 1024;
    int ao[4], bo[4];
    {
        const int ra = wr * 64 + r, rb = wc * 64 + r;
        const int xa = h ^ ((ra >> 1) & 7), xb = h ^ ((rb >> 1) & 7);
#pragma unroll
        for (int s = 0; s < 4; ++s) { ao[s] = ra * 128 + ((xa ^ (2 * s)) << 4); bo[s] = rb * 128 + ((xb ^ (2 * s)) << 4); }
    }
    const int nk = K >> 6;
    if (probe != 1) gemm_dma(ga, gb, lda, ldb, 0, st0);
    __syncthreads();
    for (int kt = 0; kt < nk; kt += 2) {
        if (probe != 1) gemm_dma(ga, gb, lda, ldb, (kt + 1) * 64, st1);
        if (probe != 2) gemm_compute<SWAP>(lds, ao, bo, acc);
        __syncthreads();
        if (kt + 2 < nk && probe != 1) gemm_dma(ga, gb, lda, ldb, (kt + 2) * 64, st0);
        if (probe != 2) gemm_compute<SWAP>(lds + DSTAGE, ao, bo, acc);
        __syncthreads();
    }
}
DI void zero_acc(f32x16 (&acc)[2][2]) {
#pragma unroll
    for (int a = 0; a < 2; ++a)
#pragma unroll
        for (int b = 0; b < 2; ++b)
#pragma unroll
            for (int i = 0; i < 16; ++i) acc[a][b][i] = 0.f;
}
DI void tile_map(int t, int NT, int& mt, int& nt) {
    const int xcd = t & 7, j = t >> 3;
    const int grp = j / (8 * NT), rem = j - grp * 8 * NT;
    nt = rem >> 3; mt = xcd * 32 + grp * 8 + (rem & 7);
}
constexpr int CP = 132;
template <bool SWAP>
DI void acc_to_lds(const f32x16 (&acc)[2][2], unsigned char* lds) {
    const int lane = VTID & 63, w = VTID >> 6, wr = w >> 1, wc = w & 1, r = lane & 31, h = lane >> 5;
    float* base = (float*)lds + (SWAP ? ((wc * 64 + 4 * h) * CP + wr * 64 + r) : ((wr * 64 + 4 * h) * CP + wc * 64 + r));
#pragma unroll
    for (int mt = 0; mt < 2; ++mt)
#pragma unroll
        for (int nt = 0; nt < 2; ++nt)
#pragma unroll
            for (int i = 0; i < 16; ++i) {
                const int rr = (i & 3) + 8 * (i >> 2);
                if (SWAP) base[(nt * 32 + rr) * CP + mt * 32] = acc[mt][nt][i];
                else base[(mt * 32 + rr) * CP + nt * 32] = acc[mt][nt][i];
            }
}
DI void ld8(const float* q, float (&v)[8]) {
    const f32x4 a = *(const f32x4*)q, b = *(const f32x4*)(q + 4);
    v[0] = a[0]; v[1] = a[1]; v[2] = a[2]; v[3] = a[3]; v[4] = b[0]; v[5] = b[1]; v[6] = b[2]; v[7] = b[3];
}
DI u32x4 pk8(const float (&v)[8]) {
    u32x4 o; o.x = pk_bf16(v[0], v[1]); o.y = pk_bf16(v[2], v[3]); o.z = pk_bf16(v[4], v[5]); o.w = pk_bf16(v[6], v[7]);
    return o;
}
DI void out_plain(const unsigned char* lds, bf16_t* dst, size_t ldd, int nch_log2) {
    const float* Ct = (const float*)lds;
    const int total = 128 << nch_log2;
#pragma unroll 1
    for (int c = VTID; c < total; c += 256) {
        const int a = c >> nch_log2, ch = c & ((1 << nch_log2) - 1);
        float v[8]; ld8(Ct + a * CP + ch * 8, v);
        *(u32x4*)(dst + (size_t)a * ldd + ch * 8) = pk8(v);
    }
}

namespace pg8 {
#define PG8_LAS __attribute__((address_space(3)))
typedef unsigned short bf16_t;
typedef short bf16x8 __attribute__((ext_vector_type(8)));
typedef float f32x4 __attribute__((ext_vector_type(4)));
typedef unsigned u32x4 __attribute__((ext_vector_type(4)));
constexpr int BM = 256, BK = 64, HALF = 128, HTB = HALF * BK * 2  , STAGE_BYTES = 8 * HTB, NXCD = 8, WGM = 8;

__host__ __device__ __forceinline__ int lds_byte(int r, int c) { const int st = (r >> 4) * 2 + (c >> 5), rr = r & 15, cc = c & 31, ob = rr * 64 + cc * 2; return st * 1024 + (ob ^ (((ob >> 9) & 1) << 5)); }
__host__ __device__ __forceinline__ void stage_rc(int b, int& R, int& C) { const int st = b / 1024, sb = b % 1024, swz = sb ^ (((sb >> 9) & 1) << 5); R = (st >> 1) * 16 + swz / 64; C = (st & 1) * 32 + (swz % 64) / 2; }
__host__ __device__ __forceinline__ int perm32(int rho) { const int n = rho >> 4, i = rho & 15; return 8 * (i >> 2) + 4 * n + (i & 3); }

struct Unit { int pm, pn; };
struct Gemm { const bf16_t* A; const bf16_t* Bt; int M, N, K; };

struct StaticOrder {
    int nM, nN, nwg, G, c;
    __host__ __device__ void init(int M, int N, int G_, int c_) { nM = M / BM; nN = N / BM; nwg = nM * nN; G = G_; c = c_; }
    __host__ __device__ bool next(int i, Unit& u) const {
        const long L = (long)i * G + c; if (L >= nwg) return false;
        int wgid = (int)L; { const int q = nwg / NXCD, r = nwg % NXCD, xcd = wgid % NXCD, off = wgid / NXCD; wgid = (xcd < r ? xcd * (q + 1) : r * (q + 1) + (xcd - r) * q) + off; }
        const int nig = WGM * nN, gid = wgid / nig, fm = gid * WGM, gsz = (nM - fm) < WGM ? (nM - fm) : WGM;
        u.pm = fm + ((wgid % nig) % gsz); u.pn = (wgid % nig) / gsz; return true;
    }
    __device__ __forceinline__ void a_ready(const Unit&) const {}
    __device__ __forceinline__ void done(const Unit&) const {}
};

__device__ __forceinline__ unsigned cvt_pk_bf16(float lo, float hi) { unsigned r; asm volatile("v_cvt_pk_bf16_f32 %0, %1, %2" : "=v"(r) : "v"(lo), "v"(hi)); return r; }
typedef float f32x2 __attribute__((ext_vector_type(2)));
template <class Epi, class Sched, bool ALIGN_EPI = false, bool SP2 = false>
__device__ __forceinline__ void gemm_phase(PG8_LAS unsigned char* lds, const Gemm g, const Sched& S, const Epi& E) {
    const int tid = threadIdx.x, wid = __builtin_amdgcn_readfirstlane(tid >> 6), lane = tid & 63, wr = wid >> 2, wc = wid & 3, fr = lane & 15, fq = lane >> 4;
    const int K = g.K, nt = K / BK;
    unsigned voffA[2], voffB[2];
#pragma unroll
    for (int i = 0; i < 2; ++i) { int R, C; stage_rc(tid * 16 + i * 8192, R, C); const int Rb = Epi::PERM ? ((R & ~31) + perm32(R & 31)) : R;
        voffA[i] = (unsigned)(R * K + C) * 2u; voffB[i] = (unsigned)(Rb * K + C) * 2u; }
    const size_t kstep = (size_t)(BK * 2);
    const size_t hstep = (size_t)HALF * K * 2;
    const size_t tstep = 2 * hstep;
    const unsigned ldsw = (unsigned)wid * 1024u;
    const int aoff = lds_byte(wr * 64 + fr, fq * 8), boff = lds_byte(wc * 32 + fr, fq * 8);
#define PG8_SA(b, h) (((b) * 2 + (h)) * HTB)
#define PG8_SB(b, h) ((4 + (b) * 2 + (h)) * HTB)
#define PG8_STAGE(bufoff, gbase, voff) do { _Pragma("unroll") for (int _i = 0; _i < 2; ++_i) \
        __builtin_amdgcn_global_load_lds((const unsigned*)((const char*)(gbase) + (voff)[_i]), (PG8_LAS unsigned*)(lds + (bufoff) + ldsw + _i * 8192), 16, 0, 0); } while (0)
#define PG8_LDA(dst, b, h) do { _Pragma("unroll") for (int m = 0; m < 4; ++m) _Pragma("unroll") for (int k = 0; k < 2; ++k) dst[m][k] = *(const PG8_LAS bf16x8*)(lds + PG8_SA(b, h) + aoff + m * 2048 + k * 1024); } while (0)
#define PG8_LDB(dst, b, h) do { _Pragma("unroll") for (int n = 0; n < 2; ++n) _Pragma("unroll") for (int k = 0; k < 2; ++k) dst[n][k] = *(const PG8_LAS bf16x8*)(lds + PG8_SB(b, h) + boff + n * 2048 + k * 1024); } while (0)
#define PG8_MMA(ai, bj, At, Bt) do { __builtin_amdgcn_s_setprio(1); _Pragma("unroll") for (int m = 0; m < 4; ++m) _Pragma("unroll") for (int n = 0; n < 2; ++n) _Pragma("unroll") for (int k = 0; k < 2; ++k) \
        acc[ai][bj][m][n] = __builtin_amdgcn_mfma_f32_16x16x32_bf16(Bt[n][k], At[m][k], acc[ai][bj][m][n], 0, 0, 0); __builtin_amdgcn_s_setprio(0); } while (0)
#define PG8_WAIT_V(n) asm volatile("s_waitcnt vmcnt(" #n ")" ::: "memory")
#define PG8_WAIT_L(n) asm volatile("s_waitcnt lgkmcnt(" #n ")" ::: "memory")
#define PG8_BAR __builtin_amdgcn_s_barrier()
#define PG8_SCHED __builtin_amdgcn_sched_barrier(0)
    Unit cur, nxt; int ui = 0;
    if (!S.next(0, cur)) return;
    f32x4 acc[2][2][4][2];
#pragma unroll
    for (int a = 0; a < 2; ++a)
#pragma unroll
        for (int b = 0; b < 2; ++b)
#pragma unroll
            for (int m = 0; m < 4; ++m)
#pragma unroll
                for (int n = 0; n < 2; ++n) acc[a][b][m][n] = (f32x4){0.f, 0.f, 0.f, 0.f};
    bf16x8 At[4][2], B0[2][2], B1[2][2];
    const char* cA = (const char*)g.A + (size_t)cur.pm * tstep; const char* cB = (const char*)g.Bt + (size_t)cur.pn * tstep;
    S.a_ready(cur);
    if constexpr (SP2) {
        PG8_STAGE(PG8_SB(0, 0), cB, voffB); PG8_STAGE(PG8_SB(0, 1), cB + hstep, voffB); PG8_STAGE(PG8_SA(0, 0), cA, voffA); PG8_STAGE(PG8_SA(0, 1), cA + hstep, voffA);
        if (wr == 1) PG8_BAR;
        PG8_WAIT_V(2); PG8_BAR;
        PG8_STAGE(PG8_SB(1, 0), cB + kstep, voffB); PG8_STAGE(PG8_SA(1, 0), cA + kstep, voffA); PG8_STAGE(PG8_SB(1, 1), cB + hstep + kstep, voffB);
        PG8_WAIT_V(6); PG8_BAR;
    } else {
        PG8_STAGE(PG8_SB(0, 0), cB, voffB); PG8_STAGE(PG8_SA(0, 0), cA, voffA); PG8_STAGE(PG8_SB(0, 1), cB + hstep, voffB); PG8_STAGE(PG8_SA(0, 1), cA + hstep, voffA);
        if (wr == 1) PG8_BAR;
        PG8_WAIT_V(4); PG8_BAR;
        PG8_STAGE(PG8_SB(1, 0), cB + kstep, voffB); PG8_STAGE(PG8_SA(1, 0), cA + kstep, voffA); PG8_STAGE(PG8_SB(1, 1), cB + hstep + kstep, voffB);
        PG8_WAIT_V(6); PG8_BAR;
    }
    for (;;) {
        const bool has_next = S.next(ui + 1, nxt);
        const char* nA = has_next ? (const char*)g.A + (size_t)nxt.pm * tstep : cA; const char* nB = has_next ? (const char*)g.Bt + (size_t)nxt.pn * tstep : cB;
        for (int t = 0; t < nt; t += 2) {
            const bool last = (t == nt - 2);
            const char* a1 = cA + (size_t)(t + 1) * kstep;
            const char* a2 = last ? nA : cA + (size_t)(t + 2) * kstep; const char* b2 = last ? nB : cB + (size_t)(t + 2) * kstep;
            const char* a3 = a2 + kstep; const char* b3 = b2 + kstep;
            if (last && has_next) S.a_ready(nxt);
            if constexpr (SP2) {
            PG8_LDB(B0, 0, 0); PG8_LDB(B1, 0, 1); PG8_SCHED; PG8_LDA(At, 0, 0); PG8_STAGE(PG8_SA(1, 1), a1 + hstep, voffA);
            PG8_WAIT_V(8); PG8_WAIT_L(0); PG8_BAR; PG8_MMA(0, 0, At, B0); PG8_MMA(0, 1, At, B1); PG8_BAR; PG8_SCHED;
            PG8_LDA(At, 0, 1); PG8_STAGE(PG8_SB(0, 0), b2, voffB); PG8_STAGE(PG8_SB(0, 1), b2 + hstep, voffB); PG8_STAGE(PG8_SA(0, 0), a2, voffA);
            PG8_WAIT_V(8); PG8_WAIT_L(0); PG8_BAR; PG8_MMA(1, 0, At, B0); PG8_MMA(1, 1, At, B1); PG8_BAR; PG8_SCHED;
            PG8_LDB(B0, 1, 0); PG8_LDB(B1, 1, 1); PG8_SCHED; PG8_LDA(At, 1, 0); PG8_STAGE(PG8_SA(0, 1), a2 + hstep, voffA);
            PG8_WAIT_V(8); PG8_WAIT_L(0); PG8_BAR; PG8_MMA(0, 0, At, B0); PG8_MMA(0, 1, At, B1); PG8_BAR; PG8_SCHED;
            PG8_LDA(At, 1, 1); PG8_STAGE(PG8_SB(1, 0), b3, voffB); PG8_STAGE(PG8_SB(1, 1), b3 + hstep, voffB); PG8_STAGE(PG8_SA(1, 0), a3, voffA);
            PG8_WAIT_V(8); PG8_WAIT_L(0); PG8_BAR; PG8_MMA(1, 0, At, B0); PG8_MMA(1, 1, At, B1); PG8_BAR; PG8_SCHED;
            } else {
            PG8_LDB(B0, 0, 0); PG8_SCHED; PG8_LDA(At, 0, 0); PG8_STAGE(PG8_SA(1, 1), a1 + hstep, voffA);
            PG8_WAIT_L(8); PG8_BAR; PG8_WAIT_L(0); PG8_MMA(0, 0, At, B0); PG8_BAR; PG8_SCHED;
            PG8_LDB(B1, 0, 1); PG8_STAGE(PG8_SB(0, 0), b2, voffB);
            PG8_BAR; PG8_WAIT_L(0); PG8_MMA(0, 1, At, B1); PG8_BAR;
            PG8_LDA(At, 0, 1); PG8_STAGE(PG8_SA(0, 0), a2, voffA);
            PG8_BAR; PG8_WAIT_L(0); PG8_MMA(1, 0, At, B0); PG8_BAR; PG8_SCHED;
            PG8_STAGE(PG8_SB(0, 1), b2 + hstep, voffB);
            PG8_WAIT_V(6); PG8_BAR; PG8_MMA(1, 1, At, B1); PG8_BAR;
            PG8_LDB(B0, 1, 0); PG8_SCHED; PG8_LDA(At, 1, 0); PG8_STAGE(PG8_SA(0, 1), a2 + hstep, voffA);
            PG8_WAIT_L(8); PG8_BAR; PG8_WAIT_L(0); PG8_MMA(0, 0, At, B0); PG8_BAR; PG8_SCHED;
            PG8_LDB(B1, 1, 1); PG8_STAGE(PG8_SB(1, 0), b3, voffB);
            PG8_BAR; PG8_WAIT_L(0); PG8_MMA(0, 1, At, B1); PG8_BAR;
            PG8_LDA(At, 1, 1); PG8_STAGE(PG8_SA(1, 0), a3, voffA);
            PG8_BAR; PG8_WAIT_L(0); PG8_MMA(1, 0, At, B0); PG8_BAR; PG8_SCHED;
            PG8_STAGE(PG8_SB(1, 1), b3 + hstep, voffB);
            PG8_WAIT_V(6); PG8_BAR; PG8_MMA(1, 1, At, B1); PG8_BAR;
            }
        }
        if constexpr (ALIGN_EPI) { if (wr == 0) PG8_BAR; }
        if constexpr (!Epi::AFTER_DRAIN) { E(acc, cur, wr, wc, fr, fq); S.done(cur); }
        if (!has_next) break;
#pragma unroll
        for (int a = 0; a < 2; ++a)
#pragma unroll
            for (int b = 0; b < 2; ++b)
#pragma unroll
                for (int m = 0; m < 4; ++m)
#pragma unroll
                    for (int n = 0; n < 2; ++n) acc[a][b][m][n] = (f32x4){0.f, 0.f, 0.f, 0.f};
        cur = nxt; cA = nA; cB = nB; ++ui;
        if constexpr (ALIGN_EPI) { if (wr == 1) PG8_BAR; }
    }
    PG8_WAIT_V(0);
    if constexpr (!ALIGN_EPI) { if (wr == 0) PG8_BAR; }
    PG8_BAR;
    if constexpr (Epi::AFTER_DRAIN) { E.fused(acc, cur, wr, wc, fr, fq, lds, wid, lane); S.done(cur); }
#undef PG8_SA
#undef PG8_SB
#undef PG8_STAGE
#undef PG8_LDA
#undef PG8_LDB
#undef PG8_MMA
#undef PG8_WAIT_V
#undef PG8_WAIT_L
#undef PG8_BAR
#undef PG8_SCHED
}


struct EpiPlain {
    static constexpr bool PERM = true, AFTER_DRAIN = false;
    bf16_t* O; int ldc;
    __device__ __forceinline__ void operator()(const f32x4 (&acc)[2][2][4][2], const Unit& u, int wr, int wc, int fr, int fq) const {
        bf16_t* base = O + (size_t)(u.pm * BM + wr * 64 + fr) * ldc + u.pn * BM + wc * 32 + 8 * fq;
#pragma unroll
        for (int ai = 0; ai < 2; ++ai)
#pragma unroll
            for (int m = 0; m < 4; ++m) {
                bf16_t* rowp = base + (size_t)(ai * HALF + m * 16) * ldc;
#pragma unroll
                for (int bj = 0; bj < 2; ++bj) {
                    const f32x4 v0 = acc[ai][bj][m][0], v1 = acc[ai][bj][m][1];
                    u32x4 w; w.x = cvt_pk_bf16(v0[0], v0[1]); w.y = cvt_pk_bf16(v0[2], v0[3]); w.z = cvt_pk_bf16(v1[0], v1[1]); w.w = cvt_pk_bf16(v1[2], v1[3]);
                    *(u32x4*)(rowp + bj * HALF) = w;
                }
            }
    }
};
struct EpiSwiGLU {
    static constexpr bool PERM = true, AFTER_DRAIN = false;
    bf16_t* ACT; int ldc;
    __device__ __forceinline__ void operator()(const f32x4 (&acc)[2][2][4][2], const Unit& u, int wr, int wc, int fr, int fq) const {
        bf16_t* base = ACT + (size_t)(u.pm * BM + wr * 64 + fr) * ldc + ((u.pn * BM + wc * 32 + 8 * fq) >> 1);
#pragma unroll
        for (int ai = 0; ai < 2; ++ai)
#pragma unroll
            for (int m = 0; m < 4; ++m) {
                bf16_t* rowp = base + (size_t)(ai * HALF + m * 16) * ldc;
#pragma unroll
                for (int bj = 0; bj < 2; ++bj) {
                    const f32x4 g = acc[ai][bj][m][0], up = acc[ai][bj][m][1];
                    float a[4];
#pragma unroll
                    for (int e = 0; e < 4; ++e) a[e] = g[e] * __builtin_amdgcn_rcpf(1.f + __expf(-g[e])) * up[e];
                    typedef unsigned u32x2v __attribute__((ext_vector_type(2)));
                    u32x2v w; w.x = cvt_pk_bf16(a[0], a[1]); w.y = cvt_pk_bf16(a[2], a[3]);
                    *(u32x2v*)(rowp + bj * (HALF / 2)) = w;
                }
            }
    }
};
struct EpiInproj {
    static constexpr bool PERM = true, AFTER_DRAIN = false;
    unsigned char* ws; size_t off_qd, off_kd, off_vdt, off_qn, off_kct, off_vct, off_ks, off_vst, off_kw, off_vwt, off_gates, off_rope;
    __device__ __forceinline__ void operator()(const f32x4 (&acc)[2][2][4][2], const Unit& u, int wr, int wc, int fr, int fq) const {
        typedef unsigned u32x2v __attribute__((ext_vector_type(2)));
        typedef float f32x2v __attribute__((ext_vector_type(2)));
        const int row0 = u.pm * BM + wr * 64 + fr;
        const int b = row0 >> 12, pos0 = row0 & 4095;
#pragma unroll
        for (int bj = 0; bj < 2; ++bj) {
            const int cb = u.pn * BM + bj * HALF;
            const int cl = wc * 32 + 8 * fq;
            int kind = 4; size_t off = 0; int hidx = 0;
            if (cb < 512) { kind = 0; off = off_qd; hidx = b * 8 + ((cb + cl) >> 6); }
            else if (cb < 1024) { kind = 0; off = off_kd; hidx = b * 8 + ((cb - 512 + cl) >> 6); }
            else if (cb < 1536) { kind = 2; off = off_vdt; hidx = b * 4 + ((cb - 1024) >> 7); }
            else if (cb < 2048) { kind = 0; off = off_qn; hidx = b * 8 + ((cb - 1536 + cl) >> 6); }
            else if (cb == 2048) { kind = 0; off = off_kct; hidx = b * 2 + (cl >> 6); }
            else if (cb == 2176) { kind = 1; off = off_vct; hidx = b * 2 + (cl >> 6); }
            else if (cb == 2304) { kind = 0; off = off_ks; hidx = b * 2 + (cl >> 6); }
            else if (cb == 2432) { kind = 3; off = off_vst; hidx = b * 2 + (cl >> 6); }
            else if (cb == 2560) { kind = 0; off = off_kw; hidx = b * 2 + (cl >> 6); }
            else if (cb == 2688) { kind = 3; off = off_vwt; hidx = b * 2 + (cl >> 6); }
            else if (cb == 2816) kind = 5;
            if (kind == 0) {
                const int g4 = 4 * (((cl & 63) >> 3));
                bf16_t* dst = (bf16_t*)(ws + off) + ((size_t)hidx * 4096 + pos0) * 64 + g4;
                const f32x2v* tab = (const f32x2v*)(ws + off_rope) + (size_t)pos0 * 32 + g4;
#pragma unroll
                for (int ai = 0; ai < 2; ++ai)
#pragma unroll
                    for (int m = 0; m < 4; ++m) {
                        const int dp = ai * HALF + m * 16;
                        const f32x4 x1 = acc[ai][bj][m][0], x2 = acc[ai][bj][m][1];
                        const f32x4 t01 = *(const f32x4*)(tab + (size_t)dp * 32), t23 = *(const f32x4*)(tab + (size_t)dp * 32 + 2);
                        const float c0 = t01[0], s0 = t01[1], c1 = t01[2], s1 = t01[3], c2 = t23[0], s2 = t23[1], c3 = t23[2], s3 = t23[3];
                        u32x2v lo, hi;
                        lo.x = cvt_pk_bf16(x1[0] * c0 - x2[0] * s0, x1[1] * c1 - x2[1] * s1); lo.y = cvt_pk_bf16(x1[2] * c2 - x2[2] * s2, x1[3] * c3 - x2[3] * s3);
                        hi.x = cvt_pk_bf16(x1[0] * s0 + x2[0] * c0, x1[1] * s1 + x2[1] * c1); hi.y = cvt_pk_bf16(x1[2] * s2 + x2[2] * c2, x1[3] * s3 + x2[3] * c3);
                        *(u32x2v*)(dst + (size_t)dp * 64) = lo; *(u32x2v*)(dst + (size_t)dp * 64 + 32) = hi;
                    }
            } else if (kind == 1) {
                bf16_t* dst = (bf16_t*)(ws + off) + ((size_t)hidx * 4096 + pos0) * 64 + (cl & 63);
#pragma unroll
                for (int ai = 0; ai < 2; ++ai)
#pragma unroll
                    for (int m = 0; m < 4; ++m) {
                        const f32x4 v0 = acc[ai][bj][m][0], v1 = acc[ai][bj][m][1];
                        u32x4 w; w.x = cvt_pk_bf16(v0[0], v0[1]); w.y = cvt_pk_bf16(v0[2], v0[3]); w.z = cvt_pk_bf16(v1[0], v1[1]); w.w = cvt_pk_bf16(v1[2], v1[3]);
                        *(u32x4*)(dst + (size_t)(ai * HALF + m * 16) * 64) = w;
                    }
            } else if (kind == 2 || kind == 3) {
                const int dv = (kind == 2) ? 128 : 64;
                const int e0 = (kind == 2) ? cl : (cl & 63);
#pragma unroll
                for (int ai = 0; ai < 2; ++ai) {
                    const int pa = pos0 + ai * HALF;
                    bf16_t* dst = (bf16_t*)(ws + off) + (((size_t)hidx * 64 + (pa >> 6)) * dv + e0) * 64 + (pa & 63);
#pragma unroll
                    for (int m = 0; m < 4; ++m)
#pragma unroll
                        for (int n = 0; n < 2; ++n)
#pragma unroll
                            for (int j = 0; j < 4; ++j) {
                                const unsigned pk = cvt_pk_bf16(acc[ai][bj][m][n][j], 0.f);
                                dst[(4 * n + j) * 64 + 16 * m] = (bf16_t)(pk & 0xffffu);
                            }
                }
            } else if (kind == 5) {
                if (wc == 0 && fq < 3) {
                    float* gates = (float*)(ws + off_gates) + (size_t)row0 * 24 + 8 * fq;
#pragma unroll
                    for (int ai = 0; ai < 2; ++ai)
#pragma unroll
                        for (int m = 0; m < 4; ++m) {
                            f32x4 a = acc[ai][bj][m][0], c = acc[ai][bj][m][1];
#pragma unroll
                            for (int e = 0; e < 4; ++e) { a[e] = 1.f / (1.f + __expf(-a[e])); c[e] = 1.f / (1.f + __expf(-c[e])); }
                            float* gp = gates + (size_t)(ai * HALF + m * 16) * 24;
                            *(f32x4*)gp = a; *(f32x4*)(gp + 4) = c;
                        }
                }
            }
        }
    }
};
}

DI void epi_inproj(const Params& p, const unsigned char* lds, int m0, int n0) {
    unsigned char* ws = p.ws;
    const float* Ct = (const float*)lds;
    const int b = m0 >> 12, pos0 = m0 & 4095;
    int tid = VTID; asm volatile("" : "+v"(tid));
    if (n0 == 2816) {
        float* gates = (float*)(ws + OFF_GATES);
#pragma unroll 1
        for (int c = tid; c < 128 * 3; c += 256) {
            const int a = c / 3, ch = c - a * 3;
            float v[8]; ld8(Ct + a * CP + ch * 8, v);
            f32x4 o0, o1;
            o0[0] = sigmoidf(v[0]); o0[1] = sigmoidf(v[1]); o0[2] = sigmoidf(v[2]); o0[3] = sigmoidf(v[3]);
            o1[0] = sigmoidf(v[4]); o1[1] = sigmoidf(v[5]); o1[2] = sigmoidf(v[6]); o1[3] = sigmoidf(v[7]);
            float* g = gates + (size_t)(m0 + a) * 24 + ch * 8;
            *(f32x4*)g = o0; *(f32x4*)(g + 4) = o1;
        }
        return;
    }
    const bool tr = (n0 >= 1024 && n0 < 1536) || n0 == 2432 || n0 == 2688;
    if (tr) {
        bf16_t* dst; int hshift, hbase, nbase;
        if (n0 < 1536) { dst = (bf16_t*)(ws + OFF_VDT); hshift = 7; hbase = b * 4; nbase = 1024; }
        else if (n0 == 2432) { dst = (bf16_t*)(ws + OFF_VST); hshift = 6; hbase = b * 2; nbase = 2432; }
        else { dst = (bf16_t*)(ws + OFF_VWT); hshift = 6; hbase = b * 2; nbase = 2688; }
#pragma unroll 1
        for (int c = tid; c < 2048; c += 256) {
            const int a = c >> 4, ch = c & 15;
            const int cr = n0 + a - nbase;
            const int hidx = hbase + (cr >> hshift), e = cr & ((1 << hshift) - 1);
            float v[8]; ld8(Ct + a * CP + ch * 8, v);
            const int pos = pos0 + ch * 8;
            *(u32x4*)(dst + ((((size_t)hidx * 64 + (pos >> 6)) << hshift) + e) * 64 + (pos & 63)) = pk8(v);
        }
        return;
    }
    if (n0 == 2176) {
        bf16_t* dst = (bf16_t*)(ws + OFF_VCT);
#pragma unroll 1
        for (int c = tid; c < 2048; c += 256) {
            const int a = c >> 4, ch = c & 15;
            const int hidx = b * 2 + (ch >> 3);
            float v[8]; ld8(Ct + a * CP + ch * 8, v);
            *(u32x4*)(dst + ((size_t)hidx * 4096 + pos0 + a) * 64 + (ch & 7) * 8) = pk8(v);
        }
        return;
    }
    {
        bf16_t* dst; int hbase;
        if (n0 < 512) { dst = (bf16_t*)(ws + OFF_QD); hbase = b * 8 + (n0 >> 6); }
        else if (n0 < 1024) { dst = (bf16_t*)(ws + OFF_KD); hbase = b * 8 + ((n0 - 512) >> 6); }
        else if (n0 < 2048) { dst = (bf16_t*)(ws + OFF_QN); hbase = b * 8 + ((n0 - 1536) >> 6); }
        else if (n0 == 2048) { dst = (bf16_t*)(ws + OFF_KCT); hbase = b * 2; }
        else if (n0 == 2304) { dst = (bf16_t*)(ws + OFF_KS); hbase = b * 2; }
        else { dst = (bf16_t*)(ws + OFF_KW); hbase = b * 2; }
        const float* tab = (const float*)(ws + OFF_ROPE);
#pragma unroll 1
        for (int c = tid; c < 1024; c += 256) {
            const int a = c >> 3, hd = (c >> 2) & 1, cc = c & 3;
            float x1[8], x2[8], cs[16];
            ld8(Ct + a * CP + hd * 64 + cc * 8, x1); ld8(Ct + a * CP + hd * 64 + 32 + cc * 8, x2);
            const int pos = pos0 + a;
            const float* tp = tab + ((size_t)pos * 32 + cc * 8) * 2;
            {
                const f32x4 t0 = *(const f32x4*)tp, t1 = *(const f32x4*)(tp + 4), t2 = *(const f32x4*)(tp + 8), t3 = *(const f32x4*)(tp + 12);
                cs[0] = t0[0]; cs[1] = t0[1]; cs[2] = t0[2]; cs[3] = t0[3]; cs[4] = t1[0]; cs[5] = t1[1]; cs[6] = t1[2]; cs[7] = t1[3];
                cs[8] = t2[0]; cs[9] = t2[1]; cs[10] = t2[2]; cs[11] = t2[3]; cs[12] = t3[0]; cs[13] = t3[1]; cs[14] = t3[2]; cs[15] = t3[3];
            }
            float y1[8], y2[8];
#pragma unroll
            for (int e = 0; e < 8; ++e) { const float cv = cs[2 * e], sv = cs[2 * e + 1]; y1[e] = x1[e] * cv - x2[e] * sv; y2[e] = x1[e] * sv + x2[e] * cv; }
            bf16_t* d = dst + ((size_t)(hbase + hd) * 4096 + pos) * 64 + cc * 8;
            *(u32x4*)d = pk8(y1); *(u32x4*)(d + 32) = pk8(y2);
        }
    }
}
DI void phase1(const Params& p, unsigned char* lds) {
    pg8::Gemm g; g.A = (const bf16_t*)(p.ws + OFF_H); g.Bt = (const bf16_t*)(p.ws + OFF_WINT); g.M = T; g.N = INP; g.K = 1024;
    pg8::StaticOrder S; S.init(T, INP, (int)gridDim.x, (int)blockIdx.x);
    pg8::EpiInproj E; E.ws = p.ws; E.off_qd = OFF_QD; E.off_kd = OFF_KD; E.off_vdt = OFF_VDT; E.off_qn = OFF_QN; E.off_kct = OFF_KCT; E.off_vct = OFF_VCT;
    E.off_ks = OFF_KS; E.off_vst = OFF_VST; E.off_kw = OFF_KW; E.off_vwt = OFF_VWT; E.off_gates = OFF_GATES; E.off_rope = OFF_ROPE;
    pg8::gemm_phase<pg8::EpiInproj, pg8::StaticOrder, true, true>((PG8_LAS unsigned char*)lds, g, S, E);
    __syncthreads();
}

DI void phase2(const Params& p, unsigned char* lds) {
    unsigned char* hl = lds + VHALF * HALF_LDS;
    for (int t = blockIdx.x; t < 128; t += gridDim.x) {
        const int kv = t >> 6, bg = (t >> 2) & 15, mt = (t >> 1) & 1, nt = t & 1, kh = VHALF * 1024;
        const bf16_t* A = (const bf16_t*)(p.ws + (kv ? OFF_VCT : OFF_KCT)) + (size_t)bg * 4096 * 64 + (size_t)mt * 128 * 1024 + kh;
        const bf16_t* B = (const bf16_t*)(p.ws + OFF_W1T) + (size_t)kv * 256 * 2048 + (size_t)nt * 128 * 2048 + kh;
        f32x16 acc[2][2]; zero_acc(acc);
        gemm_main<false>(A, 1024, B, 2048, 1024, acc, hl);
        acc_to_lds<false>(acc, hl);
        __syncthreads();
        const float* b1 = (const float*)(p.ws + OFF_B1) + kv * 256 + nt * 128;
        bf16_t* HID = (bf16_t*)(p.ws + OFF_HID) + (size_t)(kv * 16 + bg) * 65536 + (size_t)mt * 128 * 256 + nt * 128;
        const float* C0 = (const float*)lds; const float* C1 = (const float*)(lds + HALF_LDS);
#pragma unroll 1
        for (int c = threadIdx.x; c < 2048; c += 512) {
            const int a = c >> 4, ch = c & 15;
            float v[8], v2[8], bb[8]; ld8(C0 + a * CP + ch * 8, v); ld8(C1 + a * CP + ch * 8, v2); ld8(b1 + ch * 8, bb);
#pragma unroll
            for (int e = 0; e < 8; ++e) { const float z = (v[e] + v2[e]) + bb[e]; v[e] = z * sigmoidf(z); }
            *(u32x4*)(HID + (size_t)a * 256 + ch * 8) = pk8(v);
        }
        __syncthreads();
    }
}
DI void phase3(const Params& p, unsigned char* lds) {
    unsigned char* hl = lds + VHALF * HALF_LDS;
    for (int t = blockIdx.x; t < 64; t += gridDim.x) {
        const int kv = t >> 5, bg = (t >> 1) & 15, mt = t & 1, kh = VHALF * 128;
        const bf16_t* A = (const bf16_t*)(p.ws + OFF_HID) + (size_t)(kv * 16 + bg) * 65536 + (size_t)mt * 128 * 256 + kh;
        const bf16_t* B = (const bf16_t*)(p.ws + OFF_W2T) + (size_t)kv * 128 * 256 + kh;
        f32x16 acc[2][2]; zero_acc(acc);
        if (kv == 0) { gemm_main<false>(A, 256, B, 256, 128, acc, hl); acc_to_lds<false>(acc, hl); }
        else { gemm_main<true>(A, 256, B, 256, 128, acc, hl); acc_to_lds<true>(acc, hl); }
        __syncthreads();
        const float* C0 = (const float*)lds; const float* C1 = (const float*)(lds + HALF_LDS);
        if (kv == 0) {
            bf16_t* KC = (bf16_t*)(p.ws + OFF_KCMP) + (size_t)bg * 256 * 64 + (size_t)mt * 128 * 64;
#pragma unroll 1
            for (int c = threadIdx.x; c < 128 * 8; c += 512) {
                const int a = c >> 3, ch = c & 7;
                float v[8], v2[8]; ld8(C0 + a * CP + ch * 8, v); ld8(C1 + a * CP + ch * 8, v2);
#pragma unroll
                for (int e = 0; e < 8; ++e) v[e] += v2[e];
                *(u32x4*)(KC + (size_t)a * 64 + ch * 8) = pk8(v);
            }
        } else {
            bf16_t* VC = (bf16_t*)(p.ws + OFF_VCMPT) + (size_t)bg * 64 * 256;
#pragma unroll 1
            for (int c = threadIdx.x; c < 64 * 16; c += 512) {
                const int a = c >> 4, ch = c & 15;
                const int n = mt * 128 + ch * 8;
                float v[8], v2[8]; ld8(C0 + a * CP + ch * 8, v); ld8(C1 + a * CP + ch * 8, v2);
#pragma unroll
                for (int e = 0; e < 8; ++e) v[e] += v2[e];
                *(u32x4*)(VC + ((size_t)(n >> 6) * 64 + a) * 64 + (n & 63)) = pk8(v);
            }
        }
        __syncthreads();
    }
}

constexpr int KP = 144;
constexpr int VP = 144;
constexpr int KT_BYTES = 64 * KP;
constexpr float SM_C = 0.125f * 1.4426950408889634f;
#define NEG_INF (-__builtin_inff())

template <int DV> struct KVStage { u32x4 k[1]; u32x4 v[DV / 64]; };

template <int DV, bool HAS_V>
DI void kv_gload(KVStage<DV>& st, const bf16_t* __restrict__ Kb, const bf16_t* __restrict__ VTb, int ldv, int key0) {
    const int tid = threadIdx.x;
    st.k[0] = *(const u32x4*)(Kb + (size_t)(key0 + (tid >> 3)) * 64 + (tid & 7) * 8);
    if (HAS_V) {
#pragma unroll
        for (int i = 0; i < DV / 64; ++i) { const int c = tid + 512 * i; st.v[i] = *(const u32x4*)(VTb + (size_t)(key0 >> 6) * (DV * 64) + c * 8); }
    }
}
template <int DV, bool HAS_V>
DI void kv_sstore(const KVStage<DV>& st, unsigned char* buf) {
    const int tid = threadIdx.x;
    *(u32x4*)(buf + (tid >> 3) * KP + (tid & 7) * 16) = st.k[0];
    if (HAS_V) {
#pragma unroll
        for (int i = 0; i < DV / 64; ++i) {
            const int c = tid + 512 * i, kc = c & 7; unsigned char* q = buf + KT_BYTES + (c >> 3) * VP + (kc >> 1) * 32 + (kc & 1) * 8;
            u32x2 lo, hi; lo.x = st.v[i].x; lo.y = st.v[i].y; hi.x = st.v[i].z; hi.y = st.v[i].w;
            *(u32x2*)q = lo; *(u32x2*)(q + 16) = hi;
        }
    }
}
template <int DV, bool HAS_V, class Next, class Body>
DI void kv_loop(unsigned char* lds, const bf16_t* Kb, const bf16_t* VTb, int ldv, int nt, int j0, Next next, Body body, int probe = 0, const KVStage<DV>* pre = nullptr) {
    constexpr int SB = KT_BYTES + (HAS_V ? DV * VP : 0);
    KVStage<DV> st;
    int jn = j0;
    if (pre) { st = *pre; kv_sstore<DV, HAS_V>(st, lds); }
    else if (probe != 1) { kv_gload<DV, HAS_V>(st, Kb, VTb, ldv, jn * 64); kv_sstore<DV, HAS_V>(st, lds); }
    __syncthreads();
    for (int i = 0; i < nt; ++i) {
        const int j = jn;
        const bool more = (i + 1 < nt);
        if (more) { jn = next(j); if (probe != 1) kv_gload<DV, HAS_V>(st, Kb, VTb, ldv, jn * 64); }
        if (probe != 2) body(j, (const unsigned char*)(lds + (i & 1) * SB));
        if (more && probe != 1) kv_sstore<DV, HAS_V>(st, lds + ((i + 1) & 1) * SB);
        __syncthreads();
    }
}
DI void attn_scores(const unsigned char* kb, const bf16x8 (&qf)[4], int r, int h, f32x16& s0, f32x16& s1) {
#pragma unroll
    for (int i = 0; i < 16; ++i) { s0[i] = 0.f; s1[i] = 0.f; }
#pragma unroll
    for (int s = 0; s < 4; ++s) {
        const bf16x8 k0 = *(const bf16x8*)(kb + r * KP + s * 32 + h * 16);
        const bf16x8 k1 = *(const bf16x8*)(kb + (32 + r) * KP + s * 32 + h * 16);
        s0 = MFMA(k0, qf[s], s0); s1 = MFMA(k1, qf[s], s1);
    }
}
DI void pack_p(const f32x16& p0, const f32x16& p1, bf16x8 (&pf)[2][2]) {
#pragma unroll
    for (int sp = 0; sp < 2; ++sp) {
        u32x4 a, b;
        a.x = pk_bf16(p0[8 * sp + 0], p0[8 * sp + 1]); a.y = pk_bf16(p0[8 * sp + 2], p0[8 * sp + 3]);
        a.z = pk_bf16(p0[8 * sp + 4], p0[8 * sp + 5]); a.w = pk_bf16(p0[8 * sp + 6], p0[8 * sp + 7]);
        b.x = pk_bf16(p1[8 * sp + 0], p1[8 * sp + 1]); b.y = pk_bf16(p1[8 * sp + 2], p1[8 * sp + 3]);
        b.z = pk_bf16(p1[8 * sp + 4], p1[8 * sp + 5]); b.w = pk_bf16(p1[8 * sp + 6], p1[8 * sp + 7]);
        pf[0][sp] = __builtin_bit_cast(bf16x8, a); pf[1][sp] = __builtin_bit_cast(bf16x8, b);
    }
}
template <int DV>
DI void attn_pv(const unsigned char* vb, const bf16x8 (&pf)[2][2], int r, int h, f32x16 (&o)[DV / 32]) {
#pragma unroll
    for (int dt = 0; dt < DV / 32; ++dt)
#pragma unroll
        for (int mt = 0; mt < 2; ++mt)
#pragma unroll
            for (int sp = 0; sp < 2; ++sp) {
                const bf16x8 vf = *(const bf16x8*)(vb + (dt * 32 + r) * VP + (2 * mt + sp) * 32 + h * 16);
                o[dt] = MFMA(vf, pf[mt][sp], o[dt]);
            }
}
constexpr float SM_THR = 7.2f;
typedef float f32x8 __attribute__((ext_vector_type(8)));
DI float hsum16(const f32x16& v) {
    const f32x8 a = __builtin_shufflevector(v, v, 0, 1, 2, 3, 4, 5, 6, 7) + __builtin_shufflevector(v, v, 8, 9, 10, 11, 12, 13, 14, 15);
    const f32x4 b = __builtin_shufflevector(a, a, 0, 1, 2, 3) + __builtin_shufflevector(a, a, 4, 5, 6, 7);
    return (b[0] + b[1]) + (b[2] + b[3]);
}
template <int DV>
DI void attn_softmax_pv(f32x16& s0, f32x16& s1, float& m, float& l, f32x16 (&o)[DV / 32], const unsigned char* vb, int r, int h) {
    s0 = s0 * SM_C; s1 = s1 * SM_C;
    const f32x16 t = __builtin_elementwise_max(s0, s1);
    float mx = fmaxf(fmaxf(fmaxf(t[0], t[1]), fmaxf(t[2], t[3])), fmaxf(fmaxf(t[4], t[5]), fmaxf(t[6], t[7])));
    mx = fmaxf(mx, fmaxf(fmaxf(fmaxf(t[8], t[9]), fmaxf(t[10], t[11])), fmaxf(fmaxf(t[12], t[13]), fmaxf(t[14], t[15]))));
    mx = xhalf_max(mx);
    if (!__all(mx - m <= SM_THR)) {
        const float mn = fmaxf(m, mx);
        const float alpha = fast_exp2(m - mn);
        l *= alpha; m = mn;
#pragma unroll
        for (int dt = 0; dt < DV / 32; ++dt) o[dt] = o[dt] * alpha;
    }
    s0 = s0 - m; s1 = s1 - m;
#pragma unroll
    for (int i = 0; i < 16; ++i) { s0[i] = fast_exp2(s0[i]); s1[i] = fast_exp2(s1[i]); }
    const f32x16 sm = s0 + s1;
    l += xhalf_sum(hsum16(sm));
    bf16x8 pf[2][2]; pack_p(s0, s1, pf);
    attn_pv<DV>(vb, pf, r, h, o);
}

DI void diff_unit(const Params& p, int u, unsigned char* lds, int probe = 0) {
    int tid_ = threadIdx.x; asm volatile("" : "+v"(tid_));
    const int lane = tid_ & 63, w = tid_ >> 6, r = lane & 31, h = lane >> 5;
    const int qt = 15 - (u >> 5), bh = u & 31, b = bh >> 2, hh = bh & 3;
    const int q0 = qt * 256, wq0 = q0 + 32 * w, qpos = wq0 + r;
    const int ntl = 4 * qt + 4;
    const float lam = ((const float*)(p.ws + OFF_CTL))[16];
    const bf16_t* VTb = (const bf16_t*)(p.ws + OFF_VDT) + (size_t)(b * 4 + hh) * 128 * 4096;
#pragma unroll 1
    for (int mp = 0; mp < 2; ++mp) {
        const size_t hoff = ((size_t)(b * 8 + hh * 2 + mp) * 4096) * 64;
        const bf16_t* Qb = (const bf16_t*)(p.ws + OFF_QD) + hoff;
        const bf16_t* Kb = (const bf16_t*)(p.ws + OFF_KD) + hoff;
        bf16x8 qf[4];
#pragma unroll
        for (int s = 0; s < 4; ++s) qf[s] = *(const bf16x8*)(Qb + (size_t)qpos * 64 + s * 16 + h * 8);
#pragma unroll
        for (int s = 0; s < 4; ++s) asm volatile("" : "+v"(qf[s]));
        f32x16 o[4];
#pragma unroll
        for (int dt = 0; dt < 4; ++dt)
#pragma unroll
            for (int i = 0; i < 16; ++i) o[dt][i] = 0.f;
        float m = -1e30f, l = 0.f;
        kv_loop<128, true>(lds, Kb, VTb, 4096, ntl, 0, [](int j) { return j + 1; }, [&](int j, const unsigned char* sb) {
            const int k0 = j * 64;
            if (k0 <= wq0 + 31) {
                f32x16 s0, s1; attn_scores(sb, qf, r, h, s0, s1);
                if (k0 + 63 > wq0) {
#pragma unroll
                    for (int i = 0; i < 16; ++i) {
                        const int kl = k0 + crow(i, h);
                        if (kl > qpos) s0[i] = NEG_INF;
                        if (kl + 32 > qpos) s1[i] = NEG_INF;
                    }
                }
                attn_softmax_pv<128>(s0, s1, m, l, o, sb + KT_BYTES, r, h);
            }
        }, probe);
        if (probe) {
            float chk = l + m;
#pragma unroll
            for (int dt = 0; dt < 4; ++dt)
#pragma unroll
                for (int i = 0; i < 16; ++i) chk += o[dt][i];
            if (chk == 1.2345e-30f) ((float*)(p.ws + OFF_CTL))[32] = chk;
            continue;
        }
        const float inv = 1.f / l;
        bf16_t* O = (bf16_t*)(p.ws + OFF_O) + ((size_t)b * 4096 + qpos) * 1024 + hh * 128;
        if (mp == 0) {
#pragma unroll
            for (int dt = 0; dt < 4; ++dt)
#pragma unroll
                for (int g4 = 0; g4 < 4; ++g4) {
                    u32x2 ov; ov.x = pk_bf16(o[dt][4 * g4] * inv, o[dt][4 * g4 + 1] * inv); ov.y = pk_bf16(o[dt][4 * g4 + 2] * inv, o[dt][4 * g4 + 3] * inv);
                    *(u32x2*)(O + dt * 32 + 8 * g4 + 4 * h) = ov;
                }
        } else {
            float ss = 0.f;
            const float li = lam * inv;
#pragma unroll
            for (int dt = 0; dt < 4; ++dt)
#pragma unroll
                for (int g4 = 0; g4 < 4; ++g4) {
                    const u32x2 pv = *(const u32x2*)(O + dt * 32 + 8 * g4 + 4 * h);
                    const float v0 = bflo(pv.x) - li * o[dt][4 * g4], v1 = bfhi(pv.x) - li * o[dt][4 * g4 + 1];
                    const float v2 = bflo(pv.y) - li * o[dt][4 * g4 + 2], v3 = bfhi(pv.y) - li * o[dt][4 * g4 + 3];
                    o[dt][4 * g4] = v0; o[dt][4 * g4 + 1] = v1; o[dt][4 * g4 + 2] = v2; o[dt][4 * g4 + 3] = v3;
                    ss += (v0 * v0 + v1 * v1) + (v2 * v2 + v3 * v3);
                }
            ss = xhalf_sum(ss);
            const float rstd = rsqrtf(ss * (1.f / 128.f) + NORM_EPS) * 0.8f;
            const float* sub = p.in[7];
#pragma unroll
            for (int dt = 0; dt < 4; ++dt)
#pragma unroll
                for (int g4 = 0; g4 < 4; ++g4) {
                    const int d = dt * 32 + 8 * g4 + 4 * h;
                    const f32x4 sg = *(const f32x4*)(sub + d);
                    u32x2 ov; ov.x = pk_bf16(o[dt][4 * g4] * rstd * sg[0], o[dt][4 * g4 + 1] * rstd * sg[1]);
                    ov.y = pk_bf16(o[dt][4 * g4 + 2] * rstd * sg[2], o[dt][4 * g4 + 3] * rstd * sg[3]);
                    *(u32x2*)(O + d) = ov;
                }
        }
    }
}

constexpr int NSA_IMPW = 36864;
constexpr int NSA_SEL = NSA_IMPW + 65536;
constexpr int NSA_UN = NSA_SEL + 512;
constexpr int NSA_FT = NSA_UN + 64;
constexpr int LDS_UNIT = 2 * 73728 + 16;
DI void nsa_unit(const Params& p, int u, unsigned char* lds, int probe = 0) {
    int tid_ = threadIdx.x; asm volatile("" : "+v"(tid_));
    const int lane = tid_ & 63, w = tid_ >> 6, r = lane & 31, h = lane >> 5;
    const int qt = 63 - (u >> 4), bg = u & 15, b = bg >> 1, g = bg & 1;
    const int hq = w >> 2, q0 = qt * 64, qb = q0 + 32 * hq, qpos = qb + r, head = g * 4 + (w & 3);
    float* IMPW = (float*)(lds + NSA_IMPW);
    u64* SEL = (u64*)(lds + NSA_SEL);
    u64* UN = (u64*)(lds + NSA_UN);
    const bf16_t* Qb = (const bf16_t*)(p.ws + OFF_QN) + ((size_t)(b * 8 + head) * 4096) * 64;
    bf16x8 qf[4];
#pragma unroll
    for (int s = 0; s < 4; ++s) qf[s] = *(const bf16x8*)(Qb + (size_t)qpos * 64 + s * 16 + h * 8);
#pragma unroll
    for (int s = 0; s < 4; ++s) asm volatile("" : "+v"(qf[s]));
    const float* gp = (const float*)(p.ws + OFF_GATES) + ((size_t)b * 4096 + qpos) * 24 + head * 3;
    auto inc = [](int j) { return j + 1; };
    f32x16 oacc[2];

    float* FT = (float*)(lds + NSA_FT);
    {
        const bf16_t* Kc = (const bf16_t*)(p.ws + OFF_KCMP) + (size_t)bg * 256 * 64;
        const bf16_t* VcT = (const bf16_t*)(p.ws + OFF_VCMPT) + (size_t)bg * 64 * 256;
        const int nmax = ((q0 + 32) >> 4) + 1, ntc = (nmax + 63) >> 6;
        const int nvalid = qpos >= 31 ? ((qpos - 31) >> 4) + 1 : 0;
        float m = -1e30f, l = 0.f, carry = 0.f;
        f32x16 oc[2];
#pragma unroll
        for (int dt = 0; dt < 2; ++dt)
#pragma unroll
            for (int i = 0; i < 16; ++i) oc[dt][i] = 0.f;
        kv_loop<64, true>(lds, Kc, VcT, 256, ntc, 0, inc, [&](int j, const unsigned char* sb) {
            f32x16 s0, s1; attn_scores(sb, qf, r, h, s0, s1);
            float mx = NEG_INF;
#pragma unroll
            for (int i = 0; i < 16; ++i) {
                const int n = j * 64 + crow(i, h);
                if (n >= nvalid) s0[i] = NEG_INF;
                if (n + 32 >= nvalid) s1[i] = NEG_INF;
                mx = fmaxf(mx, fmaxf(s0[i], s1[i]));
            }
            mx = xhalf_max(mx);
            const float mn = fmaxf(m, mx);
            const float alpha = fast_exp2((m - mn) * SM_C), nb = -mn * SM_C;
            m = mn; l *= alpha; carry *= alpha;
#pragma unroll
            for (int dt = 0; dt < 2; ++dt) oc[dt] = oc[dt] * alpha;
            if (h == 0) FT[(w * 32 + r) * 4 + j] = mn;
            float rs = 0.f;
#pragma unroll
            for (int i = 0; i < 16; ++i) {
                s0[i] = fast_exp2(__builtin_fmaf(s0[i], SM_C, nb)); s1[i] = fast_exp2(__builtin_fmaf(s1[i], SM_C, nb));
                rs += s0[i] + s1[i];
            }
            l += xhalf_sum(rs);
#pragma unroll
            for (int mt = 0; mt < 2; ++mt)
#pragma unroll
                for (int a = 0; a < 4; ++a) {
                    const float x0 = mt ? s1[4 * a] : s0[4 * a], x1 = mt ? s1[4 * a + 1] : s0[4 * a + 1];
                    const float x2 = mt ? s1[4 * a + 2] : s0[4 * a + 2], x3 = mt ? s1[4 * a + 3] : s0[4 * a + 3];
                    float mainv = ((x0 + x1) + x2) + 0.5f * x3;
                    const float cr = 0.5f * x3;
                    const float other = __shfl_xor(cr, 32);
                    mainv += h ? other : carry;
                    carry = other;
                    IMPW[(w * 32 + r) * 64 + 16 * j + 8 * mt + 2 * a + h] = mainv;
                }
            bf16x8 pf[2][2]; pack_p(s0, s1, pf);
            attn_pv<64>(sb + KT_BYTES, pf, r, h, oc);
        }, probe);
        const float invl = l > 0.f ? 1.f / l : 0.f;
        if (h == 0) {
#pragma unroll
            for (int t = 0; t < 4; ++t)
                if (t < ntc) { const float mt_ = FT[(w * 32 + r) * 4 + t]; FT[(w * 32 + r) * 4 + t] = fast_exp2((mt_ - m) * SM_C) * invl; }
        }
        const float g0 = gp[0] * invl;
#pragma unroll
        for (int dt = 0; dt < 2; ++dt)
#pragma unroll
            for (int i = 0; i < 16; ++i) oacc[dt][i] = g0 * oc[dt][i];
        __syncthreads();
    }
    KVStage<64> preS; kv_gload<64, true>(preS, (const bf16_t*)(p.ws + OFF_KS) + (size_t)bg * 4096 * 64, (const bf16_t*)(p.ws + OFF_VST) + (size_t)bg * 64 * 4096, 0, 0);
    {
        u64 un = 0;
#pragma unroll 1
        for (int qq = 0; qq < 8; ++qq) {
            const int rr = 8 * w + qq, qp = q0 + rr, cur = qp >> 6, j = lane;
            const bool valid = j <= cur;
            float v = 0.f;
            if (valid) {
                const float* ip = IMPW + ((rr >> 5) * 4 * 32 + (rr & 31)) * 64 + j;
                const float* fp = FT + ((rr >> 5) * 4 * 32 + (rr & 31)) * 4 + (j >> 4);
                v = ((ip[0] * fp[0] + ip[2048] * fp[128]) + ip[4096] * fp[256]) + ip[6144] * fp[384];
            }
            const bool forced = (j == 0) || (j == cur) || (j == cur - 1);
            const float key = forced ? __builtin_inff() : (valid ? v : NEG_INF);
            const unsigned kb_ = __float_as_uint(key);
            const unsigned uk = (kb_ & 0x80000000u) ? ~kb_ : (kb_ | 0x80000000u);
            unsigned thr = 0u;
#pragma unroll
            for (int bit = 31; bit >= 0; --bit) {
                const unsigned cand = thr | (1u << bit);
                if (__popcll(__ballot(uk >= cand)) >= 16) thr = cand;
            }
            const u64 gtm = __ballot(uk > thr), eqm = __ballot(uk == thr);
            const int need = 16 - (int)__popcll(gtm);
            const int below = (int)__builtin_amdgcn_mbcnt_hi((unsigned)(eqm >> 32), __builtin_amdgcn_mbcnt_lo((unsigned)eqm, 0u));
            const bool sel = ((uk > thr) || (uk == thr && below < need)) && valid;
            const u64 mask = __ballot(sel);
            if (lane == 0) SEL[rr] = mask;
            un |= mask;
        }
        if (lane == 0) UN[w] = un;
        __syncthreads();
    }
    const u64 mysel = SEL[32 * hq + r];
    const u64 U = ((UN[0] | UN[1]) | (UN[2] | UN[3])) | ((UN[4] | UN[5]) | (UN[6] | UN[7]));
    unsigned char* ql = lds + NSA_IMPW + (w * 32 + r) * 144 + h * 16;
#pragma unroll
    for (int s = 0; s < 4; ++s) *(bf16x8*)(ql + s * 32) = qf[s];
    {
        const bf16_t* Ks = (const bf16_t*)(p.ws + OFF_KS) + (size_t)bg * 4096 * 64;
        const bf16_t* VsT = (const bf16_t*)(p.ws + OFF_VST) + (size_t)bg * 64 * 4096;
        const int nts = __popcll(U), j0 = __ffsll((long long)U) - 1;
        f32x16 o[2];
#pragma unroll
        for (int dt = 0; dt < 2; ++dt)
#pragma unroll
            for (int i = 0; i < 16; ++i) o[dt][i] = 0.f;
        float m = -1e30f, l = 0.f;
        kv_loop<64, true>(lds, Ks, VsT, 4096, nts, j0, [U](int j) { return __ffsll((long long)(U & (~0ull << (j + 1)))) - 1; }, [&](int j, const unsigned char* sb) {
            const bool mine = (mysel >> j) & 1ull;
            if (__ballot(mine) != 0ull) {
                bf16x8 q2[4];
#pragma unroll
                for (int s = 0; s < 4; ++s) q2[s] = *(const bf16x8*)(ql + s * 32);
                f32x16 s0, s1; attn_scores(sb, q2, r, h, s0, s1);
                const int lim = mine ? (qpos - 64 * j) : -1;
#pragma unroll
                for (int i = 0; i < 16; ++i) {
                    const int kl = crow(i, h);
                    if (kl > lim) s0[i] = NEG_INF;
                    if (kl + 32 > lim) s1[i] = NEG_INF;
                }
                attn_softmax_pv<64>(s0, s1, m, l, o, sb + KT_BYTES, r, h);
            }
        }, probe, &preS);
        const float sc = l > 0.f ? gp[1] / l : 0.f;
#pragma unroll
        for (int dt = 0; dt < 2; ++dt)
#pragma unroll
            for (int i = 0; i < 16; ++i) oacc[dt][i] += sc * o[dt][i];
    }
    {
        const bf16_t* Kw = (const bf16_t*)(p.ws + OFF_KW) + (size_t)bg * 4096 * 64;
        const bf16_t* VwT = (const bf16_t*)(p.ws + OFF_VWT) + (size_t)bg * 64 * 4096;
        const int tlo = (q0 > 511 ? q0 - 511 : 0) >> 6, thi = (q0 + 63) >> 6;
        f32x16 o[2];
#pragma unroll
        for (int dt = 0; dt < 2; ++dt)
#pragma unroll
            for (int i = 0; i < 16; ++i) o[dt][i] = 0.f;
        float m = -1e30f, l = 0.f;
        kv_loop<64, true>(lds, Kw, VwT, 4096, thi - tlo + 1, tlo, inc, [&](int j, const unsigned char* sb) {
            const int k0 = j * 64;
            if (k0 > qb + 31 || k0 + 63 <= qb - 512) return;
            bf16x8 q2[4];
#pragma unroll
            for (int s = 0; s < 4; ++s) q2[s] = *(const bf16x8*)(ql + s * 32);
            f32x16 s0, s1; attn_scores(sb, q2, r, h, s0, s1);
            if (!(k0 + 63 <= qb && k0 > qb + 31 - 512)) {
#pragma unroll
                for (int i = 0; i < 16; ++i) {
                    const int ka = k0 + crow(i, h), kb2 = ka + 32;
                    if (!(ka <= qpos && ka > qpos - 512)) s0[i] = NEG_INF;
                    if (!(kb2 <= qpos && kb2 > qpos - 512)) s1[i] = NEG_INF;
                }
            }
            attn_softmax_pv<64>(s0, s1, m, l, o, sb + KT_BYTES, r, h);
        }, probe);
        const float sc = l > 0.f ? gp[2] / l : 0.f;
#pragma unroll
        for (int dt = 0; dt < 2; ++dt)
#pragma unroll
            for (int i = 0; i < 16; ++i) oacc[dt][i] += sc * o[dt][i];
    }
    if (probe) {
        float chk = 0.f;
#pragma unroll
        for (int dt = 0; dt < 2; ++dt)
#pragma unroll
            for (int i = 0; i < 16; ++i) chk += oacc[dt][i];
        if (chk == 1.2345e-30f) ((float*)(p.ws + OFF_CTL))[33] = chk;
        return;
    }
    bf16_t* O = (bf16_t*)(p.ws + OFF_O) + ((size_t)b * 4096 + qpos) * 1024 + 512 + head * 64;
#pragma unroll
    for (int dt = 0; dt < 2; ++dt)
#pragma unroll
        for (int g4 = 0; g4 < 4; ++g4) {
            u32x2 ov; ov.x = pk_bf16(oacc[dt][4 * g4], oacc[dt][4 * g4 + 1]); ov.y = pk_bf16(oacc[dt][4 * g4 + 2], oacc[dt][4 * g4 + 3]);
            *(u32x2*)(O + dt * 32 + 8 * g4 + 4 * h) = ov;
        }
}
DI void phase4(const Params& p, unsigned char* lds, int rep = 0, int probe = 0, int which = 3) {
    unsigned* counter = (unsigned*)(p.ws + OFF_CTL) + 2 * rep;
    volatile int* su = (volatile int*)(lds + LDS_UNIT);
    if (which & 1) for (;;) {
        if (threadIdx.x == 0) *su = (int)atomicAdd(counter, 1u);
        __syncthreads();
        const int u = *su;
        __syncthreads();
        if (u >= 512) break;
        diff_unit(p, u, lds, probe);
    }
    if (which & 2) for (;;) {
        if (threadIdx.x == 0) *su = (int)atomicAdd(counter + 1, 1u);
        __syncthreads();
        const int u = *su;
        __syncthreads();
        if (u >= 1024) break;
        nsa_unit(p, u, lds, probe);
    }
}
DI void phase5(const Params& p, unsigned char* lds) {
    pg8::Gemm g; g.A = (const bf16_t*)(p.ws + OFF_O); g.Bt = (const bf16_t*)(p.ws + OFF_WOUTT); g.M = T; g.N = 1024; g.K = 1024;
    pg8::StaticOrder S; S.init(T, 1024, (int)gridDim.x, (int)blockIdx.x);
    pg8::EpiPlain E; E.O = (bf16_t*)(p.ws + OFF_MIX); E.ldc = 1024;
    pg8::gemm_phase<pg8::EpiPlain, pg8::StaticOrder, true, true>((PG8_LAS unsigned char*)lds, g, S, E);
    __syncthreads();
}
DI void phase6(const Params& p) {
    const int lane = VTID & 63, w = VTID >> 6;
    const float* x = p.in[0]; const float* gpost = p.in[15]; const float* gffn = p.in[16];
    const bf16_t* MIX = (const bf16_t*)(p.ws + OFF_MIX);
    bf16_t* H = (bf16_t*)(p.ws + OFF_H);
    float* RSTD = (float*)(p.ws + OFF_GATES);
    const int stride = VGRID * 4;
    int row = VBLK * 4 + w;
    u32x2 um[4], nu[4]; f32x4 xv[4], nx[4];
    if (row < T) {
#pragma unroll
        for (int i = 0; i < 4; ++i) { um[i] = *(const u32x2*)(MIX + (size_t)row * 1024 + i * 256 + lane * 4); xv[i] = *(const f32x4*)(x + (size_t)row * 1024 + i * 256 + lane * 4); }
    }
    for (; row < T; row += stride) {
        const int nrow = row + stride;
        if (nrow < T) {
#pragma unroll
            for (int i = 0; i < 4; ++i) { nu[i] = *(const u32x2*)(MIX + (size_t)nrow * 1024 + i * 256 + lane * 4); nx[i] = *(const f32x4*)(x + (size_t)nrow * 1024 + i * 256 + lane * 4); }
        }
        f32x4 mv[4]; float ss = 0.f;
#pragma unroll
        for (int i = 0; i < 4; ++i) {
            mv[i][0] = bflo(um[i].x); mv[i][1] = bfhi(um[i].x); mv[i][2] = bflo(um[i].y); mv[i][3] = bfhi(um[i].y);
            ss += mv[i][0] * mv[i][0] + mv[i][1] * mv[i][1] + mv[i][2] * mv[i][2] + mv[i][3] * mv[i][3];
        }
        ss = wave_sum(ss);
        const float rstd = rsqrtf(ss * (1.f / 1024.f) + NORM_EPS);
        if (lane == 0) RSTD[row] = rstd;
        float ss2 = 0.f;
#pragma unroll
        for (int i = 0; i < 4; ++i) {
            const f32x4 gg = *(const f32x4*)(gpost + i * 256 + lane * 4);
#pragma unroll
            for (int e2 = 0; e2 < 4; ++e2) { xv[i][e2] += mv[i][e2] * rstd * gg[e2]; ss2 += xv[i][e2] * xv[i][e2]; }
        }
        ss2 = wave_sum(ss2);
        const float rstd2 = rsqrtf(ss2 * (1.f / 1024.f) + NORM_EPS);
#pragma unroll
        for (int i = 0; i < 4; ++i) {
            const f32x4 gg = *(const f32x4*)(gffn + i * 256 + lane * 4);
            u32x2 o; o.x = pk_bf16(xv[i][0] * rstd2 * gg[0], xv[i][1] * rstd2 * gg[1]); o.y = pk_bf16(xv[i][2] * rstd2 * gg[2], xv[i][3] * rstd2 * gg[3]);
            *(u32x2*)(H + (size_t)row * 1024 + i * 256 + lane * 4) = o;
        }
#pragma unroll
        for (int i = 0; i < 4; ++i) { um[i] = nu[i]; xv[i] = nx[i]; }
    }
}
DI void phase7(const Params& p, unsigned char* lds, int probe = 0) {
    pg8::Gemm g; g.A = (const bf16_t*)(p.ws + OFF_H); g.Bt = (const bf16_t*)(p.ws + OFF_WGUT); g.M = T; g.N = 2 * DFF; g.K = 1024;
    pg8::StaticOrder S; S.init(T, 2 * DFF, (int)gridDim.x, (int)blockIdx.x);
    pg8::EpiSwiGLU E; E.ACT = (bf16_t*)(p.ws + OFF_ACT); E.ldc = DFF;
    pg8::gemm_phase<pg8::EpiSwiGLU, pg8::StaticOrder, true, true>((PG8_LAS unsigned char*)lds, g, S, E);
    __syncthreads();
}
DI void phase8(const Params& p, unsigned char* lds) {
    pg8::Gemm g; g.A = (const bf16_t*)(p.ws + OFF_ACT); g.Bt = (const bf16_t*)(p.ws + OFF_WDT); g.M = T; g.N = 1024; g.K = DFF;
    pg8::StaticOrder S; S.init(T, 1024, (int)gridDim.x, (int)blockIdx.x);
    pg8::EpiPlain E; E.O = (bf16_t*)(p.ws + OFF_O); E.ldc = 1024;
    pg8::gemm_phase<pg8::EpiPlain, pg8::StaticOrder, true, true>((PG8_LAS unsigned char*)lds, g, S, E);
    __syncthreads();
}
DI void phase9(const Params& p) {
    const int lane = VTID & 63, w = VTID >> 6;
    const float* x = p.in[0]; const float* g1 = p.in[15]; const float* g2 = p.in[20];
    const bf16_t* MIX = (const bf16_t*)(p.ws + OFF_MIX);
    const bf16_t* F = (const bf16_t*)(p.ws + OFF_O);
    const float* RSTD = (const float*)(p.ws + OFF_GATES);
    const int stride = VGRID * 4;
    int row = VBLK * 4 + w;
    u32x2 uf[4], um[4], nf[4], nm[4]; f32x4 xr[4], nx[4]; float r1 = 0.f, nr1 = 0.f;
    if (row < T) {
#pragma unroll
        for (int i = 0; i < 4; ++i) {
            uf[i] = *(const u32x2*)(F + (size_t)row * 1024 + i * 256 + lane * 4); um[i] = *(const u32x2*)(MIX + (size_t)row * 1024 + i * 256 + lane * 4);
            xr[i] = *(const f32x4*)(x + (size_t)row * 1024 + i * 256 + lane * 4);
        }
        r1 = RSTD[row];
    }
    for (; row < T; row += stride) {
        const int nrow = row + stride;
        if (nrow < T) {
#pragma unroll
            for (int i = 0; i < 4; ++i) {
                nf[i] = *(const u32x2*)(F + (size_t)nrow * 1024 + i * 256 + lane * 4); nm[i] = *(const u32x2*)(MIX + (size_t)nrow * 1024 + i * 256 + lane * 4);
                nx[i] = *(const f32x4*)(x + (size_t)nrow * 1024 + i * 256 + lane * 4);
            }
            nr1 = RSTD[nrow];
        }
        f32x4 fv[4], mv[4]; float ss = 0.f;
#pragma unroll
        for (int i = 0; i < 4; ++i) {
            fv[i][0] = bflo(uf[i].x); fv[i][1] = bfhi(uf[i].x); fv[i][2] = bflo(uf[i].y); fv[i][3] = bfhi(uf[i].y);
            mv[i][0] = bflo(um[i].x); mv[i][1] = bfhi(um[i].x); mv[i][2] = bflo(um[i].y); mv[i][3] = bfhi(um[i].y);
            ss += fv[i][0] * fv[i][0] + fv[i][1] * fv[i][1] + fv[i][2] * fv[i][2] + fv[i][3] * fv[i][3];
        }
        ss = wave_sum(ss);
        const float rstd = rsqrtf(ss * (1.f / 1024.f) + NORM_EPS);
#pragma unroll
        for (int i = 0; i < 4; ++i) {
            const f32x4 ga = *(const f32x4*)(g1 + i * 256 + lane * 4);
            const f32x4 gb = *(const f32x4*)(g2 + i * 256 + lane * 4);
            f32x4 xv = xr[i];
#pragma unroll
            for (int e2 = 0; e2 < 4; ++e2) { xv[e2] += mv[i][e2] * r1 * ga[e2]; xv[e2] += fv[i][e2] * rstd * gb[e2]; }
            *(f32x4*)(p.out + (size_t)row * 1024 + i * 256 + lane * 4) = xv;
        }
#pragma unroll
        for (int i = 0; i < 4; ++i) { uf[i] = nf[i]; um[i] = nm[i]; xr[i] = nx[i]; }
        r1 = nr1;
    }
}

__global__ void __launch_bounds__(512, 2) mega(Params p) {
    extern __shared__ __attribute__((aligned(16))) unsigned char lds[];
    cg::grid_group grid = cg::this_grid();
    const bool fused = (p.ph_hi - p.ph_lo) > 1;
    XcdBarrier xb; xb.bar = (unsigned*)(p.ws + OFF_XB); xb.x = 0; xb.st = (volatile LAS unsigned*)(lds + LDS_XB);
    if (fused) {
        if (threadIdx.x == 0) { xb.st[0] = 0u; xb.st[1] = 0u; }
        __syncthreads();
        xb = xcd_barrier_post((unsigned*)(p.ws + OFF_XB), (volatile LAS unsigned*)(lds + LDS_XB));
    }
    if (p.ph_hi > 1000) grid.sync();
#ifndef ONLY_PH
#define ONLY_PH -1
#endif
#define PH_ON(n) (ONLY_PH < 0 || ONLY_PH == (n))
#define RUN_PHASE(n, call) if (p.ph_lo <= (n) && (n) < p.ph_hi) { if (PH_ON(n)) { call; } if ((n) + 1 < p.ph_hi) { xcd_barrier(xb); if (PROBE_MODE == 1) xcd_barrier(xb); } }
    RUN_PHASE(0, phase0(p, lds))
    RUN_PHASE(1, phase1(p, lds))
    RUN_PHASE(2, phase2(p, lds))
    RUN_PHASE(3, phase3(p, lds))
    RUN_PHASE(4, phase4(p, lds))
#if PROBE_MODE == 2
    RUN_PHASE(4, phase4(p, lds, 1))
#endif
#if PROBE_MODE == 8
    RUN_PHASE(4, phase4(p, lds, 1, 0, 1))
#endif
#if PROBE_MODE == 9
    RUN_PHASE(4, phase4(p, lds, 1, 0, 2))
#endif
#if PROBE_MODE == 6
    RUN_PHASE(4, phase4(p, lds, 1, 1))
#endif
#if PROBE_MODE == 7
    RUN_PHASE(4, phase4(p, lds, 1, 2))
#endif
    RUN_PHASE(5, phase5(p, lds))
    RUN_PHASE(6, phase6(p))
    RUN_PHASE(7, phase7(p, lds))
#if PROBE_MODE == 3
    RUN_PHASE(7, phase7(p, lds))
#endif
#if PROBE_MODE == 4
    RUN_PHASE(7, phase7(p, lds, 1))
#endif
#if PROBE_MODE == 5
    RUN_PHASE(7, phase7(p, lds, 2))
#endif
    RUN_PHASE(8, phase8(p, lds))
    RUN_PHASE(9, phase9(p))
}

extern "C" void kernel_launch(void* const* d_in, const int* in_sizes, int n_in, void* d_out, int out_size, void* d_ws, size_t ws_size, hipStream_t stream) {
    static int grid_blocks = 0;
    if (grid_blocks == 0) {
        if (n_in != 21 || ws_size < WS_END) { fprintf(stderr, "kernel_launch: unexpected n_in %d / ws %zu (need %zu)\n", n_in, ws_size, (size_t)WS_END); grid_blocks = -1; return; }
        int dev = 0, cus = 0, per_cu = 0;
        hipGetDevice(&dev);
        hipDeviceGetAttribute(&cus, hipDeviceAttributeMultiprocessorCount, dev);
        if (hipFuncSetAttribute((const void*)mega, hipFuncAttributeMaxDynamicSharedMemorySize, LDS_BYTES) != hipSuccess) { fprintf(stderr, "kernel_launch: hipFuncSetAttribute failed\n"); grid_blocks = -1; return; }
        hipOccupancyMaxActiveBlocksPerMultiprocessor(&per_cu, (const void*)mega, 512, LDS_BYTES);
        if (per_cu < 1) per_cu = 1;
        if (per_cu > 1) per_cu = 1;
        grid_blocks = cus * per_cu;
        if (grid_blocks > 256) grid_blocks = 256;
    }
    if (grid_blocks < 0) return;
    Params p{};
    for (int i = 0; i < 21; ++i) p.in[i] = (const float*)d_in[i];
    p.out = (float*)d_out; p.ws = (unsigned char*)d_ws;
#if MULTI_LAUNCH
    for (int ph = 0; ph < NPH; ++ph) {
        p.ph_lo = ph; p.ph_hi = ph + 1;
        hipLaunchKernelGGL(mega, dim3(grid_blocks), dim3(512), LDS_BYTES, stream, p);
    }
#else
    p.ph_lo = 0; p.ph_hi = NPH;
    if (hipMemsetAsync((unsigned char*)d_ws + OFF_XB, 0, XCD_BAR_WORDS * 4, stream) != hipSuccess) { fprintf(stderr, "kernel_launch: memset of barrier words failed\n"); return; }
    void* args[] = {&p};
    hipError_t e = hipLaunchCooperativeKernel((const void*)mega, dim3(grid_blocks), dim3(512), args, LDS_BYTES, stream);
    if (e != hipSuccess) fprintf(stderr, "cooperative launch failed: %s (grid %d)\n", hipGetErrorString(e), grid_blocks);
#endif
}
```

```cpp
#include <hip/hip_runtime.h>
#include <hip/hip_cooperative_groups.h>
#include <cstdio>
#include <cstdint>
namespace cg = cooperative_groups;

#ifndef MULTI_LAUNCH
#define MULTI_LAUNCH 0
#endif
#ifndef PROBE_MODE
#define PROBE_MODE 0
#endif

typedef unsigned short bf16_t;
typedef short bf16x8 __attribute__((ext_vector_type(8)));
typedef short s16x4 __attribute__((ext_vector_type(4)));
typedef float f32x16 __attribute__((ext_vector_type(16)));
typedef float f32x4 __attribute__((ext_vector_type(4)));
typedef float f32x2 __attribute__((ext_vector_type(2)));
typedef unsigned u32x4 __attribute__((ext_vector_type(4)));
typedef unsigned u32x2 __attribute__((ext_vector_type(2)));
typedef __bf16 bf16v2 __attribute__((ext_vector_type(2)));
typedef unsigned long long u64;

#define DI __device__ __forceinline__
#define MFMA(a, b, c) __builtin_amdgcn_mfma_f32_32x32x16_bf16((a), (b), (c), 0, 0, 0)

constexpr int T = 32768, S = 4096, DM = 1024;
constexpr int INC = 2840, INP = 3072, DFF = 2816;
constexpr int NPH = 10;
constexpr int HALF_LDS = 73728;
constexpr int LDS_BYTES = 2 * HALF_LDS + 256;
#define VTID ((int)(threadIdx.x & 255))
#define VHALF ((int)(threadIdx.x >> 8))
#define VBLK ((int)(blockIdx.x * 2 + (threadIdx.x >> 8)))
#define VGRID ((int)(gridDim.x * 2))
constexpr float NORM_EPS = 1e-6f;

constexpr size_t al256(size_t x) { return (x + 255) & ~(size_t)255; }
constexpr size_t OFF_CTL = 0;
constexpr size_t OFF_XB = 4096;
constexpr size_t OFF_WINT = 4096 + 16384;
constexpr size_t OFF_WOUTT = OFF_WINT + (size_t)INP * 1024 * 2;
constexpr size_t OFF_WGUT = OFF_WOUTT + (size_t)1024 * 1024 * 2;
constexpr size_t OFF_WDT = OFF_WGUT + (size_t)2 * DFF * 1024 * 2;
constexpr size_t OFF_W1T = OFF_WDT + (size_t)1024 * DFF * 2;
constexpr size_t OFF_W2T = OFF_W1T + (size_t)2 * 256 * 2048 * 2;
constexpr size_t OFF_B1 = OFF_W2T + (size_t)2 * 128 * 256 * 2;
constexpr size_t OFF_ROPE = OFF_B1 + 2 * 256 * 4;
constexpr size_t OFF_H = al256(OFF_ROPE + (size_t)4096 * 32 * 8);
constexpr size_t OFF_O = OFF_H + (size_t)T * 1024 * 2;
constexpr size_t OFF_MIX = OFF_O + (size_t)T * 1024 * 2;
constexpr size_t OFF_QKV = OFF_MIX + (size_t)T * 1024 * 2;
constexpr size_t SZ_H8 = (size_t)8 * 8 * 4096 * 64 * 2;
constexpr size_t SZ_G2 = (size_t)8 * 2 * 4096 * 64 * 2;
constexpr size_t OFF_QD = OFF_QKV;
constexpr size_t OFF_KD = OFF_QD + SZ_H8;
constexpr size_t OFF_VDT = OFF_KD + SZ_H8;
constexpr size_t OFF_QN = OFF_VDT + SZ_H8;
constexpr size_t OFF_KCT = OFF_QN + SZ_H8;
constexpr size_t OFF_VCT = OFF_KCT + SZ_G2;
constexpr size_t OFF_KS = OFF_VCT + SZ_G2;
constexpr size_t OFF_VST = OFF_KS + SZ_G2;
constexpr size_t OFF_KW = OFF_VST + SZ_G2;
constexpr size_t OFF_VWT = OFF_KW + SZ_G2;
constexpr size_t OFF_GATES = OFF_VWT + SZ_G2;
constexpr size_t OFF_HID = OFF_GATES + (size_t)T * 24 * 4;
constexpr size_t OFF_KCMP = OFF_HID + (size_t)2 * 16 * 256 * 256 * 2;
constexpr size_t OFF_VCMPT = OFF_KCMP + (size_t)16 * 256 * 64 * 2;
constexpr size_t OFF_QKV_END = OFF_VCMPT + (size_t)16 * 256 * 64 * 2;
constexpr size_t OFF_ACT = OFF_QKV;
constexpr size_t OFF_ACT_END = OFF_ACT + (size_t)T * DFF * 2;
constexpr size_t WS_END = OFF_ACT_END > OFF_QKV_END ? OFF_ACT_END : OFF_QKV_END;

struct Params {
    const float* in[21];
    float* out;
    unsigned char* ws;
    int ph_lo, ph_hi;
};

DI unsigned pk_bf16(float a, float b) { f32x2 v = {a, b}; return __builtin_bit_cast(unsigned, __builtin_convertvector(v, bf16v2)); }
DI bf16_t f2bf(float a) { return (bf16_t)(pk_bf16(a, 0.f) & 0xffffu); }
DI float bflo(unsigned u) { return __uint_as_float(u << 16); }
DI float bfhi(unsigned u) { return __uint_as_float(u & 0xffff0000u); }
DI u32x4 pk8(const float (&v)[8]);
DI int crow(int i, int h) { return (i & 3) + 8 * (i >> 2) + 4 * h; }
DI float wave_sum(float v) {
    v += __shfl_xor(v, 32); v += __shfl_xor(v, 16); v += __shfl_xor(v, 8);
    v += __shfl_xor(v, 4); v += __shfl_xor(v, 2); v += __shfl_xor(v, 1);
    return v;
}
DI float fast_exp2(float x) { return __builtin_amdgcn_exp2f(x); }
DI float xhalf_max(float x) { auto rr = __builtin_amdgcn_permlane32_swap(__float_as_uint(x), __float_as_uint(x), false, false); return fmaxf(__uint_as_float(rr[0]), __uint_as_float(rr[1])); }
DI float xhalf_sum(float x) { auto rr = __builtin_amdgcn_permlane32_swap(__float_as_uint(x), __float_as_uint(x), false, false); return __uint_as_float(rr[0]) + __uint_as_float(rr[1]); }
DI float sigmoidf(float x) { return 1.f / (1.f + __expf(-x)); }


#define XB_TMO      128
#define XB_XCNT(j)  (256  + 64 * (j))
#define XB_XSUB(j)  (1280 + 64 * (j))
#define XB_XGEN(j)  (2304 + 64 * (j))
#define XB_TOP      3328
#define XB_TOPGEN   3392
#define XCD_BAR_WORDS 3456
#define XB_SPIN_CAP (1u << 18)
#define LAS __attribute__((address_space(3)))
DI unsigned xb_ld(unsigned* p) { return __hip_atomic_load(p, __ATOMIC_RELAXED, __HIP_MEMORY_SCOPE_AGENT); }
DI unsigned xb_add(unsigned* p, unsigned v) { return __hip_atomic_fetch_add(p, v, __ATOMIC_RELAXED, __HIP_MEMORY_SCOPE_AGENT); }
DI unsigned xb_xcc_id() { return (unsigned)__builtin_amdgcn_s_getreg((3 << 11) | 20) & 0xFu; }
#define XB_SPIN(cond, bar) do { unsigned _sp = 0; while (cond) { __builtin_amdgcn_s_sleep(1); \
    if ((++_sp & 255u) == 0u) { if (xb_ld(&(bar)[XB_TMO])) break; if (_sp > XB_SPIN_CAP) { atomicAdd(&(bar)[XB_TMO], 1u); break; } } } } while (0)
struct XcdBarrier { unsigned* bar; unsigned x; volatile LAS unsigned* st; };
DI XcdBarrier xcd_barrier_post(unsigned* bar, volatile LAS unsigned* st) {
    XcdBarrier b; b.bar = bar; b.x = xb_xcc_id(); b.st = st;
    if (threadIdx.x == 0) (void)xb_add(&bar[XB_XCNT(b.x)], 1u);
    return b;
}
DI void xcd_barrier_complete(unsigned* bar, unsigned x, unsigned& nloc, unsigned& nx) {
    const unsigned G = gridDim.x * gridDim.y * gridDim.z;
    unsigned sum, cnt, mine, sp = 0u;
    for (;;) {
        sum = 0u; cnt = 0u; mine = 0u;
#pragma unroll
        for (unsigned j = 0; j < 16; ++j) { const unsigned c = xb_ld(&bar[XB_XCNT(j)]); sum += c; cnt += (c > 0u) ? 1u : 0u; mine = (j == x) ? c : mine; }
        if (sum == G) break;
        __builtin_amdgcn_s_sleep(1);
        if ((++sp & 255u) == 0u) { if (xb_ld(&bar[XB_TMO])) break; if (sp > XB_SPIN_CAP) { atomicAdd(&bar[XB_TMO], 1u); break; } }
    }
    nloc = mine > 0u ? mine : 1u; nx = cnt > 0u ? cnt : 1u;
}
DI void xcd_barrier(const XcdBarrier& b) {
    asm volatile("s_waitcnt vmcnt(0)" ::: "memory");
    __syncthreads();
    if (threadIdx.x == 0) {
        unsigned* bar = b.bar;
        __builtin_amdgcn_s_waitcnt(0);
        unsigned nloc = b.st[0], nx = b.st[1];
        if (nloc == 0u) { xcd_barrier_complete(bar, b.x, nloc, nx); b.st[0] = nloc; b.st[1] = nx; }
        const unsigned old = xb_add(&bar[XB_XSUB(b.x)], 1u);
        const unsigned gen = old / nloc;
        if (old + 1u == (gen + 1u) * nloc) {
            __builtin_amdgcn_fence(__ATOMIC_RELEASE, "agent");
            asm volatile("s_waitcnt vmcnt(0)" ::: "memory");
            const unsigned og = xb_add(&bar[XB_TOP], 1u);
            const unsigned tg = og / nx;
            if (og + 1u == (tg + 1u) * nx) xb_add(&bar[XB_TOPGEN], 1u);
            else XB_SPIN(xb_ld(&bar[XB_TOPGEN]) == tg, bar);
            __builtin_amdgcn_fence(__ATOMIC_ACQUIRE, "agent");
            xb_add(&bar[XB_XGEN(b.x)], 1u);
            asm volatile("s_waitcnt vmcnt(0)" ::: "memory");
        } else {
            XB_SPIN(xb_ld(&bar[XB_XGEN(b.x)]) == gen, bar);
            __builtin_amdgcn_fence(__ATOMIC_ACQUIRE, "agent");
            asm volatile("s_waitcnt vmcnt(0)" ::: "memory");
        }
    }
    __syncthreads();
}
constexpr int LDS_XB = 2 * 73728;

DI int wdst_row(int n, int mode) {
    int dr = n;
    if (mode == 1 || mode == 2) dr = (n >> 2) * 8 + (n & 3) + (mode == 2 ? 4 : 0);
    else if (mode == 3) {
        const bool rope = (n < 1024) || (n >= 1536 && n < 2176) || (n >= 2304 && n < 2432) || (n >= 2560 && n < 2688);
        if (rope) { const int d = n & 63; dr = (n & ~63) + 8 * ((d & 31) >> 2) + (d & 3) + 4 * (d >> 5); }
    }
    return dr;
}
DI void transpose_tile(const float* __restrict__ src, int K, int N, bf16_t* __restrict__ dst, int ldd, int mode, int tile, float* tl, bool valid) {
    const int nbN = (N + 63) >> 6;
    const int kb = tile / nbN, nb = tile - kb * nbN;
    const int t = VTID;
    if (valid) {
#pragma unroll
        for (int i = 0; i < 4; ++i) {
            const int row = (t >> 4) + 16 * i, c4 = (t & 15) * 4, n = nb * 64 + c4;
            f32x4 v = {0.f, 0.f, 0.f, 0.f};
            if (n < N) v = *(const f32x4*)(src + (size_t)(kb * 64 + row) * N + n);
            float* q = tl + row * 65 + c4;
            q[0] = v[0]; q[1] = v[1]; q[2] = v[2]; q[3] = v[3];
        }
    }
    __syncthreads();
    if (valid) {
        const int nl = t >> 2, kc = (t & 3) * 16, n = nb * 64 + nl;
        if (n < N) {
            float a[8], b[8];
#pragma unroll
            for (int k = 0; k < 8; ++k) { a[k] = tl[(kc + k) * 65 + nl]; b[k] = tl[(kc + 8 + k) * 65 + nl]; }
            bf16_t* d = dst + (size_t)wdst_row(n, mode) * ldd + kb * 64 + kc;
            *(u32x4*)d = pk8(a); *(u32x4*)(d + 8) = pk8(b);
        }
    }
    __syncthreads();
}

DI void phase0(const Params& p, unsigned char* lds) {
    const int tid = VTID, lane = tid & 63, w = tid >> 6;
    const int G = VGRID;
    unsigned char* ws = p.ws;
    float* tl = (float*)(lds + VHALF * HALF_LDS);
    if (VBLK == 0) {
        if (tid < 64) {
            float a = p.in[3][lane] * p.in[4][lane];
            float b = p.in[5][lane] * p.in[6][lane];
            a = wave_sum(a); b = wave_sum(b);
            if (lane == 0) {
                ((float*)(ws + OFF_CTL))[16] = expf(a) - expf(b) + 0.2f;
                ((unsigned*)(ws + OFF_CTL))[0] = 0u; ((unsigned*)(ws + OFF_CTL))[1] = 0u; ((unsigned*)(ws + OFF_CTL))[2] = 0u; ((unsigned*)(ws + OFF_CTL))[3] = 0u;
            }
        }
    }
    {
        const int c0 = 720, c1 = c0 + 256, c2 = c1 + 704, c3 = c2 + 704, c4 = c3 + 704, c5 = c4 + 128, c6 = c5 + 128, c7 = c6 + 4, c8 = c7 + 4;
        for (int tb = 0; tb < c8; tb += G) {
            const bool valid = tb + VBLK < c8; const int t = valid ? tb + VBLK : c8 - 1;
            if (t < c0) transpose_tile(p.in[2], 1024, INC, (bf16_t*)(ws + OFF_WINT), 1024, 3, t, tl, valid);
            else if (t < c1) transpose_tile(p.in[14], 1024, 1024, (bf16_t*)(ws + OFF_WOUTT), 1024, 0, t - c0, tl, valid);
            else if (t < c2) transpose_tile(p.in[17], 1024, DFF, (bf16_t*)(ws + OFF_WGUT), 1024, 1, t - c1, tl, valid);
            else if (t < c3) transpose_tile(p.in[18], 1024, DFF, (bf16_t*)(ws + OFF_WGUT), 1024, 2, t - c2, tl, valid);
            else if (t < c4) transpose_tile(p.in[19], DFF, 1024, (bf16_t*)(ws + OFF_WDT), DFF, 0, t - c3, tl, valid);
            else if (t < c5) transpose_tile(p.in[9], 2048, 256, (bf16_t*)(ws + OFF_W1T), 2048, 0, t - c4, tl, valid);
            else if (t < c6) transpose_tile(p.in[12], 2048, 256, (bf16_t*)(ws + OFF_W1T) + 256 * 2048, 2048, 0, t - c5, tl, valid);
            else if (t < c7) transpose_tile(p.in[10], 256, 64, (bf16_t*)(ws + OFF_W2T), 256, 0, t - c6, tl, valid);
            else transpose_tile(p.in[13], 256, 64, (bf16_t*)(ws + OFF_W2T) + 128 * 256, 256, 0, t - c7, tl, valid);
        }
    }
    for (int t = VBLK; t < 8; t += G) {
        const int kv = t >> 2, cgp = t & 3;
        const float* pos = p.in[kv ? 11 : 8];
        const float* w1 = p.in[kv ? 12 : 9];
        const int c = cgp * 64 + (tid & 63), part = tid >> 6;
        float acc = 0.f;
        for (int k = part * 512; k < part * 512 + 512; ++k) acc += pos[k] * w1[(size_t)k * 256 + c];
        __syncthreads();
        tl[part * 64 + (tid & 63)] = acc;
        __syncthreads();
        if (tid < 64) ((float*)(ws + OFF_B1))[kv * 256 + c] = (tl[tid] + tl[64 + tid]) + (tl[128 + tid] + tl[192 + tid]);
        __syncthreads();
    }
    {
        f32x2* tab = (f32x2*)(ws + OFF_ROPE);
        for (int i = VBLK * 256 + tid; i < 4096 * 32; i += G * 256) {
            const int pos = i >> 5, j = i & 31;
            const float inv = 1.0f / powf(10000.f, (float)(2 * j) / 64.f);
            const float ang = (float)pos * inv;
            f32x2 cs; cs.x = cosf(ang); cs.y = sinf(ang);
            tab[i] = cs;
        }
    }
    {
        const float* x = p.in[0]; const float* g = p.in[1];
        bf16_t* H = (bf16_t*)(ws + OFF_H);
        for (int row = VBLK * 4 + w; row < T; row += G * 4) {
            const float* xr = x + (size_t)row * 1024;
            f32x4 v[4]; float ss = 0.f;
#pragma unroll
            for (int i = 0; i < 4; ++i) { v[i] = *(const f32x4*)(xr + i * 256 + lane * 4); ss += v[i][0] * v[i][0] + v[i][1] * v[i][1] + v[i][2] * v[i][2] + v[i][3] * v[i][3]; }
            ss = wave_sum(ss);
            const float rstd = rsqrtf(ss * (1.f / 1024.f) + NORM_EPS);
#pragma unroll
            for (int i = 0; i < 4; ++i) {
                const f32x4 gg = *(const f32x4*)(g + i * 256 + lane * 4);
                u32x2 o; o.x = pk_bf16(v[i][0] * rstd * gg[0], v[i][1] * rstd * gg[1]); o.y = pk_bf16(v[i][2] * rstd * gg[2], v[i][3] * rstd * gg[3]);
                *(u32x2*)(H + (size_t)row * 1024 + i * 256 + lane * 4) = o;
            }
        }
    }
}

constexpr int GP = 144;
constexpr int GT = 128 * GP;
constexpr int DT = 16384;
constexpr int DSTAGE = 2 * DT;
#define LAS3 __attribute__((address_space(3)))
template <bool SWAP>
DI void gemm_compute(const unsigned char* base, const int (&ao)[4], const int (&bo)[4], f32x16 (&acc)[2][2]) {
#pragma unroll
    for (int s = 0; s < 4; ++s) {
        const bf16x8 a0 = *(const bf16x8*)(base + ao[s]), a1 = *(const bf16x8*)(base + ao[s] + 32 * 128);
        const bf16x8 b0 = *(const bf16x8*)(base + DT + bo[s]), b1 = *(const bf16x8*)(base + DT + bo[s] + 32 * 128);
        if (SWAP) {
            acc[0][0] = MFMA(b0, a0, acc[0][0]); acc[0][1] = MFMA(b1, a0, acc[0][1]);
            acc[1][0] = MFMA(b0, a1, acc[1][0]); acc[1][1] = MFMA(b1, a1, acc[1][1]);
        } else {
            acc[0][0] = MFMA(a0, b0, acc[0][0]); acc[0][1] = MFMA(a0, b1, acc[0][1]);
            acc[1][0] = MFMA(a1, b0, acc[1][0]); acc[1][1] = MFMA(a1, b1, acc[1][1]);
        }
    }
}
DI void gemm_dma(const bf16_t* ga, const bf16_t* gb, int lda, int ldb, int k0, unsigned char* stage_w) {
#pragma unroll
    for (int i = 0; i < 4; ++i) {
        __builtin_amdgcn_global_load_lds((const unsigned*)(ga + (size_t)(32 * i) * lda + k0), (LAS3 unsigned*)(stage_w + i * 4096), 16, 0, 0);
        __builtin_amdgcn_global_load_lds((const unsigned*)(gb + (size_t)(32 * i) * ldb + k0), (LAS3 unsigned*)(stage_w + DT + i * 4096), 16, 0, 0);
    }
}
template <bool SWAP>
DI void gemm_main(const bf16_t* __restrict__ Ag, int lda, const bf16_t* __restrict__ Bg, int ldb, int K, f32x16 (&acc)[2][2], unsigned char* lds, int probe = 0) {
    const int tid = VTID, lane = tid & 63, w = __builtin_amdgcn_readfirstlane(tid >> 6), wr = w >> 1, wc = w & 1, r = lane & 31, h = lane >> 5;
    const int row0 = 8 * w + (lane >> 3), kch = (lane & 7) ^ ((row0 >> 1) & 7);
    const bf16_t* ga = Ag + (size_t)row0 * lda + kch * 8;
    const bf16_t* gb = Bg + (size_t)row0 * ldb + kch * 8;
    unsigned char* st0 = lds + w * 1024;
    unsigned char* st1 = lds + DSTAGE + w * 1024;
    int ao[4], bo[4];
    {
        const int ra = wr * 64 + r, rb = wc * 64 + r;
        const int xa = h ^ ((ra >> 1) & 7), xb = h ^ ((rb >> 1) & 7);
#pragma unroll
        for (int s = 0; s < 4; ++s) { ao[s] = ra * 128 + ((xa ^ (2 * s)) << 4); bo[s] = rb * 128 + ((xb ^ (2 * s)) << 4); }
    }
    const int nk = K >> 6;
    if (probe != 1) gemm_dma(ga, gb, lda, ldb, 0, st0);
    __syncthreads();
    for (int kt = 0; kt < nk; kt += 2) {
        if (probe != 1) gemm_dma(ga, gb, lda, ldb, (kt + 1) * 64, st1);
        if (probe != 2) gemm_compute<SWAP>(lds, ao, bo, acc);
        __syncthreads();
        if (kt + 2 < nk && probe != 1) gemm_dma(ga, gb, lda, ldb, (kt + 2) * 64, st0);
        if (probe != 2) gemm_compute<SWAP>(lds + DSTAGE, ao, bo, acc);
        __syncthreads();
    }
}
DI void zero_acc(f32x16 (&acc)[2][2]) {
#pragma unroll
    for (int a = 0; a < 2; ++a)
#pragma unroll
        for (int b = 0; b < 2; ++b)
#pragma unroll
            for (int i = 0; i < 16; ++i) acc[a][b][i] = 0.f;
}
DI void tile_map(int t, int NT, int& mt, int& nt) {
    const int xcd = t & 7, j = t >> 3;
    const int grp = j / (8 * NT), rem = j - grp * 8 * NT;
    nt = rem >> 3; mt = xcd * 32 + grp * 8 + (rem & 7);
}
constexpr int CP = 132;
template <bool SWAP>
DI void acc_to_lds(const f32x16 (&acc)[2][2], unsigned char* lds) {
    const int lane = VTID & 63, w = VTID >> 6, wr = w >> 1, wc = w & 1, r = lane & 31, h = lane >> 5;
    float* base = (float*)lds + (SWAP ? ((wc * 64 + 4 * h) * CP + wr * 64 + r) : ((wr * 64 + 4 * h) * CP + wc * 64 + r));
#pragma unroll
    for (int mt = 0; mt < 2; ++mt)
#pragma unroll
        for (int nt = 0; nt < 2; ++nt)
#pragma unroll
            for (int i = 0; i < 16; ++i) {
                const int rr = (i & 3) + 8 * (i >> 2);
                if (SWAP) base[(nt * 32 + rr) * CP + mt * 32] = acc[mt][nt][i];
                else base[(mt * 32 + rr) * CP + nt * 32] = acc[mt][nt][i];
            }
}
DI void ld8(const float* q, float (&v)[8]) {
    const f32x4 a = *(const f32x4*)q, b = *(const f32x4*)(q + 4);
    v[0] = a[0]; v[1] = a[1]; v[2] = a[2]; v[3] = a[3]; v[4] = b[0]; v[5] = b[1]; v[6] = b[2]; v[7] = b[3];
}
DI u32x4 pk8(const float (&v)[8]) {
    u32x4 o; o.x = pk_bf16(v[0], v[1]); o.y = pk_bf16(v[2], v[3]); o.z = pk_bf16(v[4], v[5]); o.w = pk_bf16(v[6], v[7]);
    return o;
}
DI void out_plain(const unsigned char* lds, bf16_t* dst, size_t ldd, int nch_log2) {
    const float* Ct = (const float*)lds;
    const int total = 128 << nch_log2;
#pragma unroll 1
    for (int c = VTID; c < total; c += 256) {
        const int a = c >> nch_log2, ch = c & ((1 << nch_log2) - 1);
        float v[8]; ld8(Ct + a * CP + ch * 8, v);
        *(u32x4*)(dst + (size_t)a * ldd + ch * 8) = pk8(v);
    }
}

namespace pg8 {
#define PG8_LAS __attribute__((address_space(3)))
typedef unsigned short bf16_t;
typedef short bf16x8 __attribute__((ext_vector_type(8)));
typedef float f32x4 __attribute__((ext_vector_type(4)));
typedef unsigned u32x4 __attribute__((ext_vector_type(4)));
constexpr int BM = 256, BK = 64, HALF = 128, HTB = HALF * BK * 2  , STAGE_BYTES = 8 * HTB, NXCD = 8, WGM = 8;

__host__ __device__ __forceinline__ int lds_byte(int r, int c) { const int st = (r >> 4) * 2 + (c >> 5), rr = r & 15, cc = c & 31, ob = rr * 64 + cc * 2; return st * 1024 + (ob ^ (((ob >> 9) & 1) << 5)); }
__host__ __device__ __forceinline__ void stage_rc(int b, int& R, int& C) { const int st = b / 1024, sb = b % 1024, swz = sb ^ (((sb >> 9) & 1) << 5); R = (st >> 1) * 16 + swz / 64; C = (st & 1) * 32 + (swz % 64) / 2; }
__host__ __device__ __forceinline__ int perm32(int rho) { const int n = rho >> 4, i = rho & 15; return 8 * (i >> 2) + 4 * n + (i & 3); }

struct Unit { int pm, pn; };
struct Gemm { const bf16_t* A; const bf16_t* Bt; int M, N, K; };

struct StaticOrder {
    int nM, nN, nwg, G, c;
    __host__ __device__ void init(int M, int N, int G_, int c_) { nM = M / BM; nN = N / BM; nwg = nM * nN; G = G_; c = c_; }
    __host__ __device__ bool next(int i, Unit& u) const {
        const long L = (long)i * G + c; if (L >= nwg) return false;
        int wgid = (int)L; { const int q = nwg / NXCD, r = nwg % NXCD, xcd = wgid % NXCD, off = wgid / NXCD; wgid = (xcd < r ? xcd * (q + 1) : r * (q + 1) + (xcd - r) * q) + off; }
        const int nig = WGM * nN, gid = wgid / nig, fm = gid * WGM, gsz = (nM - fm) < WGM ? (nM - fm) : WGM;
        u.pm = fm + ((wgid % nig) % gsz); u.pn = (wgid % nig) / gsz; return true;
    }
    __device__ __forceinline__ void a_ready(const Unit&) const {}
    __device__ __forceinline__ void done(const Unit&) const {}
};

__device__ __forceinline__ unsigned cvt_pk_bf16(float lo, float hi) { unsigned r; asm volatile("v_cvt_pk_bf16_f32 %0, %1, %2" : "=v"(r) : "v"(lo), "v"(hi)); return r; }
typedef float f32x2 __attribute__((ext_vector_type(2)));
template <class Epi, class Sched, bool ALIGN_EPI = false, bool SP2 = false>
__device__ __forceinline__ void gemm_phase(PG8_LAS unsigned char* lds, const Gemm g, const Sched& S, const Epi& E) {
    const int tid = threadIdx.x, wid = __builtin_amdgcn_readfirstlane(tid >> 6), lane = tid & 63, wr = wid >> 2, wc = wid & 3, fr = lane & 15, fq = lane >> 4;
    const int K = g.K, nt = K / BK;
    unsigned voffA[2], voffB[2];
#pragma unroll
    for (int i = 0; i < 2; ++i) { int R, C; stage_rc(tid * 16 + i * 8192, R, C); const int Rb = Epi::PERM ? ((R & ~31) + perm32(R & 31)) : R;
        voffA[i] = (unsigned)(R * K + C) * 2u; voffB[i] = (unsigned)(Rb * K + C) * 2u; }
    const size_t kstep = (size_t)(BK * 2);
    const size_t hstep = (size_t)HALF * K * 2;
    const size_t tstep = 2 * hstep;
    const unsigned ldsw = (unsigned)wid * 1024u;
    const int aoff = lds_byte(wr * 64 + fr, fq * 8), boff = lds_byte(wc * 32 + fr, fq * 8);
#define PG8_SA(b, h) (((b) * 2 + (h)) * HTB)
#define PG8_SB(b, h) ((4 + (b) * 2 + (h)) * HTB)
#define PG8_STAGE(bufoff, gbase, voff) do { _Pragma("unroll") for (int _i = 0; _i < 2; ++_i) \
        __builtin_amdgcn_global_load_lds((const unsigned*)((const char*)(gbase) + (voff)[_i]), (PG8_LAS unsigned*)(lds + (bufoff) + ldsw + _i * 8192), 16, 0, 0); } while (0)
#define PG8_LDA(dst, b, h) do { _Pragma("unroll") for (int m = 0; m < 4; ++m) _Pragma("unroll") for (int k = 0; k < 2; ++k) dst[m][k] = *(const PG8_LAS bf16x8*)(lds + PG8_SA(b, h) + aoff + m * 2048 + k * 1024); } while (0)
#define PG8_LDB(dst, b, h) do { _Pragma("unroll") for (int n = 0; n < 2; ++n) _Pragma("unroll") for (int k = 0; k < 2; ++k) dst[n][k] = *(const PG8_LAS bf16x8*)(lds + PG8_SB(b, h) + boff + n * 2048 + k * 1024); } while (0)
#define PG8_MMA(ai, bj, At, Bt) do { __builtin_amdgcn_s_setprio(1); _Pragma("unroll") for (int m = 0; m < 4; ++m) _Pragma("unroll") for (int n = 0; n < 2; ++n) _Pragma("unroll") for (int k = 0; k < 2; ++k) \
        acc[ai][bj][m][n] = __builtin_amdgcn_mfma_f32_16x16x32_bf16(Bt[n][k], At[m][k], acc[ai][bj][m][n], 0, 0, 0); __builtin_amdgcn_s_setprio(0); } while (0)
#define PG8_WAIT_V(n) asm volatile("s_waitcnt vmcnt(" #n ")" ::: "memory")
#define PG8_WAIT_L(n) asm volatile("s_waitcnt lgkmcnt(" #n ")" ::: "memory")
#define PG8_BAR __builtin_amdgcn_s_barrier()
#define PG8_SCHED __builtin_amdgcn_sched_barrier(0)
    Unit cur, nxt; int ui = 0;
    if (!S.next(0, cur)) return;
    f32x4 acc[2][2][4][2];
#pragma unroll
    for (int a = 0; a < 2; ++a)
#pragma unroll
        for (int b = 0; b < 2; ++b)
#pragma unroll
            for (int m = 0; m < 4; ++m)
#pragma unroll
                for (int n = 0; n < 2; ++n) acc[a][b][m][n] = (f32x4){0.f, 0.f, 0.f, 0.f};
    bf16x8 At[4][2], B0[2][2], B1[2][2];
    const char* cA = (const char*)g.A + (size_t)cur.pm * tstep; const char* cB = (const char*)g.Bt + (size_t)cur.pn * tstep;
    S.a_ready(cur);
    if constexpr (SP2) {
        PG8_STAGE(PG8_SB(0, 0), cB, voffB); PG8_STAGE(PG8_SB(0, 1), cB + hstep, voffB); PG8_STAGE(PG8_SA(0, 0), cA, voffA); PG8_STAGE(PG8_SA(0, 1), cA + hstep, voffA);
        if (wr == 1) PG8_BAR;
        PG8_WAIT_V(2); PG8_BAR;
        PG8_STAGE(PG8_SB(1, 0), cB + kstep, voffB); PG8_STAGE(PG8_SA(1, 0), cA + kstep, voffA); PG8_STAGE(PG8_SB(1, 1), cB + hstep + kstep, voffB);
        PG8_WAIT_V(6); PG8_BAR;
    } else {
        PG8_STAGE(PG8_SB(0, 0), cB, voffB); PG8_STAGE(PG8_SA(0, 0), cA, voffA); PG8_STAGE(PG8_SB(0, 1), cB + hstep, voffB); PG8_STAGE(PG8_SA(0, 1), cA + hstep, voffA);
        if (wr == 1) PG8_BAR;
        PG8_WAIT_V(4); PG8_BAR;
        PG8_STAGE(PG8_SB(1, 0), cB + kstep, voffB); PG8_STAGE(PG8_SA(1, 0), cA + kstep, voffA); PG8_STAGE(PG8_SB(1, 1), cB + hstep + kstep, voffB);
        PG8_WAIT_V(6); PG8_BAR;
    }
    for (;;) {
        const bool has_next = S.next(ui + 1, nxt);
        const char* nA = has_next ? (const char*)g.A + (size_t)nxt.pm * tstep : cA; const char* nB = has_next ? (const char*)g.Bt + (size_t)nxt.pn * tstep : cB;
        for (int t = 0; t < nt; t += 2) {
            const bool last = (t == nt - 2);
            const char* a1 = cA + (size_t)(t + 1) * kstep;
            const char* a2 = last ? nA : cA + (size_t)(t + 2) * kstep; const char* b2 = last ? nB : cB + (size_t)(t + 2) * kstep;
            const char* a3 = a2 + kstep; const char* b3 = b2 + kstep;
            if (last && has_next) S.a_ready(nxt);
            if constexpr (SP2) {
            PG8_LDB(B0, 0, 0); PG8_LDB(B1, 0, 1); PG8_SCHED; PG8_LDA(At, 0, 0); PG8_STAGE(PG8_SA(1, 1), a1 + hstep, voffA);
            PG8_WAIT_V(8); PG8_WAIT_L(0); PG8_BAR; PG8_MMA(0, 0, At, B0); PG8_MMA(0, 1, At, B1); PG8_BAR; PG8_SCHED;
            PG8_LDA(At, 0, 1); PG8_STAGE(PG8_SB(0, 0), b2, voffB); PG8_STAGE(PG8_SB(0, 1), b2 + hstep, voffB); PG8_STAGE(PG8_SA(0, 0), a2, voffA);
            PG8_WAIT_V(8); PG8_WAIT_L(0); PG8_BAR; PG8_MMA(1, 0, At, B0); PG8_MMA(1, 1, At, B1); PG8_BAR; PG8_SCHED;
            PG8_LDB(B0, 1, 0); PG8_LDB(B1, 1, 1); PG8_SCHED; PG8_LDA(At, 1, 0); PG8_STAGE(PG8_SA(0, 1), a2 + hstep, voffA);
            PG8_WAIT_V(8); PG8_WAIT_L(0); PG8_BAR; PG8_MMA(0, 0, At, B0); PG8_MMA(0, 1, At, B1); PG8_BAR; PG8_SCHED;
            PG8_LDA(At, 1, 1); PG8_STAGE(PG8_SB(1, 0), b3, voffB); PG8_STAGE(PG8_SB(1, 1), b3 + hstep, voffB); PG8_STAGE(PG8_SA(1, 0), a3, voffA);
            PG8_WAIT_V(8); PG8_WAIT_L(0); PG8_BAR; PG8_MMA(1, 0, At, B0); PG8_MMA(1, 1, At, B1); PG8_BAR; PG8_SCHED;
            } else {
            PG8_LDB(B0, 0, 0); PG8_SCHED; PG8_LDA(At, 0, 0); PG8_STAGE(PG8_SA(1, 1), a1 + hstep, voffA);
            PG8_WAIT_L(8); PG8_BAR; PG8_WAIT_L(0); PG8_MMA(0, 0, At, B0); PG8_BAR; PG8_SCHED;
            PG8_LDB(B1, 0, 1); PG8_STAGE(PG8_SB(0, 0), b2, voffB);
            PG8_BAR; PG8_WAIT_L(0); PG8_MMA(0, 1, At, B1); PG8_BAR;
            PG8_LDA(At, 0, 1); PG8_STAGE(PG8_SA(0, 0), a2, voffA);
            PG8_BAR; PG8_WAIT_L(0); PG8_MMA(1, 0, At, B0); PG8_BAR; PG8_SCHED;
            PG8_STAGE(PG8_SB(0, 1), b2 + hstep, voffB);
            PG8_WAIT_V(6); PG8_BAR; PG8_MMA(1, 1, At, B1); PG8_BAR;
            PG8_LDB(B0, 1, 0); PG8_SCHED; PG8_LDA(At, 1, 0); PG8_STAGE(PG8_SA(0, 1), a2 + hstep, voffA);
            PG8_WAIT_L(8); PG8_BAR; PG8_WAIT_L(0); PG8_MMA(0, 0, At, B0); PG8_BAR; PG8_SCHED;
            PG8_LDB(B1, 1, 1); PG8_STAGE(PG8_SB(1, 0), b3, voffB);
            PG8_BAR; PG8_WAIT_L(0); PG8_MMA(0, 1, At, B1); PG8_BAR;
            PG8_LDA(At, 1, 1); PG8_STAGE(PG8_SA(1, 0), a3, voffA);
            PG8_BAR; PG8_WAIT_L(0); PG8_MMA(1, 0, At, B0); PG8_BAR; PG8_SCHED;
            PG8_STAGE(PG8_SB(1, 1), b3 + hstep, voffB);
            PG8_WAIT_V(6); PG8_BAR; PG8_MMA(1, 1, At, B1); PG8_BAR;
            }
        }
        if constexpr (ALIGN_EPI) { if (wr == 0) PG8_BAR; }
        if constexpr (!Epi::AFTER_DRAIN) { E(acc, cur, wr, wc, fr, fq); S.done(cur); }
        if (!has_next) break;
#pragma unroll
        for (int a = 0; a < 2; ++a)
#pragma unroll
            for (int b = 0; b < 2; ++b)
#pragma unroll
                for (int m = 0; m < 4; ++m)
#pragma unroll
                    for (int n = 0; n < 2; ++n) acc[a][b][m][n] = (f32x4){0.f, 0.f, 0.f, 0.f};
        cur = nxt; cA = nA; cB = nB; ++ui;
        if constexpr (ALIGN_EPI) { if (wr == 1) PG8_BAR; }
    }
    PG8_WAIT_V(0);
    if constexpr (!ALIGN_EPI) { if (wr == 0) PG8_BAR; }
    PG8_BAR;
    if constexpr (Epi::AFTER_DRAIN) { E.fused(acc, cur, wr, wc, fr, fq, lds, wid, lane); S.done(cur); }
#undef PG8_SA
#undef PG8_SB
#undef PG8_STAGE
#undef PG8_LDA
#undef PG8_LDB
#undef PG8_MMA
#undef PG8_WAIT_V
#undef PG8_WAIT_L
#undef PG8_BAR
#undef PG8_SCHED
}


struct EpiPlain {
    static constexpr bool PERM = true, AFTER_DRAIN = false;
    bf16_t* O; int ldc;
    __device__ __forceinline__ void operator()(const f32x4 (&acc)[2][2][4][2], const Unit& u, int wr, int wc, int fr, int fq) const {
        bf16_t* base = O + (size_t)(u.pm * BM + wr * 64 + fr) * ldc + u.pn * BM + wc * 32 + 8 * fq;
#pragma unroll
        for (int ai = 0; ai < 2; ++ai)
#pragma unroll
            for (int m = 0; m < 4; ++m) {
                bf16_t* rowp = base + (size_t)(ai * HALF + m * 16) * ldc;
#pragma unroll
                for (int bj = 0; bj < 2; ++bj) {
                    const f32x4 v0 = acc[ai][bj][m][0], v1 = acc[ai][bj][m][1];
                    u32x4 w; w.x = cvt_pk_bf16(v0[0], v0[1]); w.y = cvt_pk_bf16(v0[2], v0[3]); w.z = cvt_pk_bf16(v1[0], v1[1]); w.w = cvt_pk_bf16(v1[2], v1[3]);
                    *(u32x4*)(rowp + bj * HALF) = w;
                }
            }
    }
};
struct EpiSwiGLU {
    static constexpr bool PERM = true, AFTER_DRAIN = false;
    bf16_t* ACT; int ldc;
    __device__ __forceinline__ void operator()(const f32x4 (&acc)[2][2][4][2], const Unit& u, int wr, int wc, int fr, int fq) const {
        bf16_t* base = ACT + (size_t)(u.pm * BM + wr * 64 + fr) * ldc + ((u.pn * BM + wc * 32 + 8 * fq) >> 1);
#pragma unroll
        for (int ai = 0; ai < 2; ++ai)
#pragma unroll
            for (int m = 0; m < 4; ++m) {
                bf16_t* rowp = base + (size_t)(ai * HALF + m * 16) * ldc;
#pragma unroll
                for (int bj = 0; bj < 2; ++bj) {
                    const f32x4 g = acc[ai][bj][m][0], up = acc[ai][bj][m][1];
                    float a[4];
#pragma unroll
                    for (int e = 0; e < 4; ++e) a[e] = g[e] * __builtin_amdgcn_rcpf(1.f + __expf(-g[e])) * up[e];
                    typedef unsigned u32x2v __attribute__((ext_vector_type(2)));
                    u32x2v w; w.x = cvt_pk_bf16(a[0], a[1]); w.y = cvt_pk_bf16(a[2], a[3]);
                    *(u32x2v*)(rowp + bj * (HALF / 2)) = w;
                }
            }
    }
};
struct EpiInproj {
    static constexpr bool PERM = true, AFTER_DRAIN = false;
    unsigned char* ws; size_t off_qd, off_kd, off_vdt, off_qn, off_kct, off_vct, off_ks, off_vst, off_kw, off_vwt, off_gates, off_rope;
    __device__ __forceinline__ void operator()(const f32x4 (&acc)[2][2][4][2], const Unit& u, int wr, int wc, int fr, int fq) const {
        typedef unsigned u32x2v __attribute__((ext_vector_type(2)));
        typedef float f32x2v __attribute__((ext_vector_type(2)));
        const int row0 = u.pm * BM + wr * 64 + fr;
        const int b = row0 >> 12, pos0 = row0 & 4095;
#pragma unroll
        for (int bj = 0; bj < 2; ++bj) {
            const int cb = u.pn * BM + bj * HALF;
            const int cl = wc * 32 + 8 * fq;
            int kind = 4; size_t off = 0; int hidx = 0;
            if (cb < 512) { kind = 0; off = off_qd; hidx = b * 8 + ((cb + cl) >> 6); }
            else if (cb < 1024) { kind = 0; off = off_kd; hidx = b * 8 + ((cb - 512 + cl) >> 6); }
            else if (cb < 1536) { kind = 2; off = off_vdt; hidx = b * 4 + ((cb - 1024) >> 7); }
            else if (cb < 2048) { kind = 0; off = off_qn; hidx = b * 8 + ((cb - 1536 + cl) >> 6); }
            else if (cb == 2048) { kind = 0; off = off_kct; hidx = b * 2 + (cl >> 6); }
            else if (cb == 2176) { kind = 1; off = off_vct; hidx = b * 2 + (cl >> 6); }
            else if (cb == 2304) { kind = 0; off = off_ks; hidx = b * 2 + (cl >> 6); }
            else if (cb == 2432) { kind = 3; off = off_vst; hidx = b * 2 + (cl >> 6); }
            else if (cb == 2560) { kind = 0; off = off_kw; hidx = b * 2 + (cl >> 6); }
            else if (cb == 2688) { kind = 3; off = off_vwt; hidx = b * 2 + (cl >> 6); }
            else if (cb == 2816) kind = 5;
            if (kind == 0) {
                const int g4 = 4 * (((cl & 63) >> 3));
                bf16_t* dst = (bf16_t*)(ws + off) + ((size_t)hidx * 4096 + pos0) * 64 + g4;
                const f32x2v* tab = (const f32x2v*)(ws + off_rope) + (size_t)pos0 * 32 + g4;
#pragma unroll
                for (int ai = 0; ai < 2; ++ai)
#pragma unroll
                    for (int m = 0; m < 4; ++m) {
                        const int dp = ai * HALF + m * 16;
                        const f32x4 x1 = acc[ai][bj][m][0], x2 = acc[ai][bj][m][1];
                        const f32x4 t01 = *(const f32x4*)(tab + (size_t)dp * 32), t23 = *(const f32x4*)(tab + (size_t)dp * 32 + 2);
                        const float c0 = t01[0], s0 = t01[1], c1 = t01[2], s1 = t01[3], c2 = t23[0], s2 = t23[1], c3 = t23[2], s3 = t23[3];
                        u32x2v lo, hi;
                        lo.x = cvt_pk_bf16(x1[0] * c0 - x2[0] * s0, x1[1] * c1 - x2[1] * s1); lo.y = cvt_pk_bf16(x1[2] * c2 - x2[2] * s2, x1[3] * c3 - x2[3] * s3);
                        hi.x = cvt_pk_bf16(x1[0] * s0 + x2[0] * c0, x1[1] * s1 + x2[1] * c1); hi.y = cvt_pk_bf16(x1[2] * s2 + x2[2] * c2, x1[3] * s3 + x2[3] * c3);
                        *(u32x2v*)(dst + (size_t)dp * 64) = lo; *(u32x2v*)(dst + (size_t)dp * 64 + 32) = hi;
                    }
            } else if (kind == 1) {
                bf16_t* dst = (bf16_t*)(ws + off) + ((size_t)hidx * 4096 + pos0) * 64 + (cl & 63);
#pragma unroll
                for (int ai = 0; ai < 2; ++ai)
#pragma unroll
                    for (int m = 0; m < 4; ++m) {
                        const f32x4 v0 = acc[ai][bj][m][0], v1 = acc[ai][bj][m][1];
                        u32x4 w; w.x = cvt_pk_bf16(v0[0], v0[1]); w.y = cvt_pk_bf16(v0[2], v0[3]); w.z = cvt_pk_bf16(v1[0], v1[1]); w.w = cvt_pk_bf16(v1[2], v1[3]);
                        *(u32x4*)(dst + (size_t)(ai * HALF + m * 16) * 64) = w;
                    }
            } else if (kind == 2 || kind == 3) {
                const int dv = (kind == 2) ? 128 : 64;
                const int e0 = (kind == 2) ? cl : (cl & 63);
#pragma unroll
                for (int ai = 0; ai < 2; ++ai) {
                    const int pa = pos0 + ai * HALF;
                    bf16_t* dst = (bf16_t*)(ws + off) + (((size_t)hidx * 64 + (pa >> 6)) * dv + e0) * 64 + (pa & 63);
#pragma unroll
                    for (int m = 0; m < 4; ++m)
#pragma unroll
                        for (int n = 0; n < 2; ++n)
#pragma unroll
                            for (int j = 0; j < 4; ++j) {
                                const unsigned pk = cvt_pk_bf16(acc[ai][bj][m][n][j], 0.f);
                                dst[(4 * n + j) * 64 + 16 * m] = (bf16_t)(pk & 0xffffu);
                            }
                }
            } else if (kind == 5) {
                if (wc == 0 && fq < 3) {
                    float* gates = (float*)(ws + off_gates) + (size_t)row0 * 24 + 8 * fq;
#pragma unroll
                    for (int ai = 0; ai < 2; ++ai)
#pragma unroll
                        for (int m = 0; m < 4; ++m) {
                            f32x4 a = acc[ai][bj][m][0], c = acc[ai][bj][m][1];
#pragma unroll
                            for (int e = 0; e < 4; ++e) { a[e] = 1.f / (1.f + __expf(-a[e])); c[e] = 1.f / (1.f + __expf(-c[e])); }
                            float* gp = gates + (size_t)(ai * HALF + m * 16) * 24;
                            *(f32x4*)gp = a; *(f32x4*)(gp + 4) = c;
                        }
                }
            }
        }
    }
};
}

DI void epi_inproj(const Params& p, const unsigned char* lds, int m0, int n0) {
    unsigned char* ws = p.ws;
    const float* Ct = (const float*)lds;
    const int b = m0 >> 12, pos0 = m0 & 4095;
    int tid = VTID; asm volatile("" : "+v"(tid));
    if (n0 == 2816) {
        float* gates = (float*)(ws + OFF_GATES);
#pragma unroll 1
        for (int c = tid; c < 128 * 3; c += 256) {
            const int a = c / 3, ch = c - a * 3;
            float v[8]; ld8(Ct + a * CP + ch * 8, v);
            f32x4 o0, o1;
            o0[0] = sigmoidf(v[0]); o0[1] = sigmoidf(v[1]); o0[2] = sigmoidf(v[2]); o0[3] = sigmoidf(v[3]);
            o1[0] = sigmoidf(v[4]); o1[1] = sigmoidf(v[5]); o1[2] = sigmoidf(v[6]); o1[3] = sigmoidf(v[7]);
            float* g = gates + (size_t)(m0 + a) * 24 + ch * 8;
            *(f32x4*)g = o0; *(f32x4*)(g + 4) = o1;
        }
        return;
    }
    const bool tr = (n0 >= 1024 && n0 < 1536) || n0 == 2432 || n0 == 2688;
    if (tr) {
        bf16_t* dst; int hshift, hbase, nbase;
        if (n0 < 1536) { dst = (bf16_t*)(ws + OFF_VDT); hshift = 7; hbase = b * 4; nbase = 1024; }
        else if (n0 == 2432) { dst = (bf16_t*)(ws + OFF_VST); hshift = 6; hbase = b * 2; nbase = 2432; }
        else { dst = (bf16_t*)(ws + OFF_VWT); hshift = 6; hbase = b * 2; nbase = 2688; }
#pragma unroll 1
        for (int c = tid; c < 2048; c += 256) {
            const int a = c >> 4, ch = c & 15;
            const int cr = n0 + a - nbase;
            const int hidx = hbase + (cr >> hshift), e = cr & ((1 << hshift) - 1);
            float v[8]; ld8(Ct + a * CP + ch * 8, v);
            const int pos = pos0 + ch * 8;
            *(u32x4*)(dst + ((((size_t)hidx * 64 + (pos >> 6)) << hshift) + e) * 64 + (pos & 63)) = pk8(v);
        }
        return;
    }
    if (n0 == 2176) {
        bf16_t* dst = (bf16_t*)(ws + OFF_VCT);
#pragma unroll 1
        for (int c = tid; c < 2048; c += 256) {
            const int a = c >> 4, ch = c & 15;
            const int hidx = b * 2 + (ch >> 3);
            float v[8]; ld8(Ct + a * CP + ch * 8, v);
            *(u32x4*)(dst + ((size_t)hidx * 4096 + pos0 + a) * 64 + (ch & 7) * 8) = pk8(v);
        }
        return;
    }
    {
        bf16_t* dst; int hbase;
        if (n0 < 512) { dst = (bf16_t*)(ws + OFF_QD); hbase = b * 8 + (n0 >> 6); }
        else if (n0 < 1024) { dst = (bf16_t*)(ws + OFF_KD); hbase = b * 8 + ((n0 - 512) >> 6); }
        else if (n0 < 2048) { dst = (bf16_t*)(ws + OFF_QN); hbase = b * 8 + ((n0 - 1536) >> 6); }
        else if (n0 == 2048) { dst = (bf16_t*)(ws + OFF_KCT); hbase = b * 2; }
        else if (n0 == 2304) { dst = (bf16_t*)(ws + OFF_KS); hbase = b * 2; }
        else { dst = (bf16_t*)(ws + OFF_KW); hbase = b * 2; }
        const float* tab = (const float*)(ws + OFF_ROPE);
#pragma unroll 1
        for (int c = tid; c < 1024; c += 256) {
            const int a = c >> 3, hd = (c >> 2) & 1, cc = c & 3;
            float x1[8], x2[8], cs[16];
            ld8(Ct + a * CP + hd * 64 + cc * 8, x1); ld8(Ct + a * CP + hd * 64 + 32 + cc * 8, x2);
            const int pos = pos0 + a;
            const float* tp = tab + ((size_t)pos * 32 + cc * 8) * 2;
            {
                const f32x4 t0 = *(const f32x4*)tp, t1 = *(const f32x4*)(tp + 4), t2 = *(const f32x4*)(tp + 8), t3 = *(const f32x4*)(tp + 12);
                cs[0] = t0[0]; cs[1] = t0[1]; cs[2] = t0[2]; cs[3] = t0[3]; cs[4] = t1[0]; cs[5] = t1[1]; cs[6] = t1[2]; cs[7] = t1[3];
                cs[8] = t2[0]; cs[9] = t2[1]; cs[10] = t2[2]; cs[11] = t2[3]; cs[12] = t3[0]; cs[13] = t3[1]; cs[14] = t3[2]; cs[15] = t3[3];
            }
            float y1[8], y2[8];
#pragma unroll
            for (int e = 0; e < 8; ++e) { const float cv = cs[2 * e], sv = cs[2 * e + 1]; y1[e] = x1[e] * cv - x2[e] * sv; y2[e] = x1[e] * sv + x2[e] * cv; }
            bf16_t* d = dst + ((size_t)(hbase + hd) * 4096 + pos) * 64 + cc * 8;
            *(u32x4*)d = pk8(y1); *(u32x4*)(d + 32) = pk8(y2);
        }
    }
}
DI void phase1(const Params& p, unsigned char* lds) {
    pg8::Gemm g; g.A = (const bf16_t*)(p.ws + OFF_H); g.Bt = (const bf16_t*)(p.ws + OFF_WINT); g.M = T; g.N = INP; g.K = 1024;
    pg8::StaticOrder S; S.init(T, INP, (int)gridDim.x, (int)blockIdx.x);
    pg8::EpiInproj E; E.ws = p.ws; E.off_qd = OFF_QD; E.off_kd = OFF_KD; E.off_vdt = OFF_VDT; E.off_qn = OFF_QN; E.off_kct = OFF_KCT; E.off_vct = OFF_VCT;
    E.off_ks = OFF_KS; E.off_vst = OFF_VST; E.off_kw = OFF_KW; E.off_vwt = OFF_VWT; E.off_gates = OFF_GATES; E.off_rope = OFF_ROPE;
    pg8::gemm_phase<pg8::EpiInproj, pg8::StaticOrder, true, true>((PG8_LAS unsigned char*)lds, g, S, E);
    __syncthreads();
}

DI void phase2(const Params& p, unsigned char* lds) {
    unsigned char* hl = lds + VHALF * HALF_LDS;
    for (int t = blockIdx.x; t < 128; t += gridDim.x) {
        const int kv = t >> 6, bg = (t >> 2) & 15, mt = (t >> 1) & 1, nt = t & 1, kh = VHALF * 1024;
        const bf16_t* A = (const bf16_t*)(p.ws + (kv ? OFF_VCT : OFF_KCT)) + (size_t)bg * 4096 * 64 + (size_t)mt * 128 * 1024 + kh;
        const bf16_t* B = (const bf16_t*)(p.ws + OFF_W1T) + (size_t)kv * 256 * 2048 + (size_t)nt * 128 * 2048 + kh;
        f32x16 acc[2][2]; zero_acc(acc);
        gemm_main<false>(A, 1024, B, 2048, 1024, acc, hl);
        acc_to_lds<false>(acc, hl);
        __syncthreads();
        const float* b1 = (const float*)(p.ws + OFF_B1) + kv * 256 + nt * 128;
        bf16_t* HID = (bf16_t*)(p.ws + OFF_HID) + (size_t)(kv * 16 + bg) * 65536 + (size_t)mt * 128 * 256 + nt * 128;
        const float* C0 = (const float*)lds; const float* C1 = (const float*)(lds + HALF_LDS);
#pragma unroll 1
        for (int c = threadIdx.x; c < 2048; c += 512) {
            const int a = c >> 4, ch = c & 15;
            float v[8], v2[8], bb[8]; ld8(C0 + a * CP + ch * 8, v); ld8(C1 + a * CP + ch * 8, v2); ld8(b1 + ch * 8, bb);
#pragma unroll
            for (int e = 0; e < 8; ++e) { const float z = (v[e] + v2[e]) + bb[e]; v[e] = z * sigmoidf(z); }
            *(u32x4*)(HID + (size_t)a * 256 + ch * 8) = pk8(v);
        }
        __syncthreads();
    }
}
DI void phase3(const Params& p, unsigned char* lds) {
    unsigned char* hl = lds + VHALF * HALF_LDS;
    for (int t = blockIdx.x; t < 64; t += gridDim.x) {
        const int kv = t >> 5, bg = (t >> 1) & 15, mt = t & 1, kh = VHALF * 128;
        const bf16_t* A = (const bf16_t*)(p.ws + OFF_HID) + (size_t)(kv * 16 + bg) * 65536 + (size_t)mt * 128 * 256 + kh;
        const bf16_t* B = (const bf16_t*)(p.ws + OFF_W2T) + (size_t)kv * 128 * 256 + kh;
        f32x16 acc[2][2]; zero_acc(acc);
        if (kv == 0) { gemm_main<false>(A, 256, B, 256, 128, acc, hl); acc_to_lds<false>(acc, hl); }
        else { gemm_main<true>(A, 256, B, 256, 128, acc, hl); acc_to_lds<true>(acc, hl); }
        __syncthreads();
        const float* C0 = (const float*)lds; const float* C1 = (const float*)(lds + HALF_LDS);
        if (kv == 0) {
            bf16_t* KC = (bf16_t*)(p.ws + OFF_KCMP) + (size_t)bg * 256 * 64 + (size_t)mt * 128 * 64;
#pragma unroll 1
            for (int c = threadIdx.x; c < 128 * 8; c += 512) {
                const int a = c >> 3, ch = c & 7;
                float v[8], v2[8]; ld8(C0 + a * CP + ch * 8, v); ld8(C1 + a * CP + ch * 8, v2);
#pragma unroll
                for (int e = 0; e < 8; ++e) v[e] += v2[e];
                *(u32x4*)(KC + (size_t)a * 64 + ch * 8) = pk8(v);
            }
        } else {
            bf16_t* VC = (bf16_t*)(p.ws + OFF_VCMPT) + (size_t)bg * 64 * 256;
#pragma unroll 1
            for (int c = threadIdx.x; c < 64 * 16; c += 512) {
                const int a = c >> 4, ch = c & 15;
                const int n = mt * 128 + ch * 8;
                float v[8], v2[8]; ld8(C0 + a * CP + ch * 8, v); ld8(C1 + a * CP + ch * 8, v2);
#pragma unroll
                for (int e = 0; e < 8; ++e) v[e] += v2[e];
                *(u32x4*)(VC + ((size_t)(n >> 6) * 64 + a) * 64 + (n & 63)) = pk8(v);
            }
        }
        __syncthreads();
    }
}

constexpr int KP = 144;
constexpr int VP = 144;
constexpr int KT_BYTES = 64 * KP;
constexpr float SM_C = 0.125f * 1.4426950408889634f;
#define NEG_INF (-__builtin_inff())

template <int DV> struct KVStage { u32x4 k[1]; u32x4 v[DV / 64]; };

template <int DV, bool HAS_V>
DI void kv_gload(KVStage<DV>& st, const bf16_t* __restrict__ Kb, const bf16_t* __restrict__ VTb, int ldv, int key0) {
    const int tid = threadIdx.x;
    st.k[0] = *(const u32x4*)(Kb + (size_t)(key0 + (tid >> 3)) * 64 + (tid & 7) * 8);
    if (HAS_V) {
#pragma unroll
        for (int i = 0; i < DV / 64; ++i) { const int c = tid + 512 * i; st.v[i] = *(const u32x4*)(VTb + (size_t)(key0 >> 6) * (DV * 64) + c * 8); }
    }
}
template <int DV, bool HAS_V>
DI void kv_sstore(const KVStage<DV>& st, unsigned char* buf) {
    const int tid = threadIdx.x;
    *(u32x4*)(buf + (tid >> 3) * KP + (tid & 7) * 16) = st.k[0];
    if (HAS_V) {
#pragma unroll
        for (int i = 0; i < DV / 64; ++i) {
            const int c = tid + 512 * i, kc = c & 7; unsigned char* q = buf + KT_BYTES + (c >> 3) * VP + (kc >> 1) * 32 + (kc & 1) * 8;
            u32x2 lo, hi; lo.x = st.v[i].x; lo.y = st.v[i].y; hi.x = st.v[i].z; hi.y = st.v[i].w;
            *(u32x2*)q = lo; *(u32x2*)(q + 16) = hi;
        }
    }
}
template <int DV, bool HAS_V, class Next, class Body>
DI void kv_loop(unsigned char* lds, const bf16_t* Kb, const bf16_t* VTb, int ldv, int nt, int j0, Next next, Body body, int probe = 0) {
    constexpr int SB = KT_BYTES + (HAS_V ? DV * VP : 0);
    KVStage<DV> st;
    int jn = j0;
    if (probe != 1) { kv_gload<DV, HAS_V>(st, Kb, VTb, ldv, jn * 64); kv_sstore<DV, HAS_V>(st, lds); }
    __syncthreads();
    for (int i = 0; i < nt; ++i) {
        const int j = jn;
        const bool more = (i + 1 < nt);
        if (more) { jn = next(j); if (probe != 1) kv_gload<DV, HAS_V>(st, Kb, VTb, ldv, jn * 64); }
        if (probe != 2) body(j, (const unsigned char*)(lds + (i & 1) * SB));
        if (more && probe != 1) kv_sstore<DV, HAS_V>(st, lds + ((i + 1) & 1) * SB);
        __syncthreads();
    }
}
DI void attn_scores(const unsigned char* kb, const bf16x8 (&qf)[4], int r, int h, f32x16& s0, f32x16& s1) {
#pragma unroll
    for (int i = 0; i < 16; ++i) { s0[i] = 0.f; s1[i] = 0.f; }
#pragma unroll
    for (int s = 0; s < 4; ++s) {
        const bf16x8 k0 = *(const bf16x8*)(kb + r * KP + s * 32 + h * 16);
        const bf16x8 k1 = *(const bf16x8*)(kb + (32 + r) * KP + s * 32 + h * 16);
        s0 = MFMA(k0, qf[s], s0); s1 = MFMA(k1, qf[s], s1);
    }
}
DI void pack_p(const f32x16& p0, const f32x16& p1, bf16x8 (&pf)[2][2]) {
#pragma unroll
    for (int sp = 0; sp < 2; ++sp) {
        u32x4 a, b;
        a.x = pk_bf16(p0[8 * sp + 0], p0[8 * sp + 1]); a.y = pk_bf16(p0[8 * sp + 2], p0[8 * sp + 3]);
        a.z = pk_bf16(p0[8 * sp + 4], p0[8 * sp + 5]); a.w = pk_bf16(p0[8 * sp + 6], p0[8 * sp + 7]);
        b.x = pk_bf16(p1[8 * sp + 0], p1[8 * sp + 1]); b.y = pk_bf16(p1[8 * sp + 2], p1[8 * sp + 3]);
        b.z = pk_bf16(p1[8 * sp + 4], p1[8 * sp + 5]); b.w = pk_bf16(p1[8 * sp + 6], p1[8 * sp + 7]);
        pf[0][sp] = __builtin_bit_cast(bf16x8, a); pf[1][sp] = __builtin_bit_cast(bf16x8, b);
    }
}
template <int DV>
DI void attn_pv(const unsigned char* vb, const bf16x8 (&pf)[2][2], int r, int h, f32x16 (&o)[DV / 32]) {
#pragma unroll
    for (int dt = 0; dt < DV / 32; ++dt)
#pragma unroll
        for (int mt = 0; mt < 2; ++mt)
#pragma unroll
            for (int sp = 0; sp < 2; ++sp) {
                const bf16x8 vf = *(const bf16x8*)(vb + (dt * 32 + r) * VP + (2 * mt + sp) * 32 + h * 16);
                o[dt] = MFMA(vf, pf[mt][sp], o[dt]);
            }
}
constexpr float SM_THR = 7.2f;
typedef float f32x8 __attribute__((ext_vector_type(8)));
DI float hsum16(const f32x16& v) {
    const f32x8 a = __builtin_shufflevector(v, v, 0, 1, 2, 3, 4, 5, 6, 7) + __builtin_shufflevector(v, v, 8, 9, 10, 11, 12, 13, 14, 15);
    const f32x4 b = __builtin_shufflevector(a, a, 0, 1, 2, 3) + __builtin_shufflevector(a, a, 4, 5, 6, 7);
    return (b[0] + b[1]) + (b[2] + b[3]);
}
template <int DV>
DI void attn_softmax_pv(f32x16& s0, f32x16& s1, float& m, float& l, f32x16 (&o)[DV / 32], const unsigned char* vb, int r, int h) {
    s0 = s0 * SM_C; s1 = s1 * SM_C;
    const f32x16 t = __builtin_elementwise_max(s0, s1);
    float mx = fmaxf(fmaxf(fmaxf(t[0], t[1]), fmaxf(t[2], t[3])), fmaxf(fmaxf(t[4], t[5]), fmaxf(t[6], t[7])));
    mx = fmaxf(mx, fmaxf(fmaxf(fmaxf(t[8], t[9]), fmaxf(t[10], t[11])), fmaxf(fmaxf(t[12], t[13]), fmaxf(t[14], t[15]))));
    mx = xhalf_max(mx);
    if (!__all(mx - m <= SM_THR)) {
        const float mn = fmaxf(m, mx);
        const float alpha = fast_exp2(m - mn);
        l *= alpha; m = mn;
#pragma unroll
        for (int dt = 0; dt < DV / 32; ++dt) o[dt] = o[dt] * alpha;
    }
    s0 = s0 - m; s1 = s1 - m;
#pragma unroll
    for (int i = 0; i < 16; ++i) { s0[i] = fast_exp2(s0[i]); s1[i] = fast_exp2(s1[i]); }
    const f32x16 sm = s0 + s1;
    l += xhalf_sum(hsum16(sm));
    bf16x8 pf[2][2]; pack_p(s0, s1, pf);
    attn_pv<DV>(vb, pf, r, h, o);
}

DI void diff_unit(const Params& p, int u, unsigned char* lds, int probe = 0) {
    int tid_ = threadIdx.x; asm volatile("" : "+v"(tid_));
    const int lane = tid_ & 63, w = tid_ >> 6, r = lane & 31, h = lane >> 5;
    const int qt = 15 - (u >> 5), bh = u & 31, b = bh >> 2, hh = bh & 3;
    const int q0 = qt * 256, wq0 = q0 + 32 * w, qpos = wq0 + r;
    const int ntl = 4 * qt + 4;
    const float lam = ((const float*)(p.ws + OFF_CTL))[16];
    const bf16_t* VTb = (const bf16_t*)(p.ws + OFF_VDT) + (size_t)(b * 4 + hh) * 128 * 4096;
#pragma unroll 1
    for (int mp = 0; mp < 2; ++mp) {
        const size_t hoff = ((size_t)(b * 8 + hh * 2 + mp) * 4096) * 64;
        const bf16_t* Qb = (const bf16_t*)(p.ws + OFF_QD) + hoff;
        const bf16_t* Kb = (const bf16_t*)(p.ws + OFF_KD) + hoff;
        bf16x8 qf[4];
#pragma unroll
        for (int s = 0; s < 4; ++s) qf[s] = *(const bf16x8*)(Qb + (size_t)qpos * 64 + s * 16 + h * 8);
#pragma unroll
        for (int s = 0; s < 4; ++s) asm volatile("" : "+v"(qf[s]));
        f32x16 o[4];
#pragma unroll
        for (int dt = 0; dt < 4; ++dt)
#pragma unroll
            for (int i = 0; i < 16; ++i) o[dt][i] = 0.f;
        float m = -1e30f, l = 0.f;
        kv_loop<128, true>(lds, Kb, VTb, 4096, ntl, 0, [](int j) { return j + 1; }, [&](int j, const unsigned char* sb) {
            const int k0 = j * 64;
            if (k0 <= wq0 + 31) {
                f32x16 s0, s1; attn_scores(sb, qf, r, h, s0, s1);
                if (k0 + 63 > wq0) {
#pragma unroll
                    for (int i = 0; i < 16; ++i) {
                        const int kl = k0 + crow(i, h);
                        if (kl > qpos) s0[i] = NEG_INF;
                        if (kl + 32 > qpos) s1[i] = NEG_INF;
                    }
                }
                attn_softmax_pv<128>(s0, s1, m, l, o, sb + KT_BYTES, r, h);
            }
        }, probe);
        if (probe) {
            float chk = l + m;
#pragma unroll
            for (int dt = 0; dt < 4; ++dt)
#pragma unroll
                for (int i = 0; i < 16; ++i) chk += o[dt][i];
            if (chk == 1.2345e-30f) ((float*)(p.ws + OFF_CTL))[32] = chk;
            continue;
        }
        const float inv = 1.f / l;
        bf16_t* O = (bf16_t*)(p.ws + OFF_O) + ((size_t)b * 4096 + qpos) * 1024 + hh * 128;
        if (mp == 0) {
#pragma unroll
            for (int dt = 0; dt < 4; ++dt)
#pragma unroll
                for (int g4 = 0; g4 < 4; ++g4) {
                    u32x2 ov; ov.x = pk_bf16(o[dt][4 * g4] * inv, o[dt][4 * g4 + 1] * inv); ov.y = pk_bf16(o[dt][4 * g4 + 2] * inv, o[dt][4 * g4 + 3] * inv);
                    *(u32x2*)(O + dt * 32 + 8 * g4 + 4 * h) = ov;
                }
        } else {
            float ss = 0.f;
            const float li = lam * inv;
#pragma unroll
            for (int dt = 0; dt < 4; ++dt)
#pragma unroll
                for (int g4 = 0; g4 < 4; ++g4) {
                    const u32x2 pv = *(const u32x2*)(O + dt * 32 + 8 * g4 + 4 * h);
                    const float v0 = bflo(pv.x) - li * o[dt][4 * g4], v1 = bfhi(pv.x) - li * o[dt][4 * g4 + 1];
                    const float v2 = bflo(pv.y) - li * o[dt][4 * g4 + 2], v3 = bfhi(pv.y) - li * o[dt][4 * g4 + 3];
                    o[dt][4 * g4] = v0; o[dt][4 * g4 + 1] = v1; o[dt][4 * g4 + 2] = v2; o[dt][4 * g4 + 3] = v3;
                    ss += (v0 * v0 + v1 * v1) + (v2 * v2 + v3 * v3);
                }
            ss = xhalf_sum(ss);
            const float rstd = rsqrtf(ss * (1.f / 128.f) + NORM_EPS) * 0.8f;
            const float* sub = p.in[7];
#pragma unroll
            for (int dt = 0; dt < 4; ++dt)
#pragma unroll
                for (int g4 = 0; g4 < 4; ++g4) {
                    const int d = dt * 32 + 8 * g4 + 4 * h;
                    const f32x4 sg = *(const f32x4*)(sub + d);
                    u32x2 ov; ov.x = pk_bf16(o[dt][4 * g4] * rstd * sg[0], o[dt][4 * g4 + 1] * rstd * sg[1]);
                    ov.y = pk_bf16(o[dt][4 * g4 + 2] * rstd * sg[2], o[dt][4 * g4 + 3] * rstd * sg[3]);
                    *(u32x2*)(O + d) = ov;
                }
        }
    }
}

constexpr int NSA_IMPW = 36864;
constexpr int NSA_SEL = NSA_IMPW + 65536;
constexpr int NSA_UN = NSA_SEL + 512;
constexpr int NSA_FT = NSA_UN + 64;
constexpr int LDS_UNIT = 2 * 73728 + 16;
DI void nsa_unit(const Params& p, int u, unsigned char* lds, int probe = 0) {
    int tid_ = threadIdx.x; asm volatile("" : "+v"(tid_));
    const int lane = tid_ & 63, w = tid_ >> 6, r = lane & 31, h = lane >> 5;
    const int qt = 63 - (u >> 4), bg = u & 15, b = bg >> 1, g = bg & 1;
    const int hq = w >> 2, q0 = qt * 64, qb = q0 + 32 * hq, qpos = qb + r, head = g * 4 + (w & 3);
    float* IMPW = (float*)(lds + NSA_IMPW);
    u64* SEL = (u64*)(lds + NSA_SEL);
    u64* UN = (u64*)(lds + NSA_UN);
    const bf16_t* Qb = (const bf16_t*)(p.ws + OFF_QN) + ((size_t)(b * 8 + head) * 4096) * 64;
    bf16x8 qf[4];
#pragma unroll
    for (int s = 0; s < 4; ++s) qf[s] = *(const bf16x8*)(Qb + (size_t)qpos * 64 + s * 16 + h * 8);
#pragma unroll
    for (int s = 0; s < 4; ++s) asm volatile("" : "+v"(qf[s]));
    const float* gp = (const float*)(p.ws + OFF_GATES) + ((size_t)b * 4096 + qpos) * 24 + head * 3;
    auto inc = [](int j) { return j + 1; };
    f32x16 oacc[2];

    float* FT = (float*)(lds + NSA_FT);
    {
        const bf16_t* Kc = (const bf16_t*)(p.ws + OFF_KCMP) + (size_t)bg * 256 * 64;
        const bf16_t* VcT = (const bf16_t*)(p.ws + OFF_VCMPT) + (size_t)bg * 64 * 256;
        const int nmax = ((q0 + 32) >> 4) + 1, ntc = (nmax + 63) >> 6;
        const int nvalid = qpos >= 31 ? ((qpos - 31) >> 4) + 1 : 0;
        float m = -1e30f, l = 0.f, carry = 0.f;
        f32x16 oc[2];
#pragma unroll
        for (int dt = 0; dt < 2; ++dt)
#pragma unroll
            for (int i = 0; i < 16; ++i) oc[dt][i] = 0.f;
        kv_loop<64, true>(lds, Kc, VcT, 256, ntc, 0, inc, [&](int j, const unsigned char* sb) {
            f32x16 s0, s1; attn_scores(sb, qf, r, h, s0, s1);
            float mx = NEG_INF;
#pragma unroll
            for (int i = 0; i < 16; ++i) {
                const int n = j * 64 + crow(i, h);
                if (n >= nvalid) s0[i] = NEG_INF;
                if (n + 32 >= nvalid) s1[i] = NEG_INF;
                mx = fmaxf(mx, fmaxf(s0[i], s1[i]));
            }
            mx = xhalf_max(mx);
            const float mn = fmaxf(m, mx);
            const float alpha = fast_exp2((m - mn) * SM_C), nb = -mn * SM_C;
            m = mn; l *= alpha; carry *= alpha;
#pragma unroll
            for (int dt = 0; dt < 2; ++dt) oc[dt] = oc[dt] * alpha;
            if (h == 0) FT[(w * 32 + r) * 4 + j] = mn;
            float rs = 0.f;
#pragma unroll
            for (int i = 0; i < 16; ++i) {
                s0[i] = fast_exp2(__builtin_fmaf(s0[i], SM_C, nb)); s1[i] = fast_exp2(__builtin_fmaf(s1[i], SM_C, nb));
                rs += s0[i] + s1[i];
            }
            l += xhalf_sum(rs);
#pragma unroll
            for (int mt = 0; mt < 2; ++mt)
#pragma unroll
                for (int a = 0; a < 4; ++a) {
                    const float x0 = mt ? s1[4 * a] : s0[4 * a], x1 = mt ? s1[4 * a + 1] : s0[4 * a + 1];
                    const float x2 = mt ? s1[4 * a + 2] : s0[4 * a + 2], x3 = mt ? s1[4 * a + 3] : s0[4 * a + 3];
                    float mainv = ((x0 + x1) + x2) + 0.5f * x3;
                    const float cr = 0.5f * x3;
                    const float other = __shfl_xor(cr, 32);
                    mainv += h ? other : carry;
                    carry = other;
                    IMPW[(w * 32 + r) * 64 + 16 * j + 8 * mt + 2 * a + h] = mainv;
                }
            bf16x8 pf[2][2]; pack_p(s0, s1, pf);
            attn_pv<64>(sb + KT_BYTES, pf, r, h, oc);
        }, probe);
        const float invl = l > 0.f ? 1.f / l : 0.f;
        if (h == 0) {
#pragma unroll
            for (int t = 0; t < 4; ++t)
                if (t < ntc) { const float mt_ = FT[(w * 32 + r) * 4 + t]; FT[(w * 32 + r) * 4 + t] = fast_exp2((mt_ - m) * SM_C) * invl; }
        }
        const float g0 = gp[0] * invl;
#pragma unroll
        for (int dt = 0; dt < 2; ++dt)
#pragma unroll
            for (int i = 0; i < 16; ++i) oacc[dt][i] = g0 * oc[dt][i];
        __syncthreads();
    }
    {
        unsigned uk8[8]; bool val8[8];
        const int j = lane;
#pragma unroll
        for (int qq = 0; qq < 8; ++qq) {
            const int rr = 8 * w + qq, qp = q0 + rr, cur = qp >> 6;
            const bool valid = j <= cur;
            float v = 0.f;
            if (valid) {
                const float* ip = IMPW + ((rr >> 5) * 4 * 32 + (rr & 31)) * 64 + j;
                const float* fp = FT + ((rr >> 5) * 4 * 32 + (rr & 31)) * 4 + (j >> 4);
                v = ((ip[0] * fp[0] + ip[2048] * fp[128]) + ip[4096] * fp[256]) + ip[6144] * fp[384];
            }
            const bool forced = (j == 0) || (j == cur) || (j == cur - 1);
            const float key = forced ? __builtin_inff() : (valid ? v : NEG_INF);
            const unsigned kb_ = __float_as_uint(key);
            uk8[qq] = (kb_ & 0x80000000u) ? ~kb_ : (kb_ | 0x80000000u);
            val8[qq] = valid;
        }
        unsigned thr8[8];
#pragma unroll
        for (int qq = 0; qq < 8; ++qq) thr8[qq] = 0u;
#pragma unroll
        for (int bit = 31; bit >= 0; --bit) {
#pragma unroll
            for (int qq = 0; qq < 8; ++qq) {
                const unsigned cand = thr8[qq] | (1u << bit);
                if (__popcll(__ballot(uk8[qq] >= cand)) >= 16) thr8[qq] = cand;
            }
        }
        u64 un = 0;
#pragma unroll
        for (int qq = 0; qq < 8; ++qq) {
            const unsigned uk = uk8[qq], thr = thr8[qq];
            const u64 gtm = __ballot(uk > thr), eqm = __ballot(uk == thr);
            const int need = 16 - (int)__popcll(gtm);
            const int below = (int)__builtin_amdgcn_mbcnt_hi((unsigned)(eqm >> 32), __builtin_amdgcn_mbcnt_lo((unsigned)eqm, 0u));
            const bool sel = ((uk > thr) || (uk == thr && below < need)) && val8[qq];
            const u64 mask = __ballot(sel);
            if (lane == 0) SEL[8 * w + qq] = mask;
            un |= mask;
        }
        if (lane == 0) UN[w] = un;
        __syncthreads();
    }
    const u64 mysel = SEL[32 * hq + r];
    const u64 U = ((UN[0] | UN[1]) | (UN[2] | UN[3])) | ((UN[4] | UN[5]) | (UN[6] | UN[7]));
    unsigned char* ql = lds + NSA_IMPW + (w * 32 + r) * 144 + h * 16;
#pragma unroll
    for (int s = 0; s < 4; ++s) *(bf16x8*)(ql + s * 32) = qf[s];
    {
        const bf16_t* Ks = (const bf16_t*)(p.ws + OFF_KS) + (size_t)bg * 4096 * 64;
        const bf16_t* VsT = (const bf16_t*)(p.ws + OFF_VST) + (size_t)bg * 64 * 4096;
        const int nts = __popcll(U), j0 = __ffsll((long long)U) - 1;
        f32x16 o[2];
#pragma unroll
        for (int dt = 0; dt < 2; ++dt)
#pragma unroll
            for (int i = 0; i < 16; ++i) o[dt][i] = 0.f;
        float m = -1e30f, l = 0.f;
        kv_loop<64, true>(lds, Ks, VsT, 4096, nts, j0, [U](int j) { return __ffsll((long long)(U & (~0ull << (j + 1)))) - 1; }, [&](int j, const unsigned char* sb) {
            const bool mine = (mysel >> j) & 1ull;
            if (__ballot(mine) != 0ull) {
                bf16x8 q2[4];
#pragma unroll
                for (int s = 0; s < 4; ++s) q2[s] = *(const bf16x8*)(ql + s * 32);
                f32x16 s0, s1; attn_scores(sb, q2, r, h, s0, s1);
                const int lim = mine ? (qpos - 64 * j) : -1;
#pragma unroll
                for (int i = 0; i < 16; ++i) {
                    const int kl = crow(i, h);
                    if (kl > lim) s0[i] = NEG_INF;
                    if (kl + 32 > lim) s1[i] = NEG_INF;
                }
                attn_softmax_pv<64>(s0, s1, m, l, o, sb + KT_BYTES, r, h);
            }
        }, probe);
        const float sc = l > 0.f ? gp[1] / l : 0.f;
#pragma unroll
        for (int dt = 0; dt < 2; ++dt)
#pragma unroll
            for (int i = 0; i < 16; ++i) oacc[dt][i] += sc * o[dt][i];
    }
    {
        const bf16_t* Kw = (const bf16_t*)(p.ws + OFF_KW) + (size_t)bg * 4096 * 64;
        const bf16_t* VwT = (const bf16_t*)(p.ws + OFF_VWT) + (size_t)bg * 64 * 4096;
        const int tlo = (q0 > 511 ? q0 - 511 : 0) >> 6, thi = (q0 + 63) >> 6;
        f32x16 o[2];
#pragma unroll
        for (int dt = 0; dt < 2; ++dt)
#pragma unroll
            for (int i = 0; i < 16; ++i) o[dt][i] = 0.f;
        float m = -1e30f, l = 0.f;
        kv_loop<64, true>(lds, Kw, VwT, 4096, thi - tlo + 1, tlo, inc, [&](int j, const unsigned char* sb) {
            const int k0 = j * 64;
            if (k0 > qb + 31 || k0 + 63 <= qb - 512) return;
            bf16x8 q2[4];
#pragma unroll
            for (int s = 0; s < 4; ++s) q2[s] = *(const bf16x8*)(ql + s * 32);
            f32x16 s0, s1; attn_scores(sb, q2, r, h, s0, s1);
            if (!(k0 + 63 <= qb && k0 > qb + 31 - 512)) {
#pragma unroll
                for (int i = 0; i < 16; ++i) {
                    const int ka = k0 + crow(i, h), kb2 = ka + 32;
                    if (!(ka <= qpos && ka > qpos - 512)) s0[i] = NEG_INF;
                    if (!(kb2 <= qpos && kb2 > qpos - 512)) s1[i] = NEG_INF;
                }
            }
            attn_softmax_pv<64>(s0, s1, m, l, o, sb + KT_BYTES, r, h);
        }, probe);
        const float sc = l > 0.f ? gp[2] / l : 0.f;
#pragma unroll
        for (int dt = 0; dt < 2; ++dt)
#pragma unroll
            for (int i = 0; i < 16; ++i) oacc[dt][i] += sc * o[dt][i];
    }
    if (probe) {
        float chk = 0.f;
#pragma unroll
        for (int dt = 0; dt < 2; ++dt)
#pragma unroll
            for (int i = 0; i < 16; ++i) chk += oacc[dt][i];
        if (chk == 1.2345e-30f) ((float*)(p.ws + OFF_CTL))[33] = chk;
        return;
    }
    bf16_t* O = (bf16_t*)(p.ws + OFF_O) + ((size_t)b * 4096 + qpos) * 1024 + 512 + head * 64;
#pragma unroll
    for (int dt = 0; dt < 2; ++dt)
#pragma unroll
        for (int g4 = 0; g4 < 4; ++g4) {
            u32x2 ov; ov.x = pk_bf16(oacc[dt][4 * g4], oacc[dt][4 * g4 + 1]); ov.y = pk_bf16(oacc[dt][4 * g4 + 2], oacc[dt][4 * g4 + 3]);
            *(u32x2*)(O + dt * 32 + 8 * g4 + 4 * h) = ov;
        }
}
DI void phase4(const Params& p, unsigned char* lds, int rep = 0, int probe = 0, int which = 3) {
    unsigned* counter = (unsigned*)(p.ws + OFF_CTL) + 2 * rep;
    volatile int* su = (volatile int*)(lds + LDS_UNIT);
    if (which & 1) for (;;) {
        if (threadIdx.x == 0) *su = (int)atomicAdd(counter, 1u);
        __syncthreads();
        const int u = *su;
        __syncthreads();
        if (u >= 512) break;
        diff_unit(p, u, lds, probe);
    }
    if (which & 2) for (;;) {
        if (threadIdx.x == 0) *su = (int)atomicAdd(counter + 1, 1u);
        __syncthreads();
        const int u = *su;
        __syncthreads();
        if (u >= 1024) break;
        nsa_unit(p, u, lds, probe);
    }
}
DI void phase5(const Params& p, unsigned char* lds) {
    pg8::Gemm g; g.A = (const bf16_t*)(p.ws + OFF_O); g.Bt = (const bf16_t*)(p.ws + OFF_WOUTT); g.M = T; g.N = 1024; g.K = 1024;
    pg8::StaticOrder S; S.init(T, 1024, (int)gridDim.x, (int)blockIdx.x);
    pg8::EpiPlain E; E.O = (bf16_t*)(p.ws + OFF_MIX); E.ldc = 1024;
    pg8::gemm_phase<pg8::EpiPlain, pg8::StaticOrder, true, true>((PG8_LAS unsigned char*)lds, g, S, E);
    __syncthreads();
}
DI void phase6(const Params& p) {
    const int lane = VTID & 63, w = VTID >> 6;
    const float* x = p.in[0]; const float* gpost = p.in[15]; const float* gffn = p.in[16];
    const bf16_t* MIX = (const bf16_t*)(p.ws + OFF_MIX);
    bf16_t* H = (bf16_t*)(p.ws + OFF_H);
    float* RSTD = (float*)(p.ws + OFF_GATES);
    for (int row = VBLK * 4 + w; row < T; row += VGRID * 4) {
        f32x4 mv[4], xv[4]; float ss = 0.f;
#pragma unroll
        for (int i = 0; i < 4; ++i) {
            const u32x2 u = *(const u32x2*)(MIX + (size_t)row * 1024 + i * 256 + lane * 4);
            mv[i][0] = bflo(u.x); mv[i][1] = bfhi(u.x); mv[i][2] = bflo(u.y); mv[i][3] = bfhi(u.y);
            xv[i] = *(const f32x4*)(x + (size_t)row * 1024 + i * 256 + lane * 4);
            ss += mv[i][0] * mv[i][0] + mv[i][1] * mv[i][1] + mv[i][2] * mv[i][2] + mv[i][3] * mv[i][3];
        }
        ss = wave_sum(ss);
        const float rstd = rsqrtf(ss * (1.f / 1024.f) + NORM_EPS);
        if (lane == 0) RSTD[row] = rstd;
        float ss2 = 0.f;
#pragma unroll
        for (int i = 0; i < 4; ++i) {
            const f32x4 gg = *(const f32x4*)(gpost + i * 256 + lane * 4);
#pragma unroll
            for (int e = 0; e < 4; ++e) { xv[i][e] += mv[i][e] * rstd * gg[e]; ss2 += xv[i][e] * xv[i][e]; }
        }
        ss2 = wave_sum(ss2);
        const float rstd2 = rsqrtf(ss2 * (1.f / 1024.f) + NORM_EPS);
#pragma unroll
        for (int i = 0; i < 4; ++i) {
            const f32x4 gg = *(const f32x4*)(gffn + i * 256 + lane * 4);
            u32x2 o; o.x = pk_bf16(xv[i][0] * rstd2 * gg[0], xv[i][1] * rstd2 * gg[1]); o.y = pk_bf16(xv[i][2] * rstd2 * gg[2], xv[i][3] * rstd2 * gg[3]);
            *(u32x2*)(H + (size_t)row * 1024 + i * 256 + lane * 4) = o;
        }
    }
}
DI void phase7(const Params& p, unsigned char* lds, int probe = 0) {
    pg8::Gemm g; g.A = (const bf16_t*)(p.ws + OFF_H); g.Bt = (const bf16_t*)(p.ws + OFF_WGUT); g.M = T; g.N = 2 * DFF; g.K = 1024;
    pg8::StaticOrder S; S.init(T, 2 * DFF, (int)gridDim.x, (int)blockIdx.x);
    pg8::EpiSwiGLU E; E.ACT = (bf16_t*)(p.ws + OFF_ACT); E.ldc = DFF;
    pg8::gemm_phase<pg8::EpiSwiGLU, pg8::StaticOrder, true, true>((PG8_LAS unsigned char*)lds, g, S, E);
    __syncthreads();
}
DI void phase8(const Params& p, unsigned char* lds) {
    pg8::Gemm g; g.A = (const bf16_t*)(p.ws + OFF_ACT); g.Bt = (const bf16_t*)(p.ws + OFF_WDT); g.M = T; g.N = 1024; g.K = DFF;
    pg8::StaticOrder S; S.init(T, 1024, (int)gridDim.x, (int)blockIdx.x);
    pg8::EpiPlain E; E.O = (bf16_t*)(p.ws + OFF_O); E.ldc = 1024;
    pg8::gemm_phase<pg8::EpiPlain, pg8::StaticOrder, true, true>((PG8_LAS unsigned char*)lds, g, S, E);
    __syncthreads();
}
DI void phase9(const Params& p) {
    const int lane = VTID & 63, w = VTID >> 6;
    const float* x = p.in[0]; const float* g1 = p.in[15]; const float* g2 = p.in[20];
    const bf16_t* MIX = (const bf16_t*)(p.ws + OFF_MIX);
    const bf16_t* F = (const bf16_t*)(p.ws + OFF_O);
    const float* RSTD = (const float*)(p.ws + OFF_GATES);
    for (int row = VBLK * 4 + w; row < T; row += VGRID * 4) {
        f32x4 fv[4], mv[4]; float ss = 0.f;
#pragma unroll
        for (int i = 0; i < 4; ++i) {
            const u32x2 u = *(const u32x2*)(F + (size_t)row * 1024 + i * 256 + lane * 4);
            fv[i][0] = bflo(u.x); fv[i][1] = bfhi(u.x); fv[i][2] = bflo(u.y); fv[i][3] = bfhi(u.y);
            const u32x2 um = *(const u32x2*)(MIX + (size_t)row * 1024 + i * 256 + lane * 4);
            mv[i][0] = bflo(um.x); mv[i][1] = bfhi(um.x); mv[i][2] = bflo(um.y); mv[i][3] = bfhi(um.y);
            ss += fv[i][0] * fv[i][0] + fv[i][1] * fv[i][1] + fv[i][2] * fv[i][2] + fv[i][3] * fv[i][3];
        }
        ss = wave_sum(ss);
        const float rstd = rsqrtf(ss * (1.f / 1024.f) + NORM_EPS);
        const float rstd1 = RSTD[row];
#pragma unroll
        for (int i = 0; i < 4; ++i) {
            const f32x4 ga = *(const f32x4*)(g1 + i * 256 + lane * 4);
            const f32x4 gb = *(const f32x4*)(g2 + i * 256 + lane * 4);
            f32x4 xv = *(const f32x4*)(x + (size_t)row * 1024 + i * 256 + lane * 4);
#pragma unroll
            for (int e = 0; e < 4; ++e) { xv[e] += mv[i][e] * rstd1 * ga[e]; xv[e] += fv[i][e] * rstd * gb[e]; }
            *(f32x4*)(p.out + (size_t)row * 1024 + i * 256 + lane * 4) = xv;
        }
    }
}

__global__ void __launch_bounds__(512, 2) mega(Params p) {
    extern __shared__ __attribute__((aligned(16))) unsigned char lds[];
    cg::grid_group grid = cg::this_grid();
    const bool fused = (p.ph_hi - p.ph_lo) > 1;
    XcdBarrier xb; xb.bar = (unsigned*)(p.ws + OFF_XB); xb.x = 0; xb.st = (volatile LAS unsigned*)(lds + LDS_XB);
    if (fused) {
        if (threadIdx.x == 0) { xb.st[0] = 0u; xb.st[1] = 0u; }
        __syncthreads();
        xb = xcd_barrier_post((unsigned*)(p.ws + OFF_XB), (volatile LAS unsigned*)(lds + LDS_XB));
    }
    if (p.ph_hi > 1000) grid.sync();
#ifndef ONLY_PH
#define ONLY_PH -1
#endif
#define PH_ON(n) (ONLY_PH < 0 || ONLY_PH == (n))
#define RUN_PHASE(n, call) if (p.ph_lo <= (n) && (n) < p.ph_hi) { if (PH_ON(n)) { call; } if ((n) + 1 < p.ph_hi) { xcd_barrier(xb); if (PROBE_MODE == 1) xcd_barrier(xb); } }
    RUN_PHASE(0, phase0(p, lds))
    RUN_PHASE(1, phase1(p, lds))
    RUN_PHASE(2, phase2(p, lds))
    RUN_PHASE(3, phase3(p, lds))
    RUN_PHASE(4, phase4(p, lds))
#if PROBE_MODE == 2
    RUN_PHASE(4, phase4(p, lds, 1))
#endif
#if PROBE_MODE == 8
    RUN_PHASE(4, phase4(p, lds, 1, 0, 1))
#endif
#if PROBE_MODE == 9
    RUN_PHASE(4, phase4(p, lds, 1, 0, 2))
#endif
#if PROBE_MODE == 6
    RUN_PHASE(4, phase4(p, lds, 1, 1))
#endif
#if PROBE_MODE == 7
    RUN_PHASE(4, phase4(p, lds, 1, 2))
#endif
    RUN_PHASE(5, phase5(p, lds))
    RUN_PHASE(6, phase6(p))
    RUN_PHASE(7, phase7(p, lds))
#if PROBE_MODE == 3
    RUN_PHASE(7, phase7(p, lds))
#endif
#if PROBE_MODE == 4
    RUN_PHASE(7, phase7(p, lds, 1))
#endif
#if PROBE_MODE == 5
    RUN_PHASE(7, phase7(p, lds, 2))
#endif
    RUN_PHASE(8, phase8(p, lds))
    RUN_PHASE(9, phase9(p))
}

extern "C" void kernel_launch(void* const* d_in, const int* in_sizes, int n_in, void* d_out, int out_size, void* d_ws, size_t ws_size, hipStream_t stream) {
    static int grid_blocks = 0;
    if (grid_blocks == 0) {
        if (n_in != 21 || ws_size < WS_END) { fprintf(stderr, "kernel_launch: unexpected n_in %d / ws %zu (need %zu)\n", n_in, ws_size, (size_t)WS_END); grid_blocks = -1; return; }
        int dev = 0, cus = 0, per_cu = 0;
        hipGetDevice(&dev);
        hipDeviceGetAttribute(&cus, hipDeviceAttributeMultiprocessorCount, dev);
        if (hipFuncSetAttribute((const void*)mega, hipFuncAttributeMaxDynamicSharedMemorySize, LDS_BYTES) != hipSuccess) { fprintf(stderr, "kernel_launch: hipFuncSetAttribute failed\n"); grid_blocks = -1; return; }
        hipOccupancyMaxActiveBlocksPerMultiprocessor(&per_cu, (const void*)mega, 512, LDS_BYTES);
        if (per_cu < 1) per_cu = 1;
        if (per_cu > 1) per_cu = 1;
        grid_blocks = cus * per_cu;
        if (grid_blocks > 256) grid_blocks = 256;
    }
    if (grid_blocks < 0) return;
    Params p{};
    for (int i = 0; i < 21; ++i) p.in[i] = (const float*)d_in[i];
    p.out = (float*)d_out; p.ws = (unsigned char*)d_ws;
#if MULTI_LAUNCH
    for (int ph = 0; ph < NPH; ++ph) {
        p.ph_lo = ph; p.ph_hi = ph + 1;
        hipLaunchKernelGGL(mega, dim3(grid_blocks), dim3(512), LDS_BYTES, stream, p);
    }
#else
    p.ph_lo = 0; p.ph_hi = NPH;
    if (hipMemsetAsync((unsigned char*)d_ws + OFF_XB, 0, XCD_BAR_WORDS * 4, stream) != hipSuccess) { fprintf(stderr, "kernel_launch: memset of barrier words failed\n"); return; }
    void* args[] = {&p};
    hipError_t e = hipLaunchCooperativeKernel((const void*)mega, dim3(grid_blocks), dim3(512), args, LDS_BYTES, stream);
    if (e != hipSuccess) fprintf(stderr, "cooperative launch failed: %s (grid %d)\n", hipGetErrorString(e), grid_blocks);
#endif
}
```

```cpp
#include <hip/hip_runtime.h>
#include <hip/hip_cooperative_groups.h>
#include <cstdio>
#include <cstdint>
namespace cg = cooperative_groups;

#ifndef MULTI_LAUNCH
#define MULTI_LAUNCH 0
#endif
#ifndef PROBE_MODE
#define PROBE_MODE 0
#endif

typedef unsigned short bf16_t;
typedef short bf16x8 __attribute__((ext_vector_type(8)));
typedef short s16x4 __attribute__((ext_vector_type(4)));
typedef float f32x16 __attribute__((ext_vector_type(16)));
typedef float f32x4 __attribute__((ext_vector_type(4)));
typedef float f32x2 __attribute__((ext_vector_type(2)));
typedef unsigned u32x4 __attribute__((ext_vector_type(4)));
typedef unsigned u32x2 __attribute__((ext_vector_type(2)));
typedef __bf16 bf16v2 __attribute__((ext_vector_type(2)));
typedef unsigned long long u64;

#define DI __device__ __forceinline__
#define MFMA(a, b, c) __builtin_amdgcn_mfma_f32_32x32x16_bf16((a), (b), (c), 0, 0, 0)

constexpr int T = 32768, S = 4096, DM = 1024;
constexpr int INC = 2840, INP = 3072, DFF = 2816;
constexpr int NPH = 10;
constexpr int HALF_LDS = 73728;
constexpr int LDS_BYTES = 2 * HALF_LDS + 256;
#define VTID ((int)(threadIdx.x & 255))
#define VHALF ((int)(threadIdx.x >> 8))
#define VBLK ((int)(blockIdx.x * 2 + (threadIdx.x >> 8)))
#define VGRID ((int)(gridDim.x * 2))
constexpr float NORM_EPS = 1e-6f;

constexpr size_t al256(size_t x) { return (x + 255) & ~(size_t)255; }
constexpr size_t OFF_CTL = 0;
constexpr size_t OFF_XB = 4096;
constexpr size_t OFF_WINT = 4096 + 16384;
constexpr size_t OFF_WOUTT = OFF_WINT + (size_t)INP * 1024 * 2;
constexpr size_t OFF_WGUT = OFF_WOUTT + (size_t)1024 * 1024 * 2;
constexpr size_t OFF_WDT = OFF_WGUT + (size_t)2 * DFF * 1024 * 2;
constexpr size_t OFF_W1T = OFF_WDT + (size_t)1024 * DFF * 2;
constexpr size_t OFF_W2T = OFF_W1T + (size_t)2 * 256 * 2048 * 2;
constexpr size_t OFF_B1 = OFF_W2T + (size_t)2 * 128 * 256 * 2;
constexpr size_t OFF_ROPE = OFF_B1 + 2 * 256 * 4;
constexpr size_t OFF_H = al256(OFF_ROPE + (size_t)4096 * 32 * 8);
constexpr size_t OFF_O = OFF_H + (size_t)T * 1024 * 2;
constexpr size_t OFF_MIX = OFF_O + (size_t)T * 1024 * 2;
constexpr size_t OFF_QKV = OFF_MIX + (size_t)T * 1024 * 2;
constexpr size_t SZ_H8 = (size_t)8 * 8 * 4096 * 64 * 2;
constexpr size_t SZ_G2 = (size_t)8 * 2 * 4096 * 64 * 2;
constexpr size_t OFF_QD = OFF_QKV;
constexpr size_t OFF_KD = OFF_QD + SZ_H8;
constexpr size_t OFF_VDT = OFF_KD + SZ_H8;
constexpr size_t OFF_QN = OFF_VDT + SZ_H8;
constexpr size_t OFF_KCT = OFF_QN + SZ_H8;
constexpr size_t OFF_VCT = OFF_KCT + SZ_G2;
constexpr size_t OFF_KS = OFF_VCT + SZ_G2;
constexpr size_t OFF_VST = OFF_KS + SZ_G2;
constexpr size_t OFF_KW = OFF_VST + SZ_G2;
constexpr size_t OFF_VWT = OFF_KW + SZ_G2;
constexpr size_t OFF_GATES = OFF_VWT + SZ_G2;
constexpr size_t OFF_HID = OFF_GATES + (size_t)T * 24 * 4;
constexpr size_t OFF_KCMP = OFF_HID + (size_t)2 * 16 * 256 * 256 * 2;
constexpr size_t OFF_VCMPT = OFF_KCMP + (size_t)16 * 256 * 64 * 2;
constexpr size_t OFF_QKV_END = OFF_VCMPT + (size_t)16 * 256 * 64 * 2;
constexpr size_t OFF_ACT = OFF_QKV;
constexpr size_t OFF_ACT_END = OFF_ACT + (size_t)T * DFF * 2;
constexpr size_t WS_END = OFF_ACT_END > OFF_QKV_END ? OFF_ACT_END : OFF_QKV_END;

struct Params {
    const float* in[21];
    float* out;
    unsigned char* ws;
    int ph_lo, ph_hi;
};

DI unsigned pk_bf16(float a, float b) { f32x2 v = {a, b}; return __builtin_bit_cast(unsigned, __builtin_convertvector(v, bf16v2)); }
DI bf16_t f2bf(float a) { return (bf16_t)(pk_bf16(a, 0.f) & 0xffffu); }
DI float bflo(unsigned u) { return __uint_as_float(u << 16); }
DI float bfhi(unsigned u) { return __uint_as_float(u & 0xffff0000u); }
DI u32x4 pk8(const float (&v)[8]);
DI int crow(int i, int h) { return (i & 3) + 8 * (i >> 2) + 4 * h; }
DI float wave_sum(float v) {
    v += __shfl_xor(v, 32); v += __shfl_xor(v, 16); v += __shfl_xor(v, 8);
    v += __shfl_xor(v, 4); v += __shfl_xor(v, 2); v += __shfl_xor(v, 1);
    return v;
}
DI float fast_exp2(float x) { return __builtin_amdgcn_exp2f(x); }
DI float xhalf_max(float x) { auto rr = __builtin_amdgcn_permlane32_swap(__float_as_uint(x), __float_as_uint(x), false, false); return fmaxf(__uint_as_float(rr[0]), __uint_as_float(rr[1])); }
DI float xhalf_sum(float x) { auto rr = __builtin_amdgcn_permlane32_swap(__float_as_uint(x), __float_as_uint(x), false, false); return __uint_as_float(rr[0]) + __uint_as_float(rr[1]); }
DI float sigmoidf(float x) { return 1.f / (1.f + __expf(-x)); }


#define XB_TMO      128
#define XB_XCNT(j)  (256  + 64 * (j))
#define XB_XSUB(j)  (1280 + 64 * (j))
#define XB_XGEN(j)  (2304 + 64 * (j))
#define XB_TOP      3328
#define XB_TOPGEN   3392
#define XCD_BAR_WORDS 3456
#define XB_SPIN_CAP (1u << 18)
#define LAS __attribute__((address_space(3)))
DI unsigned xb_ld(unsigned* p) { return __hip_atomic_load(p, __ATOMIC_RELAXED, __HIP_MEMORY_SCOPE_AGENT); }
DI unsigned xb_add(unsigned* p, unsigned v) { return __hip_atomic_fetch_add(p, v, __ATOMIC_RELAXED, __HIP_MEMORY_SCOPE_AGENT); }
DI unsigned xb_xcc_id() { return (unsigned)__builtin_amdgcn_s_getreg((3 << 11) | 20) & 0xFu; }
#define XB_SPIN(cond, bar) do { unsigned _sp = 0; while (cond) { __builtin_amdgcn_s_sleep(1); \
    if ((++_sp & 255u) == 0u) { if (xb_ld(&(bar)[XB_TMO])) break; if (_sp > XB_SPIN_CAP) { atomicAdd(&(bar)[XB_TMO], 1u); break; } } } } while (0)
struct XcdBarrier { unsigned* bar; unsigned x; volatile LAS unsigned* st; };
DI XcdBarrier xcd_barrier_post(unsigned* bar, volatile LAS unsigned* st) {
    XcdBarrier b; b.bar = bar; b.x = xb_xcc_id(); b.st = st;
    if (threadIdx.x == 0) (void)xb_add(&bar[XB_XCNT(b.x)], 1u);
    return b;
}
DI void xcd_barrier_complete(unsigned* bar, unsigned x, unsigned& nloc, unsigned& nx) {
    const unsigned G = gridDim.x * gridDim.y * gridDim.z;
    unsigned sum, cnt, mine, sp = 0u;
    for (;;) {
        sum = 0u; cnt = 0u; mine = 0u;
#pragma unroll
        for (unsigned j = 0; j < 16; ++j) { const unsigned c = xb_ld(&bar[XB_XCNT(j)]); sum += c; cnt += (c > 0u) ? 1u : 0u; mine = (j == x) ? c : mine; }
        if (sum == G) break;
        __builtin_amdgcn_s_sleep(1);
        if ((++sp & 255u) == 0u) { if (xb_ld(&bar[XB_TMO])) break; if (sp > XB_SPIN_CAP) { atomicAdd(&bar[XB_TMO], 1u); break; } }
    }
    nloc = mine > 0u ? mine : 1u; nx = cnt > 0u ? cnt : 1u;
}
DI void xcd_barrier(const XcdBarrier& b) {
    asm volatile("s_waitcnt vmcnt(0)" ::: "memory");
    __syncthreads();
    if (threadIdx.x == 0) {
        unsigned* bar = b.bar;
        __builtin_amdgcn_s_waitcnt(0);
        unsigned nloc = b.st[0], nx = b.st[1];
        if (nloc == 0u) { xcd_barrier_complete(bar, b.x, nloc, nx); b.st[0] = nloc; b.st[1] = nx; }
        const unsigned old = xb_add(&bar[XB_XSUB(b.x)], 1u);
        const unsigned gen = old / nloc;
        if (old + 1u == (gen + 1u) * nloc) {
            __builtin_amdgcn_fence(__ATOMIC_RELEASE, "agent");
            asm volatile("s_waitcnt vmcnt(0)" ::: "memory");
            const unsigned og = xb_add(&bar[XB_TOP], 1u);
            const unsigned tg = og / nx;
            if (og + 1u == (tg + 1u) * nx) xb_add(&bar[XB_TOPGEN], 1u);
            else XB_SPIN(xb_ld(&bar[XB_TOPGEN]) == tg, bar);
            __builtin_amdgcn_fence(__ATOMIC_ACQUIRE, "agent");
            xb_add(&bar[XB_XGEN(b.x)], 1u);
            asm volatile("s_waitcnt vmcnt(0)" ::: "memory");
        } else {
            XB_SPIN(xb_ld(&bar[XB_XGEN(b.x)]) == gen, bar);
            __builtin_amdgcn_fence(__ATOMIC_ACQUIRE, "agent");
            asm volatile("s_waitcnt vmcnt(0)" ::: "memory");
        }
    }
    __syncthreads();
}
constexpr int LDS_XB = 2 * 73728;

DI int wdst_row(int n, int mode) {
    int dr = n;
    if (mode == 1 || mode == 2) dr = (n >> 2) * 8 + (n & 3) + (mode == 2 ? 4 : 0);
    else if (mode == 3) {
        const bool rope = (n < 1024) || (n >= 1536 && n < 2176) || (n >= 2304 && n < 2432) || (n >= 2560 && n < 2688);
        if (rope) { const int d = n & 63; dr = (n & ~63) + 8 * ((d & 31) >> 2) + (d & 3) + 4 * (d >> 5); }
    }
    return dr;
}
DI void transpose_tile(const float* __restrict__ src, int K, int N, bf16_t* __restrict__ dst, int ldd, int mode, int tile, float* tl, bool valid) {
    const int nbN = (N + 63) >> 6;
    const int kb = tile / nbN, nb = tile - kb * nbN;
    const int t = VTID;
    if (valid) {
#pragma unroll
        for (int i = 0; i < 4; ++i) {
            const int row = (t >> 4) + 16 * i, c4 = (t & 15) * 4, n = nb * 64 + c4;
            f32x4 v = {0.f, 0.f, 0.f, 0.f};
            if (n < N) v = *(const f32x4*)(src + (size_t)(kb * 64 + row) * N + n);
            float* q = tl + row * 65 + c4;
            q[0] = v[0]; q[1] = v[1]; q[2] = v[2]; q[3] = v[3];
        }
    }
    __syncthreads();
    if (valid) {
        const int nl = t >> 2, kc = (t & 3) * 16, n = nb * 64 + nl;
        if (n < N) {
            float a[8], b[8];
#pragma unroll
            for (int k = 0; k < 8; ++k) { a[k] = tl[(kc + k) * 65 + nl]; b[k] = tl[(kc + 8 + k) * 65 + nl]; }
            bf16_t* d = dst + (size_t)wdst_row(n, mode) * ldd + kb * 64 + kc;
            *(u32x4*)d = pk8(a); *(u32x4*)(d + 8) = pk8(b);
        }
    }
    __syncthreads();
}

DI void phase0(const Params& p, unsigned char* lds) {
    const int tid = VTID, lane = tid & 63, w = tid >> 6;
    const int G = VGRID;
    unsigned char* ws = p.ws;
    float* tl = (float*)(lds + VHALF * HALF_LDS);
    if (VBLK == 0) {
        if (tid < 64) {
            float a = p.in[3][lane] * p.in[4][lane];
            float b = p.in[5][lane] * p.in[6][lane];
            a = wave_sum(a); b = wave_sum(b);
            if (lane == 0) {
                ((float*)(ws + OFF_CTL))[16] = expf(a) - expf(b) + 0.2f;
                ((unsigned*)(ws + OFF_CTL))[0] = 0u; ((unsigned*)(ws + OFF_CTL))[1] = 0u; ((unsigned*)(ws + OFF_CTL))[2] = 0u; ((unsigned*)(ws + OFF_CTL))[3] = 0u;
            }
        }
    }
    {
        const int c0 = 720, c1 = c0 + 256, c2 = c1 + 704, c3 = c2 + 704, c4 = c3 + 704, c5 = c4 + 128, c6 = c5 + 128, c7 = c6 + 4, c8 = c7 + 4;
        for (int tb = 0; tb < c8; tb += G) {
            const bool valid = tb + VBLK < c8; const int t = valid ? tb + VBLK : c8 - 1;
            if (t < c0) transpose_tile(p.in[2], 1024, INC, (bf16_t*)(ws + OFF_WINT), 1024, 3, t, tl, valid);
            else if (t < c1) transpose_tile(p.in[14], 1024, 1024, (bf16_t*)(ws + OFF_WOUTT), 1024, 0, t - c0, tl, valid);
            else if (t < c2) transpose_tile(p.in[17], 1024, DFF, (bf16_t*)(ws + OFF_WGUT), 1024, 1, t - c1, tl, valid);
            else if (t < c3) transpose_tile(p.in[18], 1024, DFF, (bf16_t*)(ws + OFF_WGUT), 1024, 2, t - c2, tl, valid);
            else if (t < c4) transpose_tile(p.in[19], DFF, 1024, (bf16_t*)(ws + OFF_WDT), DFF, 0, t - c3, tl, valid);
            else if (t < c5) transpose_tile(p.in[9], 2048, 256, (bf16_t*)(ws + OFF_W1T), 2048, 0, t - c4, tl, valid);
            else if (t < c6) transpose_tile(p.in[12], 2048, 256, (bf16_t*)(ws + OFF_W1T) + 256 * 2048, 2048, 0, t - c5, tl, valid);
            else if (t < c7) transpose_tile(p.in[10], 256, 64, (bf16_t*)(ws + OFF_W2T), 256, 0, t - c6, tl, valid);
            else transpose_tile(p.in[13], 256, 64, (bf16_t*)(ws + OFF_W2T) + 128 * 256, 256, 0, t - c7, tl, valid);
        }
    }
    for (int t = VBLK; t < 8; t += G) {
        const int kv = t >> 2, cgp = t & 3;
        const float* pos = p.in[kv ? 11 : 8];
        const float* w1 = p.in[kv ? 12 : 9];
        const int c = cgp * 64 + (tid & 63), part = tid >> 6;
        float acc = 0.f;
        for (int k = part * 512; k < part * 512 + 512; ++k) acc += pos[k] * w1[(size_t)k * 256 + c];
        __syncthreads();
        tl[part * 64 + (tid & 63)] = acc;
        __syncthreads();
        if (tid < 64) ((float*)(ws + OFF_B1))[kv * 256 + c] = (tl[tid] + tl[64 + tid]) + (tl[128 + tid] + tl[192 + tid]);
        __syncthreads();
    }
    {
        f32x2* tab = (f32x2*)(ws + OFF_ROPE);
        for (int i = VBLK * 256 + tid; i < 4096 * 32; i += G * 256) {
            const int pos = i >> 5, j = i & 31;
            const float inv = 1.0f / powf(10000.f, (float)(2 * j) / 64.f);
            const float ang = (float)pos * inv;
            f32x2 cs; cs.x = cosf(ang); cs.y = sinf(ang);
            tab[i] = cs;
        }
    }
    {
        const float* x = p.in[0]; const float* g = p.in[1];
        bf16_t* H = (bf16_t*)(ws + OFF_H);
        for (int row = VBLK * 4 + w; row < T; row += G * 4) {
            const float* xr = x + (size_t)row * 1024;
            f32x4 v[4]; float ss = 0.f;
#pragma unroll
            for (int i = 0; i < 4; ++i) { v[i] = *(const f32x4*)(xr + i * 256 + lane * 4); ss += v[i][0] * v[i][0] + v[i][1] * v[i][1] + v[i][2] * v[i][2] + v[i][3] * v[i][3]; }
            ss = wave_sum(ss);
            const float rstd = rsqrtf(ss * (1.f / 1024.f) + NORM_EPS);
#pragma unroll
            for (int i = 0; i < 4; ++i) {
                const f32x4 gg = *(const f32x4*)(g + i * 256 + lane * 4);
                u32x2 o; o.x = pk_bf16(v[i][0] * rstd * gg[0], v[i][1] * rstd * gg[1]); o.y = pk_bf16(v[i][2] * rstd * gg[2], v[i][3] * rstd * gg[3]);
                *(u32x2*)(H + (size_t)row * 1024 + i * 256 + lane * 4) = o;
            }
        }
    }
}

constexpr int GP = 144;
constexpr int GT = 128 * GP;
constexpr int DT = 16384;
constexpr int DSTAGE = 2 * DT;
#define LAS3 __attribute__((address_space(3)))
template <bool SWAP>
DI void gemm_compute(const unsigned char* base, const int (&ao)[4], const int (&bo)[4], f32x16 (&acc)[2][2]) {
#pragma unroll
    for (int s = 0; s < 4; ++s) {
        const bf16x8 a0 = *(const bf16x8*)(base + ao[s]), a1 = *(const bf16x8*)(base + ao[s] + 32 * 128);
        const bf16x8 b0 = *(const bf16x8*)(base + DT + bo[s]), b1 = *(const bf16x8*)(base + DT + bo[s] + 32 * 128);
        if (SWAP) {
            acc[0][0] = MFMA(b0, a0, acc[0][0]); acc[0][1] = MFMA(b1, a0, acc[0][1]);
            acc[1][0] = MFMA(b0, a1, acc[1][0]); acc[1][1] = MFMA(b1, a1, acc[1][1]);
        } else {
            acc[0][0] = MFMA(a0, b0, acc[0][0]); acc[0][1] = MFMA(a0, b1, acc[0][1]);
            acc[1][0] = MFMA(a1, b0, acc[1][0]); acc[1][1] = MFMA(a1, b1, acc[1][1]);
        }
    }
}
DI void gemm_dma(const bf16_t* ga, const bf16_t* gb, int lda, int ldb, int k0, unsigned char* stage_w) {
#pragma unroll
    for (int i = 0; i < 4; ++i) {
        __builtin_amdgcn_global_load_lds((const unsigned*)(ga + (size_t)(32 * i) * lda + k0), (LAS3 unsigned*)(stage_w + i * 4096), 16, 0, 0);
        __builtin_amdgcn_global_load_lds((const unsigned*)(gb + (size_t)(32 * i) * ldb + k0), (LAS3 unsigned*)(stage_w + DT + i * 4096), 16, 0, 0);
    }
}
template <bool SWAP>
DI void gemm_main(const bf16_t* __restrict__ Ag, int lda, const bf16_t* __restrict__ Bg, int ldb, int K, f32x16 (&acc)[2][2], unsigned char* lds, int probe = 0) {
    const int tid = VTID, lane = tid & 63, w = __builtin_amdgcn_readfirstlane(tid >> 6), wr = w >> 1, wc = w & 1, r = lane & 31, h = lane >> 5;
    const int row0 = 8 * w + (lane >> 3), kch = (lane & 7) ^ ((row0 >> 1) & 7);
    const bf16_t* ga = Ag + (size_t)row0 * lda + kch * 8;
    const bf16_t* gb = Bg + (size_t)row0 * ldb + kch * 8;
    unsigned char* st0 = lds + w * 1024;
    unsigned char* st1 = lds + DSTAGE + w * 1024;
    int ao[4], bo[4];
    {
        const int ra = wr * 64 + r, rb = wc * 64 + r;
        const int xa = h ^ ((ra >> 1) & 7), xb = h ^ ((rb >> 1) & 7);
#pragma unroll
        for (int s = 0; s < 4; ++s) { ao[s] = ra * 128 + ((xa ^ (2 * s)) << 4); bo[s] = rb * 128 + ((xb ^ (2 * s)) << 4); }
    }
    const int nk = K >> 6;
    if (probe != 1) gemm_dma(ga, gb, lda, ldb, 0, st0);
    __syncthreads();
    for (int kt = 0; kt < nk; kt += 2) {
        if (probe != 1) gemm_dma(ga, gb, lda, ldb, (kt + 1) * 64, st1);
        if (probe != 2) gemm_compute<SWAP>(lds, ao, bo, acc);
        __syncthreads();
        if (kt + 2 < nk && probe != 1) gemm_dma(ga, gb, lda, ldb, (kt + 2) * 64, st0);
        if (probe != 2) gemm_compute<SWAP>(lds + DSTAGE, ao, bo, acc);
        __syncthreads();
    }
}
DI void zero_acc(f32x16 (&acc)[2][2]) {
#pragma unroll
    for (int a = 0; a < 2; ++a)
#pragma unroll
        for (int b = 0; b < 2; ++b)
#pragma unroll
            for (int i = 0; i < 16; ++i) acc[a][b][i] = 0.f;
}
DI void tile_map(int t, int NT, int& mt, int& nt) {
    const int xcd = t & 7, j = t >> 3;
    const int grp = j / (8 * NT), rem = j - grp * 8 * NT;
    nt = rem >> 3; mt = xcd * 32 + grp * 8 + (rem & 7);
}
constexpr int CP = 132;
template <bool SWAP>
DI void acc_to_lds(const f32x16 (&acc)[2][2], unsigned char* lds) {
    const int lane = VTID & 63, w = VTID >> 6, wr = w >> 1, wc = w & 1, r = lane & 31, h = lane >> 5;
    float* base = (float*)lds + (SWAP ? ((wc * 64 + 4 * h) * CP + wr * 64 + r) : ((wr * 64 + 4 * h) * CP + wc * 64 + r));
#pragma unroll
    for (int mt = 0; mt < 2; ++mt)
#pragma unroll
        for (int nt = 0; nt < 2; ++nt)
#pragma unroll
            for (int i = 0; i < 16; ++i) {
                const int rr = (i & 3) + 8 * (i >> 2);
                if (SWAP) base[(nt * 32 + rr) * CP + mt * 32] = acc[mt][nt][i];
                else base[(mt * 32 + rr) * CP + nt * 32] = acc[mt][nt][i];
            }
}
DI void ld8(const float* q, float (&v)[8]) {
    const f32x4 a = *(const f32x4*)q, b = *(const f32x4*)(q + 4);
    v[0] = a[0]; v[1] = a[1]; v[2] = a[2]; v[3] = a[3]; v[4] = b[0]; v[5] = b[1]; v[6] = b[2]; v[7] = b[3];
}
DI u32x4 pk8(const float (&v)[8]) {
    u32x4 o; o.x = pk_bf16(v[0], v[1]); o.y = pk_bf16(v[2], v[3]); o.z = pk_bf16(v[4], v[5]); o.w = pk_bf16(v[6], v[7]);
    return o;
}
DI void out_plain(const unsigned char* lds, bf16_t* dst, size_t ldd, int nch_log2) {
    const float* Ct = (const float*)lds;
    const int total = 128 << nch_log2;
#pragma unroll 1
    for (int c = VTID; c < total; c += 256) {
        const int a = c >> nch_log2, ch = c & ((1 << nch_log2) - 1);
        float v[8]; ld8(Ct + a * CP + ch * 8, v);
        *(u32x4*)(dst + (size_t)a * ldd + ch * 8) = pk8(v);
    }
}

namespace pg8 {
#define PG8_LAS __attribute__((address_space(3)))
typedef unsigned short bf16_t;
typedef short bf16x8 __attribute__((ext_vector_type(8)));
typedef float f32x4 __attribute__((ext_vector_type(4)));
typedef unsigned u32x4 __attribute__((ext_vector_type(4)));
constexpr int BM = 256, BK = 64, HALF = 128, HTB = HALF * BK * 2  , STAGE_BYTES = 8 * HTB, NXCD = 8, WGM = 8;

__host__ __device__ __forceinline__ int lds_byte(int r, int c) { const int st = (r >> 4) * 2 + (c >> 5), rr = r & 15, cc = c & 31, ob = rr * 64 + cc * 2; return st * 1024 + (ob ^ (((ob >> 9) & 1) << 5)); }
__host__ __device__ __forceinline__ void stage_rc(int b, int& R, int& C) { const int st = b / 1024, sb = b % 1024, swz = sb ^ (((sb >> 9) & 1) << 5); R = (st >> 1) * 16 + swz / 64; C = (st & 1) * 32 + (swz % 64) / 2; }
__host__ __device__ __forceinline__ int perm32(int rho) { const int n = rho >> 4, i = rho & 15; return 8 * (i >> 2) + 4 * n + (i & 3); }

struct Unit { int pm, pn; };
struct Gemm { const bf16_t* A; const bf16_t* Bt; int M, N, K; };

struct StaticOrder {
    int nM, nN, nwg, G, c;
    __host__ __device__ void init(int M, int N, int G_, int c_) { nM = M / BM; nN = N / BM; nwg = nM * nN; G = G_; c = c_; }
    __host__ __device__ bool next(int i, Unit& u) const {
        const long L = (long)i * G + c; if (L >= nwg) return false;
        int wgid = (int)L; { const int q = nwg / NXCD, r = nwg % NXCD, xcd = wgid % NXCD, off = wgid / NXCD; wgid = (xcd < r ? xcd * (q + 1) : r * (q + 1) + (xcd - r) * q) + off; }
        const int nig = WGM * nN, gid = wgid / nig, fm = gid * WGM, gsz = (nM - fm) < WGM ? (nM - fm) : WGM;
        u.pm = fm + ((wgid % nig) % gsz); u.pn = (wgid % nig) / gsz; return true;
    }
    __device__ __forceinline__ void a_ready(const Unit&) const {}
    __device__ __forceinline__ void done(const Unit&) const {}
};

__device__ __forceinline__ unsigned cvt_pk_bf16(float lo, float hi) { unsigned r; asm volatile("v_cvt_pk_bf16_f32 %0, %1, %2" : "=v"(r) : "v"(lo), "v"(hi)); return r; }
typedef float f32x2 __attribute__((ext_vector_type(2)));
template <class Epi, class Sched, bool ALIGN_EPI = false, bool SP2 = false>
__device__ __forceinline__ void gemm_phase(PG8_LAS unsigned char* lds, const Gemm g, const Sched& S, const Epi& E) {
    const int tid = threadIdx.x, wid = __builtin_amdgcn_readfirstlane(tid >> 6), lane = tid & 63, wr = wid >> 2, wc = wid & 3, fr = lane & 15, fq = lane >> 4;
    const int K = g.K, nt = K / BK;
    unsigned voffA[2], voffB[2];
#pragma unroll
    for (int i = 0; i < 2; ++i) { int R, C; stage_rc(tid * 16 + i * 8192, R, C); const int Rb = Epi::PERM ? ((R & ~31) + perm32(R & 31)) : R;
        voffA[i] = (unsigned)(R * K + C) * 2u; voffB[i] = (unsigned)(Rb * K + C) * 2u; }
    const size_t kstep = (size_t)(BK * 2);
    const size_t hstep = (size_t)HALF * K * 2;
    const size_t tstep = 2 * hstep;
    const unsigned ldsw = (unsigned)wid * 1024u;
    const int aoff = lds_byte(wr * 64 + fr, fq * 8), boff = lds_byte(wc * 32 + fr, fq * 8);
#define PG8_SA(b, h) (((b) * 2 + (h)) * HTB)
#define PG8_SB(b, h) ((4 + (b) * 2 + (h)) * HTB)
#define PG8_STAGE(bufoff, gbase, voff) do { _Pragma("unroll") for (int _i = 0; _i < 2; ++_i) \
        __builtin_amdgcn_global_load_lds((const unsigned*)((const char*)(gbase) + (voff)[_i]), (PG8_LAS unsigned*)(lds + (bufoff) + ldsw + _i * 8192), 16, 0, 0); } while (0)
#define PG8_LDA(dst, b, h) do { _Pragma("unroll") for (int m = 0; m < 4; ++m) _Pragma("unroll") for (int k = 0; k < 2; ++k) dst[m][k] = *(const PG8_LAS bf16x8*)(lds + PG8_SA(b, h) + aoff + m * 2048 + k * 1024); } while (0)
#define PG8_LDB(dst, b, h) do { _Pragma("unroll") for (int n = 0; n < 2; ++n) _Pragma("unroll") for (int k = 0; k < 2; ++k) dst[n][k] = *(const PG8_LAS bf16x8*)(lds + PG8_SB(b, h) + boff + n * 2048 + k * 1024); } while (0)
#define PG8_MMA(ai, bj, At, Bt) do { __builtin_amdgcn_s_setprio(1); _Pragma("unroll") for (int m = 0; m < 4; ++m) _Pragma("unroll") for (int n = 0; n < 2; ++n) _Pragma("unroll") for (int k = 0; k < 2; ++k) \
        acc[ai][bj][m][n] = __builtin_amdgcn_mfma_f32_16x16x32_bf16(Bt[n][k], At[m][k], acc[ai][bj][m][n], 0, 0, 0); __builtin_amdgcn_s_setprio(0); } while (0)
#define PG8_WAIT_V(n) asm volatile("s_waitcnt vmcnt(" #n ")" ::: "memory")
#define PG8_WAIT_L(n) asm volatile("s_waitcnt lgkmcnt(" #n ")" ::: "memory")
#define PG8_BAR __builtin_amdgcn_s_barrier()
#define PG8_SCHED __builtin_amdgcn_sched_barrier(0)
    Unit cur, nxt; int ui = 0;
    if (!S.next(0, cur)) return;
    f32x4 acc[2][2][4][2];
#pragma unroll
    for (int a = 0; a < 2; ++a)
#pragma unroll
        for (int b = 0; b < 2; ++b)
#pragma unroll
            for (int m = 0; m < 4; ++m)
#pragma unroll
                for (int n = 0; n < 2; ++n) acc[a][b][m][n] = (f32x4){0.f, 0.f, 0.f, 0.f};
    bf16x8 At[4][2], B0[2][2], B1[2][2];
    const char* cA = (const char*)g.A + (size_t)cur.pm * tstep; const char* cB = (const char*)g.Bt + (size_t)cur.pn * tstep;
    S.a_ready(cur);
    if constexpr (SP2) {
        PG8_STAGE(PG8_SB(0, 0), cB, voffB); PG8_STAGE(PG8_SB(0, 1), cB + hstep, voffB); PG8_STAGE(PG8_SA(0, 0), cA, voffA); PG8_STAGE(PG8_SA(0, 1), cA + hstep, voffA);
        if (wr == 1) PG8_BAR;
        PG8_WAIT_V(2); PG8_BAR;
        PG8_STAGE(PG8_SB(1, 0), cB + kstep, voffB); PG8_STAGE(PG8_SA(1, 0), cA + kstep, voffA); PG8_STAGE(PG8_SB(1, 1), cB + hstep + kstep, voffB);
        PG8_WAIT_V(6); PG8_BAR;
    } else {
        PG8_STAGE(PG8_SB(0, 0), cB, voffB); PG8_STAGE(PG8_SA(0, 0), cA, voffA); PG8_STAGE(PG8_SB(0, 1), cB + hstep, voffB); PG8_STAGE(PG8_SA(0, 1), cA + hstep, voffA);
        if (wr == 1) PG8_BAR;
        PG8_WAIT_V(4); PG8_BAR;
        PG8_STAGE(PG8_SB(1, 0), cB + kstep, voffB); PG8_STAGE(PG8_SA(1, 0), cA + kstep, voffA); PG8_STAGE(PG8_SB(1, 1), cB + hstep + kstep, voffB);
        PG8_WAIT_V(6); PG8_BAR;
    }
    for (;;) {
        const bool has_next = S.next(ui + 1, nxt);
        const char* nA = has_next ? (const char*)g.A + (size_t)nxt.pm * tstep : cA; const char* nB = has_next ? (const char*)g.Bt + (size_t)nxt.pn * tstep : cB;
        for (int t = 0; t < nt; t += 2) {
            const bool last = (t == nt - 2);
            const char* a1 = cA + (size_t)(t + 1) * kstep;
            const char* a2 = last ? nA : cA + (size_t)(t + 2) * kstep; const char* b2 = last ? nB : cB + (size_t)(t + 2) * kstep;
            const char* a3 = a2 + kstep; const char* b3 = b2 + kstep;
            if (last && has_next) S.a_ready(nxt);
            if constexpr (SP2) {
            PG8_LDB(B0, 0, 0); PG8_LDB(B1, 0, 1); PG8_SCHED; PG8_LDA(At, 0, 0); PG8_STAGE(PG8_SA(1, 1), a1 + hstep, voffA);
            PG8_WAIT_V(8); PG8_WAIT_L(0); PG8_BAR; PG8_MMA(0, 0, At, B0); PG8_MMA(0, 1, At, B1); PG8_BAR; PG8_SCHED;
            PG8_LDA(At, 0, 1); PG8_STAGE(PG8_SB(0, 0), b2, voffB); PG8_STAGE(PG8_SB(0, 1), b2 + hstep, voffB); PG8_STAGE(PG8_SA(0, 0), a2, voffA);
            PG8_WAIT_V(8); PG8_WAIT_L(0); PG8_BAR; PG8_MMA(1, 0, At, B0); PG8_MMA(1, 1, At, B1); PG8_BAR; PG8_SCHED;
            PG8_LDB(B0, 1, 0); PG8_LDB(B1, 1, 1); PG8_SCHED; PG8_LDA(At, 1, 0); PG8_STAGE(PG8_SA(0, 1), a2 + hstep, voffA);
            PG8_WAIT_V(8); PG8_WAIT_L(0); PG8_BAR; PG8_MMA(0, 0, At, B0); PG8_MMA(0, 1, At, B1); PG8_BAR; PG8_SCHED;
            PG8_LDA(At, 1, 1); PG8_STAGE(PG8_SB(1, 0), b3, voffB); PG8_STAGE(PG8_SB(1, 1), b3 + hstep, voffB); PG8_STAGE(PG8_SA(1, 0), a3, voffA);
            PG8_WAIT_V(8); PG8_WAIT_L(0); PG8_BAR; PG8_MMA(1, 0, At, B0); PG8_MMA(1, 1, At, B1); PG8_BAR; PG8_SCHED;
            } else {
            PG8_LDB(B0, 0, 0); PG8_SCHED; PG8_LDA(At, 0, 0); PG8_STAGE(PG8_SA(1, 1), a1 + hstep, voffA);
            PG8_WAIT_L(8); PG8_BAR; PG8_WAIT_L(0); PG8_MMA(0, 0, At, B0); PG8_BAR; PG8_SCHED;
            PG8_LDB(B1, 0, 1); PG8_STAGE(PG8_SB(0, 0), b2, voffB);
            PG8_BAR; PG8_WAIT_L(0); PG8_MMA(0, 1, At, B1); PG8_BAR;
            PG8_LDA(At, 0, 1); PG8_STAGE(PG8_SA(0, 0), a2, voffA);
            PG8_BAR; PG8_WAIT_L(0); PG8_MMA(1, 0, At, B0); PG8_BAR; PG8_SCHED;
            PG8_STAGE(PG8_SB(0, 1), b2 + hstep, voffB);
            PG8_WAIT_V(6); PG8_BAR; PG8_MMA(1, 1, At, B1); PG8_BAR;
            PG8_LDB(B0, 1, 0); PG8_SCHED; PG8_LDA(At, 1, 0); PG8_STAGE(PG8_SA(0, 1), a2 + hstep, voffA);
            PG8_WAIT_L(8); PG8_BAR; PG8_WAIT_L(0); PG8_MMA(0, 0, At, B0); PG8_BAR; PG8_SCHED;
            PG8_LDB(B1, 1, 1); PG8_STAGE(PG8_SB(1, 0), b3, voffB);
            PG8_BAR; PG8_WAIT_L(0); PG8_MMA(0, 1, At, B1); PG8_BAR;
            PG8_LDA(At, 1, 1); PG8_STAGE(PG8_SA(1, 0), a3, voffA);
            PG8_BAR; PG8_WAIT_L(0); PG8_MMA(1, 0, At, B0); PG8_BAR; PG8_SCHED;
            PG8_STAGE(PG8_SB(1, 1), b3 + hstep, voffB);
            PG8_WAIT_V(6); PG8_BAR; PG8_MMA(1, 1, At, B1); PG8_BAR;
            }
        }
        if constexpr (ALIGN_EPI) { if (wr == 0) PG8_BAR; }
        if constexpr (!Epi::AFTER_DRAIN) { E(acc, cur, wr, wc, fr, fq); S.done(cur); }
        if (!has_next) break;
#pragma unroll
        for (int a = 0; a < 2; ++a)
#pragma unroll
            for (int b = 0; b < 2; ++b)
#pragma unroll
                for (int m = 0; m < 4; ++m)
#pragma unroll
                    for (int n = 0; n < 2; ++n) acc[a][b][m][n] = (f32x4){0.f, 0.f, 0.f, 0.f};
        cur = nxt; cA = nA; cB = nB; ++ui;
        if constexpr (ALIGN_EPI) { if (wr == 1) PG8_BAR; }
    }
    PG8_WAIT_V(0);
    if constexpr (!ALIGN_EPI) { if (wr == 0) PG8_BAR; }
    PG8_BAR;
    if constexpr (Epi::AFTER_DRAIN) { E.fused(acc, cur, wr, wc, fr, fq, lds, wid, lane); S.done(cur); }
#undef PG8_SA
#undef PG8_SB
#undef PG8_STAGE
#undef PG8_LDA
#undef PG8_LDB
#undef PG8_MMA
#undef PG8_WAIT_V
#undef PG8_WAIT_L
#undef PG8_BAR
#undef PG8_SCHED
}


struct EpiPlain {
    static constexpr bool PERM = true, AFTER_DRAIN = false;
    bf16_t* O; int ldc;
    __device__ __forceinline__ void operator()(const f32x4 (&acc)[2][2][4][2], const Unit& u, int wr, int wc, int fr, int fq) const {
        bf16_t* base = O + (size_t)(u.pm * BM + wr * 64 + fr) * ldc + u.pn * BM + wc * 32 + 8 * fq;
#pragma unroll
        for (int ai = 0; ai < 2; ++ai)
#pragma unroll
            for (int m = 0; m < 4; ++m) {
                bf16_t* rowp = base + (size_t)(ai * HALF + m * 16) * ldc;
#pragma unroll
                for (int bj = 0; bj < 2; ++bj) {
                    const f32x4 v0 = acc[ai][bj][m][0], v1 = acc[ai][bj][m][1];
                    u32x4 w; w.x = cvt_pk_bf16(v0[0], v0[1]); w.y = cvt_pk_bf16(v0[2], v0[3]); w.z = cvt_pk_bf16(v1[0], v1[1]); w.w = cvt_pk_bf16(v1[2], v1[3]);
                    *(u32x4*)(rowp + bj * HALF) = w;
                }
            }
    }
};
struct EpiSwiGLU {
    static constexpr bool PERM = true, AFTER_DRAIN = false;
    bf16_t* ACT; int ldc;
    __device__ __forceinline__ void operator()(const f32x4 (&acc)[2][2][4][2], const Unit& u, int wr, int wc, int fr, int fq) const {
        bf16_t* base = ACT + (size_t)(u.pm * BM + wr * 64 + fr) * ldc + ((u.pn * BM + wc * 32 + 8 * fq) >> 1);
#pragma unroll
        for (int ai = 0; ai < 2; ++ai)
#pragma unroll
            for (int m = 0; m < 4; ++m) {
                bf16_t* rowp = base + (size_t)(ai * HALF + m * 16) * ldc;
#pragma unroll
                for (int bj = 0; bj < 2; ++bj) {
                    const f32x4 g = acc[ai][bj][m][0], up = acc[ai][bj][m][1];
                    float a[4];
#pragma unroll
                    for (int e = 0; e < 4; ++e) a[e] = g[e] * __builtin_amdgcn_rcpf(1.f + __expf(-g[e])) * up[e];
                    typedef unsigned u32x2v __attribute__((ext_vector_type(2)));
                    u32x2v w; w.x = cvt_pk_bf16(a[0], a[1]); w.y = cvt_pk_bf16(a[2], a[3]);
                    *(u32x2v*)(rowp + bj * (HALF / 2)) = w;
                }
            }
    }
};
struct EpiInproj {
    static constexpr bool PERM = true, AFTER_DRAIN = false;
    unsigned char* ws; size_t off_qd, off_kd, off_vdt, off_qn, off_kct, off_vct, off_ks, off_vst, off_kw, off_vwt, off_gates, off_rope;
    __device__ __forceinline__ void operator()(const f32x4 (&acc)[2][2][4][2], const Unit& u, int wr, int wc, int fr, int fq) const {
        typedef unsigned u32x2v __attribute__((ext_vector_type(2)));
        typedef float f32x2v __attribute__((ext_vector_type(2)));
        const int row0 = u.pm * BM + wr * 64 + fr;
        const int b = row0 >> 12, pos0 = row0 & 4095;
#pragma unroll
        for (int bj = 0; bj < 2; ++bj) {
            const int cb = u.pn * BM + bj * HALF;
            const int cl = wc * 32 + 8 * fq;
            int kind = 4; size_t off = 0; int hidx = 0;
            if (cb < 512) { kind = 0; off = off_qd; hidx = b * 8 + ((cb + cl) >> 6); }
            else if (cb < 1024) { kind = 0; off = off_kd; hidx = b * 8 + ((cb - 512 + cl) >> 6); }
            else if (cb < 1536) { kind = 2; off = off_vdt; hidx = b * 4 + ((cb - 1024) >> 7); }
            else if (cb < 2048) { kind = 0; off = off_qn; hidx = b * 8 + ((cb - 1536 + cl) >> 6); }
            else if (cb == 2048) { kind = 0; off = off_kct; hidx = b * 2 + (cl >> 6); }
            else if (cb == 2176) { kind = 1; off = off_vct; hidx = b * 2 + (cl >> 6); }
            else if (cb == 2304) { kind = 0; off = off_ks; hidx = b * 2 + (cl >> 6); }
            else if (cb == 2432) { kind = 3; off = off_vst; hidx = b * 2 + (cl >> 6); }
            else if (cb == 2560) { kind = 0; off = off_kw; hidx = b * 2 + (cl >> 6); }
            else if (cb == 2688) { kind = 3; off = off_vwt; hidx = b * 2 + (cl >> 6); }
            else if (cb == 2816) kind = 5;
            if (kind == 0) {
                const int g4 = 4 * (((cl & 63) >> 3));
                bf16_t* dst = (bf16_t*)(ws + off) + ((size_t)hidx * 4096 + pos0) * 64 + g4;
                const f32x2v* tab = (const f32x2v*)(ws + off_rope) + (size_t)pos0 * 32 + g4;
#pragma unroll
                for (int ai = 0; ai < 2; ++ai)
#pragma unroll
                    for (int m = 0; m < 4; ++m) {
                        const int dp = ai * HALF + m * 16;
                        const f32x4 x1 = acc[ai][bj][m][0], x2 = acc[ai][bj][m][1];
                        const f32x4 t01 = *(const f32x4*)(tab + (size_t)dp * 32), t23 = *(const f32x4*)(tab + (size_t)dp * 32 + 2);
                        const float c0 = t01[0], s0 = t01[1], c1 = t01[2], s1 = t01[3], c2 = t23[0], s2 = t23[1], c3 = t23[2], s3 = t23[3];
                        u32x2v lo, hi;
                        lo.x = cvt_pk_bf16(x1[0] * c0 - x2[0] * s0, x1[1] * c1 - x2[1] * s1); lo.y = cvt_pk_bf16(x1[2] * c2 - x2[2] * s2, x1[3] * c3 - x2[3] * s3);
                        hi.x = cvt_pk_bf16(x1[0] * s0 + x2[0] * c0, x1[1] * s1 + x2[1] * c1); hi.y = cvt_pk_bf16(x1[2] * s2 + x2[2] * c2, x1[3] * s3 + x2[3] * c3);
                        *(u32x2v*)(dst + (size_t)dp * 64) = lo; *(u32x2v*)(dst + (size_t)dp * 64 + 32) = hi;
                    }
            } else if (kind == 1) {
                bf16_t* dst = (bf16_t*)(ws + off) + ((size_t)hidx * 4096 + pos0) * 64 + (cl & 63);
#pragma unroll
                for (int ai = 0; ai < 2; ++ai)
#pragma unroll
                    for (int m = 0; m < 4; ++m) {
                        const f32x4 v0 = acc[ai][bj][m][0], v1 = acc[ai][bj][m][1];
                        u32x4 w; w.x = cvt_pk_bf16(v0[0], v0[1]); w.y = cvt_pk_bf16(v0[2], v0[3]); w.z = cvt_pk_bf16(v1[0], v1[1]); w.w = cvt_pk_bf16(v1[2], v1[3]);
                        *(u32x4*)(dst + (size_t)(ai * HALF + m * 16) * 64) = w;
                    }
            } else if (kind == 2 || kind == 3) {
                const int dv = (kind == 2) ? 128 : 64;
                const int e0 = (kind == 2) ? cl : (cl & 63);
#pragma unroll
                for (int ai = 0; ai < 2; ++ai) {
                    const int pa = pos0 + ai * HALF;
                    bf16_t* dst = (bf16_t*)(ws + off) + (((size_t)hidx * 64 + (pa >> 6)) * dv + e0) * 64 + (pa & 63);
#pragma unroll
                    for (int m = 0; m < 4; ++m)
#pragma unroll
                        for (int n = 0; n < 2; ++n)
#pragma unroll
                            for (int j = 0; j < 4; ++j) {
                                const unsigned pk = cvt_pk_bf16(acc[ai][bj][m][n][j], 0.f);
                                dst[(4 * n + j) * 64 + 16 * m] = (bf16_t)(pk & 0xffffu);
                            }
                }
            } else if (kind == 5) {
                if (wc == 0 && fq < 3) {
                    float* gates = (float*)(ws + off_gates) + (size_t)row0 * 24 + 8 * fq;
#pragma unroll
                    for (int ai = 0; ai < 2; ++ai)
#pragma unroll
                        for (int m = 0; m < 4; ++m) {
                            f32x4 a = acc[ai][bj][m][0], c = acc[ai][bj][m][1];
#pragma unroll
                            for (int e = 0; e < 4; ++e) { a[e] = 1.f / (1.f + __expf(-a[e])); c[e] = 1.f / (1.f + __expf(-c[e])); }
                            float* gp = gates + (size_t)(ai * HALF + m * 16) * 24;
                            *(f32x4*)gp = a; *(f32x4*)(gp + 4) = c;
                        }
                }
            }
        }
    }
};
}

DI void epi_inproj(const Params& p, const unsigned char* lds, int m0, int n0) {
    unsigned char* ws = p.ws;
    const float* Ct = (const float*)lds;
    const int b = m0 >> 12, pos0 = m0 & 4095;
    int tid = VTID; asm volatile("" : "+v"(tid));
    if (n0 == 2816) {
        float* gates = (float*)(ws + OFF_GATES);
#pragma unroll 1
        for (int c = tid; c < 128 * 3; c += 256) {
            const int a = c / 3, ch = c - a * 3;
            float v[8]; ld8(Ct + a * CP + ch * 8, v);
            f32x4 o0, o1;
            o0[0] = sigmoidf(v[0]); o0[1] = sigmoidf(v[1]); o0[2] = sigmoidf(v[2]); o0[3] = sigmoidf(v[3]);
            o1[0] = sigmoidf(v[4]); o1[1] = sigmoidf(v[5]); o1[2] = sigmoidf(v[6]); o1[3] = sigmoidf(v[7]);
            float* g = gates + (size_t)(m0 + a) * 24 + ch * 8;
            *(f32x4*)g = o0; *(f32x4*)(g + 4) = o1;
        }
        return;
    }
    const bool tr = (n0 >= 1024 && n0 < 1536) || n0 == 2432 || n0 == 2688;
    if (tr) {
        bf16_t* dst; int hshift, hbase, nbase;
        if (n0 < 1536) { dst = (bf16_t*)(ws + OFF_VDT); hshift = 7; hbase = b * 4; nbase = 1024; }
        else if (n0 == 2432) { dst = (bf16_t*)(ws + OFF_VST); hshift = 6; hbase = b * 2; nbase = 2432; }
        else { dst = (bf16_t*)(ws + OFF_VWT); hshift = 6; hbase = b * 2; nbase = 2688; }
#pragma unroll 1
        for (int c = tid; c < 2048; c += 256) {
            const int a = c >> 4, ch = c & 15;
            const int cr = n0 + a - nbase;
            const int hidx = hbase + (cr >> hshift), e = cr & ((1 << hshift) - 1);
            float v[8]; ld8(Ct + a * CP + ch * 8, v);
            const int pos = pos0 + ch * 8;
            *(u32x4*)(dst + ((((size_t)hidx * 64 + (pos >> 6)) << hshift) + e) * 64 + (pos & 63)) = pk8(v);
        }
        return;
    }
    if (n0 == 2176) {
        bf16_t* dst = (bf16_t*)(ws + OFF_VCT);
#pragma unroll 1
        for (int c = tid; c < 2048; c += 256) {
            const int a = c >> 4, ch = c & 15;
            const int hidx = b * 2 + (ch >> 3);
            float v[8]; ld8(Ct + a * CP + ch * 8, v);
            *(u32x4*)(dst + ((size_t)hidx * 4096 + pos0 + a) * 64 + (ch & 7) * 8) = pk8(v);
        }
        return;
    }
    {
        bf16_t* dst; int hbase;
        if (n0 < 512) { dst = (bf16_t*)(ws + OFF_QD); hbase = b * 8 + (n0 >> 6); }
        else if (n0 < 1024) { dst = (bf16_t*)(ws + OFF_KD); hbase = b * 8 + ((n0 - 512) >> 6); }
        else if (n0 < 2048) { dst = (bf16_t*)(ws + OFF_QN); hbase = b * 8 + ((n0 - 1536) >> 6); }
        else if (n0 == 2048) { dst = (bf16_t*)(ws + OFF_KCT); hbase = b * 2; }
        else if (n0 == 2304) { dst = (bf16_t*)(ws + OFF_KS); hbase = b * 2; }
        else { dst = (bf16_t*)(ws + OFF_KW); hbase = b * 2; }
        const float* tab = (const float*)(ws + OFF_ROPE);
#pragma unroll 1
        for (int c = tid; c < 1024; c += 256) {
            const int a = c >> 3, hd = (c >> 2) & 1, cc = c & 3;
            float x1[8], x2[8], cs[16];
            ld8(Ct + a * CP + hd * 64 + cc * 8, x1); ld8(Ct + a * CP + hd * 64 + 32 + cc * 8, x2);
            const int pos = pos0 + a;
            const float* tp = tab + ((size_t)pos * 32 + cc * 8) * 2;
            {
                const f32x4 t0 = *(const f32x4*)tp, t1 = *(const f32x4*)(tp + 4), t2 = *(const f32x4*)(tp + 8), t3 = *(const f32x4*)(tp + 12);
                cs[0] = t0[0]; cs[1] = t0[1]; cs[2] = t0[2]; cs[3] = t0[3]; cs[4] = t1[0]; cs[5] = t1[1]; cs[6] = t1[2]; cs[7] = t1[3];
                cs[8] = t2[0]; cs[9] = t2[1]; cs[10] = t2[2]; cs[11] = t2[3]; cs[12] = t3[0]; cs[13] = t3[1]; cs[14] = t3[2]; cs[15] = t3[3];
            }
            float y1[8], y2[8];
#pragma unroll
            for (int e = 0; e < 8; ++e) { const float cv = cs[2 * e], sv = cs[2 * e + 1]; y1[e] = x1[e] * cv - x2[e] * sv; y2[e] = x1[e] * sv + x2[e] * cv; }
            bf16_t* d = dst + ((size_t)(hbase + hd) * 4096 + pos) * 64 + cc * 8;
            *(u32x4*)d = pk8(y1); *(u32x4*)(d + 32) = pk8(y2);
        }
    }
}
DI void phase1(const Params& p, unsigned char* lds) {
    pg8::Gemm g; g.A = (const bf16_t*)(p.ws + OFF_H); g.Bt = (const bf16_t*)(p.ws + OFF_WINT); g.M = T; g.N = INP; g.K = 1024;
    pg8::StaticOrder S; S.init(T, INP, (int)gridDim.x, (int)blockIdx.x);
    pg8::EpiInproj E; E.ws = p.ws; E.off_qd = OFF_QD; E.off_kd = OFF_KD; E.off_vdt = OFF_VDT; E.off_qn = OFF_QN; E.off_kct = OFF_KCT; E.off_vct = OFF_VCT;
    E.off_ks = OFF_KS; E.off_vst = OFF_VST; E.off_kw = OFF_KW; E.off_vwt = OFF_VWT; E.off_gates = OFF_GATES; E.off_rope = OFF_ROPE;
    pg8::gemm_phase<pg8::EpiInproj, pg8::StaticOrder, true, true>((PG8_LAS unsigned char*)lds, g, S, E);
    __syncthreads();
}

DI void phase2(const Params& p, unsigned char* lds) {
    unsigned char* hl = lds + VHALF * HALF_LDS;
    for (int t = blockIdx.x; t < 128; t += gridDim.x) {
        const int kv = t >> 6, bg = (t >> 2) & 15, mt = (t >> 1) & 1, nt = t & 1, kh = VHALF * 1024;
        const bf16_t* A = (const bf16_t*)(p.ws + (kv ? OFF_VCT : OFF_KCT)) + (size_t)bg * 4096 * 64 + (size_t)mt * 128 * 1024 + kh;
        const bf16_t* B = (const bf16_t*)(p.ws + OFF_W1T) + (size_t)kv * 256 * 2048 + (size_t)nt * 128 * 2048 + kh;
        f32x16 acc[2][2]; zero_acc(acc);
        gemm_main<false>(A, 1024, B, 2048, 1024, acc, hl);
        acc_to_lds<false>(acc, hl);
        __syncthreads();
        const float* b1 = (const float*)(p.ws + OFF_B1) + kv * 256 + nt * 128;
        bf16_t* HID = (bf16_t*)(p.ws + OFF_HID) + (size_t)(kv * 16 + bg) * 65536 + (size_t)mt * 128 * 256 + nt * 128;
        const float* C0 = (const float*)lds; const float* C1 = (const float*)(lds + HALF_LDS);
#pragma unroll 1
        for (int c = threadIdx.x; c < 2048; c += 512) {
            const int a = c >> 4, ch = c & 15;
            float v[8], v2[8], bb[8]; ld8(C0 + a * CP + ch * 8, v); ld8(C1 + a * CP + ch * 8, v2); ld8(b1 + ch * 8, bb);
#pragma unroll
            for (int e = 0; e < 8; ++e) { const float z = (v[e] + v2[e]) + bb[e]; v[e] = z * sigmoidf(z); }
            *(u32x4*)(HID + (size_t)a * 256 + ch * 8) = pk8(v);
        }
        __syncthreads();
    }
}
DI void phase3(const Params& p, unsigned char* lds) {
    unsigned char* hl = lds + VHALF * HALF_LDS;
    for (int t = blockIdx.x; t < 64; t += gridDim.x) {
        const int kv = t >> 5, bg = (t >> 1) & 15, mt = t & 1, kh = VHALF * 128;
        const bf16_t* A = (const bf16_t*)(p.ws + OFF_HID) + (size_t)(kv * 16 + bg) * 65536 + (size_t)mt * 128 * 256 + kh;
        const bf16_t* B = (const bf16_t*)(p.ws + OFF_W2T) + (size_t)kv * 128 * 256 + kh;
        f32x16 acc[2][2]; zero_acc(acc);
        if (kv == 0) { gemm_main<false>(A, 256, B, 256, 128, acc, hl); acc_to_lds<false>(acc, hl); }
        else { gemm_main<true>(A, 256, B, 256, 128, acc, hl); acc_to_lds<true>(acc, hl); }
        __syncthreads();
        const float* C0 = (const float*)lds; const float* C1 = (const float*)(lds + HALF_LDS);
        if (kv == 0) {
            bf16_t* KC = (bf16_t*)(p.ws + OFF_KCMP) + (size_t)bg * 256 * 64 + (size_t)mt * 128 * 64;
#pragma unroll 1
            for (int c = threadIdx.x; c < 128 * 8; c += 512) {
                const int a = c >> 3, ch = c & 7;
                float v[8], v2[8]; ld8(C0 + a * CP + ch * 8, v); ld8(C1 + a * CP + ch * 8, v2);
#pragma unroll
                for (int e = 0; e < 8; ++e) v[e] += v2[e];
                *(u32x4*)(KC + (size_t)a * 64 + ch * 8) = pk8(v);
            }
        } else {
            bf16_t* VC = (bf16_t*)(p.ws + OFF_VCMPT) + (size_t)bg * 64 * 256;
#pragma unroll 1
            for (int c = threadIdx.x; c < 64 * 16; c += 512) {
                const int a = c >> 4, ch = c & 15;
                const int n = mt * 128 + ch * 8;
                float v[8], v2[8]; ld8(C0 + a * CP + ch * 8, v); ld8(C1 + a * CP + ch * 8, v2);
#pragma unroll
                for (int e = 0; e < 8; ++e) v[e] += v2[e];
                *(u32x4*)(VC + ((size_t)(n >> 6) * 64 + a) * 64 + (n & 63)) = pk8(v);
            }
        }
        __syncthreads();
    }
}

constexpr int KP = 144;
constexpr int VP = 144;
constexpr int KT_BYTES = 64 * KP;
constexpr float SM_C = 0.125f * 1.4426950408889634f;
#define NEG_INF (-__builtin_inff())

template <int DV> struct KVStage { u32x4 k[1]; u32x4 v[DV / 64]; };

template <int DV, bool HAS_V>
DI void kv_gload(KVStage<DV>& st, const bf16_t* __restrict__ Kb, const bf16_t* __restrict__ VTb, int ldv, int key0) {
    const int tid = threadIdx.x;
    st.k[0] = *(const u32x4*)(Kb + (size_t)(key0 + (tid >> 3)) * 64 + (tid & 7) * 8);
    if (HAS_V) {
#pragma unroll
        for (int i = 0; i < DV / 64; ++i) { const int c = tid + 512 * i; st.v[i] = *(const u32x4*)(VTb + (size_t)(key0 >> 6) * (DV * 64) + c * 8); }
    }
}
template <int DV, bool HAS_V>
DI void kv_sstore(const KVStage<DV>& st, unsigned char* buf) {
    const int tid = threadIdx.x;
    *(u32x4*)(buf + (tid >> 3) * KP + (tid & 7) * 16) = st.k[0];
    if (HAS_V) {
#pragma unroll
        for (int i = 0; i < DV / 64; ++i) {
            const int c = tid + 512 * i, kc = c & 7; unsigned char* q = buf + KT_BYTES + (c >> 3) * VP + (kc >> 1) * 32 + (kc & 1) * 8;
            u32x2 lo, hi; lo.x = st.v[i].x; lo.y = st.v[i].y; hi.x = st.v[i].z; hi.y = st.v[i].w;
            *(u32x2*)q = lo; *(u32x2*)(q + 16) = hi;
        }
    }
}
template <int DV, bool HAS_V, class Next, class Body>
DI void kv_loop(unsigned char* lds, const bf16_t* Kb, const bf16_t* VTb, int ldv, int nt, int j0, Next next, Body body, int probe = 0) {
    constexpr int SB = KT_BYTES + (HAS_V ? DV * VP : 0);
    KVStage<DV> st;
    int jn = j0;
    if (probe != 1) { kv_gload<DV, HAS_V>(st, Kb, VTb, ldv, jn * 64); kv_sstore<DV, HAS_V>(st, lds); }
    __syncthreads();
    for (int i = 0; i < nt; ++i) {
        const int j = jn;
        const bool more = (i + 1 < nt);
        if (more) { jn = next(j); if (probe != 1) kv_gload<DV, HAS_V>(st, Kb, VTb, ldv, jn * 64); }
        if (probe != 2) body(j, (const unsigned char*)(lds + (i & 1) * SB));
        if (more && probe != 1) kv_sstore<DV, HAS_V>(st, lds + ((i + 1) & 1) * SB);
        __syncthreads();
    }
}
DI void attn_scores(const unsigned char* kb, const bf16x8 (&qf)[4], int r, int h, f32x16& s0, f32x16& s1) {
#pragma unroll
    for (int i = 0; i < 16; ++i) { s0[i] = 0.f; s1[i] = 0.f; }
#pragma unroll
    for (int s = 0; s < 4; ++s) {
        const bf16x8 k0 = *(const bf16x8*)(kb + r * KP + s * 32 + h * 16);
        const bf16x8 k1 = *(const bf16x8*)(kb + (32 + r) * KP + s * 32 + h * 16);
        s0 = MFMA(k0, qf[s], s0); s1 = MFMA(k1, qf[s], s1);
    }
}
DI void pack_p(const f32x16& p0, const f32x16& p1, bf16x8 (&pf)[2][2]) {
#pragma unroll
    for (int sp = 0; sp < 2; ++sp) {
        u32x4 a, b;
        a.x = pk_bf16(p0[8 * sp + 0], p0[8 * sp + 1]); a.y = pk_bf16(p0[8 * sp + 2], p0[8 * sp + 3]);
        a.z = pk_bf16(p0[8 * sp + 4], p0[8 * sp + 5]); a.w = pk_bf16(p0[8 * sp + 6], p0[8 * sp + 7]);
        b.x = pk_bf16(p1[8 * sp + 0], p1[8 * sp + 1]); b.y = pk_bf16(p1[8 * sp + 2], p1[8 * sp + 3]);
        b.z = pk_bf16(p1[8 * sp + 4], p1[8 * sp + 5]); b.w = pk_bf16(p1[8 * sp + 6], p1[8 * sp + 7]);
        pf[0][sp] = __builtin_bit_cast(bf16x8, a); pf[1][sp] = __builtin_bit_cast(bf16x8, b);
    }
}
template <int DV>
DI void attn_pv(const unsigned char* vb, const bf16x8 (&pf)[2][2], int r, int h, f32x16 (&o)[DV / 32]) {
#pragma unroll
    for (int dt = 0; dt < DV / 32; ++dt)
#pragma unroll
        for (int mt = 0; mt < 2; ++mt)
#pragma unroll
            for (int sp = 0; sp < 2; ++sp) {
                const bf16x8 vf = *(const bf16x8*)(vb + (dt * 32 + r) * VP + (2 * mt + sp) * 32 + h * 16);
                o[dt] = MFMA(vf, pf[mt][sp], o[dt]);
            }
}
constexpr float SM_THR = 7.2f;
typedef float f32x8 __attribute__((ext_vector_type(8)));
DI float hsum16(const f32x16& v) {
    const f32x8 a = __builtin_shufflevector(v, v, 0, 1, 2, 3, 4, 5, 6, 7) + __builtin_shufflevector(v, v, 8, 9, 10, 11, 12, 13, 14, 15);
    const f32x4 b = __builtin_shufflevector(a, a, 0, 1, 2, 3) + __builtin_shufflevector(a, a, 4, 5, 6, 7);
    return (b[0] + b[1]) + (b[2] + b[3]);
}
template <int DV>
DI void attn_softmax_pv(f32x16& s0, f32x16& s1, float& m, float& l, f32x16 (&o)[DV / 32], const unsigned char* vb, int r, int h, bool on = true) {
    s0 = s0 * SM_C; s1 = s1 * SM_C;
    const f32x16 t = __builtin_elementwise_max(s0, s1);
    float mx = fmaxf(fmaxf(fmaxf(t[0], t[1]), fmaxf(t[2], t[3])), fmaxf(fmaxf(t[4], t[5]), fmaxf(t[6], t[7])));
    mx = fmaxf(mx, fmaxf(fmaxf(fmaxf(t[8], t[9]), fmaxf(t[10], t[11])), fmaxf(fmaxf(t[12], t[13]), fmaxf(t[14], t[15]))));
    mx = on ? mx : NEG_INF;
    mx = xhalf_max(mx);
    if (!__all(mx - m <= SM_THR)) {
        const float mn = fmaxf(m, mx);
        const float alpha = fast_exp2(m - mn);
        l *= alpha; m = mn;
#pragma unroll
        for (int dt = 0; dt < DV / 32; ++dt) o[dt] = o[dt] * alpha;
    }
    const float msub = on ? m : __builtin_inff();
    s0 = s0 - msub; s1 = s1 - msub;
#pragma unroll
    for (int i = 0; i < 16; ++i) { s0[i] = fast_exp2(s0[i]); s1[i] = fast_exp2(s1[i]); }
    const f32x16 sm = s0 + s1;
    l += xhalf_sum(hsum16(sm));
    bf16x8 pf[2][2]; pack_p(s0, s1, pf);
    attn_pv<DV>(vb, pf, r, h, o);
}

DI void diff_unit(const Params& p, int u, unsigned char* lds, int probe = 0) {
    int tid_ = threadIdx.x; asm volatile("" : "+v"(tid_));
    const int lane = tid_ & 63, w = tid_ >> 6, r = lane & 31, h = lane >> 5;
    const int qt = 15 - (u >> 5), bh = u & 31, b = bh >> 2, hh = bh & 3;
    const int q0 = qt * 256, wq0 = q0 + 32 * w, qpos = wq0 + r;
    const int ntl = 4 * qt + 4;
    const float lam = ((const float*)(p.ws + OFF_CTL))[16];
    const bf16_t* VTb = (const bf16_t*)(p.ws + OFF_VDT) + (size_t)(b * 4 + hh) * 128 * 4096;
#pragma unroll 1
    for (int mp = 0; mp < 2; ++mp) {
        const size_t hoff = ((size_t)(b * 8 + hh * 2 + mp) * 4096) * 64;
        const bf16_t* Qb = (const bf16_t*)(p.ws + OFF_QD) + hoff;
        const bf16_t* Kb = (const bf16_t*)(p.ws + OFF_KD) + hoff;
        bf16x8 qf[4];
#pragma unroll
        for (int s = 0; s < 4; ++s) qf[s] = *(const bf16x8*)(Qb + (size_t)qpos * 64 + s * 16 + h * 8);
#pragma unroll
        for (int s = 0; s < 4; ++s) asm volatile("" : "+v"(qf[s]));
        f32x16 o[4];
#pragma unroll
        for (int dt = 0; dt < 4; ++dt)
#pragma unroll
            for (int i = 0; i < 16; ++i) o[dt][i] = 0.f;
        float m = -1e30f, l = 0.f;
        kv_loop<128, true>(lds, Kb, VTb, 4096, ntl, 0, [](int j) { return j + 1; }, [&](int j, const unsigned char* sb) {
            const int k0 = j * 64;
            if (k0 <= wq0 + 31) {
                f32x16 s0, s1; attn_scores(sb, qf, r, h, s0, s1);
                if (k0 + 63 > wq0) {
#pragma unroll
                    for (int i = 0; i < 16; ++i) {
                        const int kl = k0 + crow(i, h);
                        if (kl > qpos) s0[i] = NEG_INF;
                        if (kl + 32 > qpos) s1[i] = NEG_INF;
                    }
                }
                attn_softmax_pv<128>(s0, s1, m, l, o, sb + KT_BYTES, r, h);
            }
        }, probe);
        if (probe) {
            float chk = l + m;
#pragma unroll
            for (int dt = 0; dt < 4; ++dt)
#pragma unroll
                for (int i = 0; i < 16; ++i) chk += o[dt][i];
            if (chk == 1.2345e-30f) ((float*)(p.ws + OFF_CTL))[32] = chk;
            continue;
        }
        const float inv = 1.f / l;
        bf16_t* O = (bf16_t*)(p.ws + OFF_O) + ((size_t)b * 4096 + qpos) * 1024 + hh * 128;
        if (mp == 0) {
#pragma unroll
            for (int dt = 0; dt < 4; ++dt)
#pragma unroll
                for (int g4 = 0; g4 < 4; ++g4) {
                    u32x2 ov; ov.x = pk_bf16(o[dt][4 * g4] * inv, o[dt][4 * g4 + 1] * inv); ov.y = pk_bf16(o[dt][4 * g4 + 2] * inv, o[dt][4 * g4 + 3] * inv);
                    *(u32x2*)(O + dt * 32 + 8 * g4 + 4 * h) = ov;
                }
        } else {
            float ss = 0.f;
            const float li = lam * inv;
#pragma unroll
            for (int dt = 0; dt < 4; ++dt)
#pragma unroll
                for (int g4 = 0; g4 < 4; ++g4) {
                    const u32x2 pv = *(const u32x2*)(O + dt * 32 + 8 * g4 + 4 * h);
                    const float v0 = bflo(pv.x) - li * o[dt][4 * g4], v1 = bfhi(pv.x) - li * o[dt][4 * g4 + 1];
                    const float v2 = bflo(pv.y) - li * o[dt][4 * g4 + 2], v3 = bfhi(pv.y) - li * o[dt][4 * g4 + 3];
                    o[dt][4 * g4] = v0; o[dt][4 * g4 + 1] = v1; o[dt][4 * g4 + 2] = v2; o[dt][4 * g4 + 3] = v3;
                    ss += (v0 * v0 + v1 * v1) + (v2 * v2 + v3 * v3);
                }
            ss = xhalf_sum(ss);
            const float rstd = rsqrtf(ss * (1.f / 128.f) + NORM_EPS) * 0.8f;
            const float* sub = p.in[7];
#pragma unroll
            for (int dt = 0; dt < 4; ++dt)
#pragma unroll
                for (int g4 = 0; g4 < 4; ++g4) {
                    const int d = dt * 32 + 8 * g4 + 4 * h;
                    const f32x4 sg = *(const f32x4*)(sub + d);
                    u32x2 ov; ov.x = pk_bf16(o[dt][4 * g4] * rstd * sg[0], o[dt][4 * g4 + 1] * rstd * sg[1]);
                    ov.y = pk_bf16(o[dt][4 * g4 + 2] * rstd * sg[2], o[dt][4 * g4 + 3] * rstd * sg[3]);
                    *(u32x2*)(O + d) = ov;
                }
        }
    }
}

constexpr int NSA_IMPW = 36864;
constexpr int NSA_SEL = NSA_IMPW + 65536;
constexpr int NSA_UN = NSA_SEL + 512;
constexpr int NSA_FT = NSA_UN + 64;
constexpr int LDS_UNIT = 2 * 73728 + 16;
DI void nsa_unit(const Params& p, int u, unsigned char* lds, int probe = 0) {
    int tid_ = threadIdx.x; asm volatile("" : "+v"(tid_));
    const int lane = tid_ & 63, w = tid_ >> 6, r = lane & 31, h = lane >> 5;
    const int qt = 63 - (u >> 4), bg = u & 15, b = bg >> 1, g = bg & 1;
    const int hq = w >> 2, q0 = qt * 64, qb = q0 + 32 * hq, qpos = qb + r, head = g * 4 + (w & 3);
    float* IMPW = (float*)(lds + NSA_IMPW);
    u64* SEL = (u64*)(lds + NSA_SEL);
    u64* UN = (u64*)(lds + NSA_UN);
    const bf16_t* Qb = (const bf16_t*)(p.ws + OFF_QN) + ((size_t)(b * 8 + head) * 4096) * 64;
    bf16x8 qf[4];
#pragma unroll
    for (int s = 0; s < 4; ++s) qf[s] = *(const bf16x8*)(Qb + (size_t)qpos * 64 + s * 16 + h * 8);
#pragma unroll
    for (int s = 0; s < 4; ++s) asm volatile("" : "+v"(qf[s]));
    const float* gp = (const float*)(p.ws + OFF_GATES) + ((size_t)b * 4096 + qpos) * 24 + head * 3;
    auto inc = [](int j) { return j + 1; };
    f32x16 oacc[2];

    float* FT = (float*)(lds + NSA_FT);
    {
        const bf16_t* Kc = (const bf16_t*)(p.ws + OFF_KCMP) + (size_t)bg * 256 * 64;
        const bf16_t* VcT = (const bf16_t*)(p.ws + OFF_VCMPT) + (size_t)bg * 64 * 256;
        const int nmax = ((q0 + 32) >> 4) + 1, ntc = (nmax + 63) >> 6;
        const int nvalid = qpos >= 31 ? ((qpos - 31) >> 4) + 1 : 0;
        float m = -1e30f, l = 0.f, carry = 0.f;
        f32x16 oc[2];
#pragma unroll
        for (int dt = 0; dt < 2; ++dt)
#pragma unroll
            for (int i = 0; i < 16; ++i) oc[dt][i] = 0.f;
        kv_loop<64, true>(lds, Kc, VcT, 256, ntc, 0, inc, [&](int j, const unsigned char* sb) {
            f32x16 s0, s1; attn_scores(sb, qf, r, h, s0, s1);
            float mx = NEG_INF;
#pragma unroll
            for (int i = 0; i < 16; ++i) {
                const int n = j * 64 + crow(i, h);
                if (n >= nvalid) s0[i] = NEG_INF;
                if (n + 32 >= nvalid) s1[i] = NEG_INF;
                mx = fmaxf(mx, fmaxf(s0[i], s1[i]));
            }
            mx = xhalf_max(mx);
            const float mn = fmaxf(m, mx);
            const float alpha = fast_exp2((m - mn) * SM_C), nb = -mn * SM_C;
            m = mn; l *= alpha; carry *= alpha;
#pragma unroll
            for (int dt = 0; dt < 2; ++dt) oc[dt] = oc[dt] * alpha;
            if (h == 0) FT[(w * 32 + r) * 4 + j] = mn;
            float rs = 0.f;
#pragma unroll
            for (int i = 0; i < 16; ++i) {
                s0[i] = fast_exp2(__builtin_fmaf(s0[i], SM_C, nb)); s1[i] = fast_exp2(__builtin_fmaf(s1[i], SM_C, nb));
                rs += s0[i] + s1[i];
            }
            l += xhalf_sum(rs);
#pragma unroll
            for (int mt = 0; mt < 2; ++mt)
#pragma unroll
                for (int a = 0; a < 4; ++a) {
                    const float x0 = mt ? s1[4 * a] : s0[4 * a], x1 = mt ? s1[4 * a + 1] : s0[4 * a + 1];
                    const float x2 = mt ? s1[4 * a + 2] : s0[4 * a + 2], x3 = mt ? s1[4 * a + 3] : s0[4 * a + 3];
                    float mainv = ((x0 + x1) + x2) + 0.5f * x3;
                    const float cr = 0.5f * x3;
                    const float other = __shfl_xor(cr, 32);
                    mainv += h ? other : carry;
                    carry = other;
                    IMPW[(w * 32 + r) * 64 + 16 * j + 8 * mt + 2 * a + h] = mainv;
                }
            bf16x8 pf[2][2]; pack_p(s0, s1, pf);
            attn_pv<64>(sb + KT_BYTES, pf, r, h, oc);
        }, probe);
        const float invl = l > 0.f ? 1.f / l : 0.f;
        if (h == 0) {
#pragma unroll
            for (int t = 0; t < 4; ++t)
                if (t < ntc) { const float mt_ = FT[(w * 32 + r) * 4 + t]; FT[(w * 32 + r) * 4 + t] = fast_exp2((mt_ - m) * SM_C) * invl; }
        }
        const float g0 = gp[0] * invl;
#pragma unroll
        for (int dt = 0; dt < 2; ++dt)
#pragma unroll
            for (int i = 0; i < 16; ++i) oacc[dt][i] = g0 * oc[dt][i];
        __syncthreads();
    }
    {
        unsigned uk8[8]; bool val8[8];
        const int j = lane;
#pragma unroll
        for (int qq = 0; qq < 8; ++qq) {
            const int rr = 8 * w + qq, qp = q0 + rr, cur = qp >> 6;
            const bool valid = j <= cur;
            float v = 0.f;
            if (valid) {
                const float* ip = IMPW + ((rr >> 5) * 4 * 32 + (rr & 31)) * 64 + j;
                const float* fp = FT + ((rr >> 5) * 4 * 32 + (rr & 31)) * 4 + (j >> 4);
                v = ((ip[0] * fp[0] + ip[2048] * fp[128]) + ip[4096] * fp[256]) + ip[6144] * fp[384];
            }
            const bool forced = (j == 0) || (j == cur) || (j == cur - 1);
            const float key = forced ? __builtin_inff() : (valid ? v : NEG_INF);
            const unsigned kb_ = __float_as_uint(key);
            uk8[qq] = (kb_ & 0x80000000u) ? ~kb_ : (kb_ | 0x80000000u);
            val8[qq] = valid;
        }
        unsigned thr8[8];
#pragma unroll
        for (int qq = 0; qq < 8; ++qq) thr8[qq] = 0u;
#pragma unroll
        for (int bit = 31; bit >= 0; --bit) {
#pragma unroll
            for (int qq = 0; qq < 8; ++qq) {
                const unsigned cand = thr8[qq] | (1u << bit);
                if (__popcll(__ballot(uk8[qq] >= cand)) >= 16) thr8[qq] = cand;
            }
        }
        u64 un = 0;
#pragma unroll
        for (int qq = 0; qq < 8; ++qq) {
            const unsigned uk = uk8[qq], thr = thr8[qq];
            const u64 gtm = __ballot(uk > thr), eqm = __ballot(uk == thr);
            const int need = 16 - (int)__popcll(gtm);
            const int below = (int)__builtin_amdgcn_mbcnt_hi((unsigned)(eqm >> 32), __builtin_amdgcn_mbcnt_lo((unsigned)eqm, 0u));
            const bool sel = ((uk > thr) || (uk == thr && below < need)) && val8[qq];
            const u64 mask = __ballot(sel);
            if (lane == 0) SEL[8 * w + qq] = mask;
            un |= mask;
        }
        if (lane == 0) UN[w] = un;
        __syncthreads();
    }
    const u64 mysel = SEL[32 * hq + r];
    const u64 U = ((UN[0] | UN[1]) | (UN[2] | UN[3])) | ((UN[4] | UN[5]) | (UN[6] | UN[7]));
    unsigned char* ql = lds + NSA_IMPW + (w * 32 + r) * 144 + h * 16;
#pragma unroll
    for (int s = 0; s < 4; ++s) *(bf16x8*)(ql + s * 32) = qf[s];
    {
        const bf16_t* Ks = (const bf16_t*)(p.ws + OFF_KS) + (size_t)bg * 4096 * 64;
        const bf16_t* VsT = (const bf16_t*)(p.ws + OFF_VST) + (size_t)bg * 64 * 4096;
        const int nts = __popcll(U), j0 = __ffsll((long long)U) - 1;
        f32x16 o[2];
#pragma unroll
        for (int dt = 0; dt < 2; ++dt)
#pragma unroll
            for (int i = 0; i < 16; ++i) o[dt][i] = 0.f;
        float m = -1e30f, l = 0.f;
        kv_loop<64, true>(lds, Ks, VsT, 4096, nts, j0, [U](int j) { return __ffsll((long long)(U & (~0ull << (j + 1)))) - 1; }, [&](int j, const unsigned char* sb) {
            const bool mine = (mysel >> j) & 1ull;
            if (__ballot(mine) != 0ull) {
                bf16x8 q2[4];
#pragma unroll
                for (int s = 0; s < 4; ++s) q2[s] = *(const bf16x8*)(ql + s * 32);
                f32x16 s0, s1; attn_scores(sb, q2, r, h, s0, s1);
                if (j == (qb >> 6)) {
                    const int lim = mine ? (qpos - 64 * j) : -1;
#pragma unroll
                    for (int i = 0; i < 16; ++i) {
                        const int kl = crow(i, h);
                        if (kl > lim) s0[i] = NEG_INF;
                        if (kl + 32 > lim) s1[i] = NEG_INF;
                    }
                    attn_softmax_pv<64>(s0, s1, m, l, o, sb + KT_BYTES, r, h);
                } else {
                    attn_softmax_pv<64>(s0, s1, m, l, o, sb + KT_BYTES, r, h, mine);
                }
            }
        }, probe);
        const float sc = l > 0.f ? gp[1] / l : 0.f;
#pragma unroll
        for (int dt = 0; dt < 2; ++dt)
#pragma unroll
            for (int i = 0; i < 16; ++i) oacc[dt][i] += sc * o[dt][i];
    }
    {
        const bf16_t* Kw = (const bf16_t*)(p.ws + OFF_KW) + (size_t)bg * 4096 * 64;
        const bf16_t* VwT = (const bf16_t*)(p.ws + OFF_VWT) + (size_t)bg * 64 * 4096;
        const int tlo = (q0 > 511 ? q0 - 511 : 0) >> 6, thi = (q0 + 63) >> 6;
        f32x16 o[2];
#pragma unroll
        for (int dt = 0; dt < 2; ++dt)
#pragma unroll
            for (int i = 0; i < 16; ++i) o[dt][i] = 0.f;
        float m = -1e30f, l = 0.f;
        kv_loop<64, true>(lds, Kw, VwT, 4096, thi - tlo + 1, tlo, inc, [&](int j, const unsigned char* sb) {
            const int k0 = j * 64;
            if (k0 > qb + 31 || k0 + 63 <= qb - 512) return;
            bf16x8 q2[4];
#pragma unroll
            for (int s = 0; s < 4; ++s) q2[s] = *(const bf16x8*)(ql + s * 32);
            f32x16 s0, s1; attn_scores(sb, q2, r, h, s0, s1);
            if (!(k0 + 63 <= qb && k0 > qb + 31 - 512)) {
#pragma unroll
                for (int i = 0; i < 16; ++i) {
                    const int ka = k0 + crow(i, h), kb2 = ka + 32;
                    if (!(ka <= qpos && ka > qpos - 512)) s0[i] = NEG_INF;
                    if (!(kb2 <= qpos && kb2 > qpos - 512)) s1[i] = NEG_INF;
                }
            }
            attn_softmax_pv<64>(s0, s1, m, l, o, sb + KT_BYTES, r, h);
        }, probe);
        const float sc = l > 0.f ? gp[2] / l : 0.f;
#pragma unroll
        for (int dt = 0; dt < 2; ++dt)
#pragma unroll
            for (int i = 0; i < 16; ++i) oacc[dt][i] += sc * o[dt][i];
    }
    if (probe) {
        float chk = 0.f;
#pragma unroll
        for (int dt = 0; dt < 2; ++dt)
#pragma unroll
            for (int i = 0; i < 16; ++i) chk += oacc[dt][i];
        if (chk == 1.2345e-30f) ((float*)(p.ws + OFF_CTL))[33] = chk;
        return;
    }
    bf16_t* O = (bf16_t*)(p.ws + OFF_O) + ((size_t)b * 4096 + qpos) * 1024 + 512 + head * 64;
#pragma unroll
    for (int dt = 0; dt < 2; ++dt)
#pragma unroll
        for (int g4 = 0; g4 < 4; ++g4) {
            u32x2 ov; ov.x = pk_bf16(oacc[dt][4 * g4], oacc[dt][4 * g4 + 1]); ov.y = pk_bf16(oacc[dt][4 * g4 + 2], oacc[dt][4 * g4 + 3]);
            *(u32x2*)(O + dt * 32 + 8 * g4 + 4 * h) = ov;
        }
}
DI void phase4(const Params& p, unsigned char* lds, int rep = 0, int probe = 0, int which = 3) {
    unsigned* counter = (unsigned*)(p.ws + OFF_CTL) + 2 * rep;
    volatile int* su = (volatile int*)(lds + LDS_UNIT);
    if (which & 1) for (;;) {
        if (threadIdx.x == 0) *su = (int)atomicAdd(counter, 1u);
        __syncthreads();
        const int u = *su;
        __syncthreads();
        if (u >= 512) break;
        diff_unit(p, u, lds, probe);
    }
    if (which & 2) for (;;) {
        if (threadIdx.x == 0) *su = (int)atomicAdd(counter + 1, 1u);
        __syncthreads();
        const int u = *su;
        __syncthreads();
        if (u >= 1024) break;
        nsa_unit(p, u, lds, probe);
    }
}
DI void phase5(const Params& p, unsigned char* lds) {
    pg8::Gemm g; g.A = (const bf16_t*)(p.ws + OFF_O); g.Bt = (const bf16_t*)(p.ws + OFF_WOUTT); g.M = T; g.N = 1024; g.K = 1024;
    pg8::StaticOrder S; S.init(T, 1024, (int)gridDim.x, (int)blockIdx.x);
    pg8::EpiPlain E; E.O = (bf16_t*)(p.ws + OFF_MIX); E.ldc = 1024;
    pg8::gemm_phase<pg8::EpiPlain, pg8::StaticOrder, true, true>((PG8_LAS unsigned char*)lds, g, S, E);
    __syncthreads();
}
DI void phase6(const Params& p) {
    const int lane = VTID & 63, w = VTID >> 6;
    const float* x = p.in[0]; const float* gpost = p.in[15]; const float* gffn = p.in[16];
    const bf16_t* MIX = (const bf16_t*)(p.ws + OFF_MIX);
    bf16_t* H = (bf16_t*)(p.ws + OFF_H);
    float* RSTD = (float*)(p.ws + OFF_GATES);
    for (int row = VBLK * 4 + w; row < T; row += VGRID * 4) {
        f32x4 mv[4], xv[4]; float ss = 0.f;
#pragma unroll
        for (int i = 0; i < 4; ++i) {
            const u32x2 u = *(const u32x2*)(MIX + (size_t)row * 1024 + i * 256 + lane * 4);
            mv[i][0] = bflo(u.x); mv[i][1] = bfhi(u.x); mv[i][2] = bflo(u.y); mv[i][3] = bfhi(u.y);
            xv[i] = *(const f32x4*)(x + (size_t)row * 1024 + i * 256 + lane * 4);
            ss += mv[i][0] * mv[i][0] + mv[i][1] * mv[i][1] + mv[i][2] * mv[i][2] + mv[i][3] * mv[i][3];
        }
        ss = wave_sum(ss);
        const float rstd = rsqrtf(ss * (1.f / 1024.f) + NORM_EPS);
        if (lane == 0) RSTD[row] = rstd;
        float ss2 = 0.f;
#pragma unroll
        for (int i = 0; i < 4; ++i) {
            const f32x4 gg = *(const f32x4*)(gpost + i * 256 + lane * 4);
#pragma unroll
            for (int e = 0; e < 4; ++e) { xv[i][e] += mv[i][e] * rstd * gg[e]; ss2 += xv[i][e] * xv[i][e]; }
        }
        ss2 = wave_sum(ss2);
        const float rstd2 = rsqrtf(ss2 * (1.f / 1024.f) + NORM_EPS);
#pragma unroll
        for (int i = 0; i < 4; ++i) {
            const f32x4 gg = *(const f32x4*)(gffn + i * 256 + lane * 4);
            u32x2 o; o.x = pk_bf16(xv[i][0] * rstd2 * gg[0], xv[i][1] * rstd2 * gg[1]); o.y = pk_bf16(xv[i][2] * rstd2 * gg[2], xv[i][3] * rstd2 * gg[3]);
            *(u32x2*)(H + (size_t)row * 1024 + i * 256 + lane * 4) = o;
        }
    }
}
DI void phase7(const Params& p, unsigned char* lds, int probe = 0) {
    pg8::Gemm g; g.A = (const bf16_t*)(p.ws + OFF_H); g.Bt = (const bf16_t*)(p.ws + OFF_WGUT); g.M = T; g.N = 2 * DFF; g.K = 1024;
    pg8::StaticOrder S; S.init(T, 2 * DFF, (int)gridDim.x, (int)blockIdx.x);
    pg8::EpiSwiGLU E; E.ACT = (bf16_t*)(p.ws + OFF_ACT); E.ldc = DFF;
    pg8::gemm_phase<pg8::EpiSwiGLU, pg8::StaticOrder, true, true>((PG8_LAS unsigned char*)lds, g, S, E);
    __syncthreads();
}
DI void phase8(const Params& p, unsigned char* lds) {
    pg8::Gemm g; g.A = (const bf16_t*)(p.ws + OFF_ACT); g.Bt = (const bf16_t*)(p.ws + OFF_WDT); g.M = T; g.N = 1024; g.K = DFF;
    pg8::StaticOrder S; S.init(T, 1024, (int)gridDim.x, (int)blockIdx.x);
    pg8::EpiPlain E; E.O = (bf16_t*)(p.ws + OFF_O); E.ldc = 1024;
    pg8::gemm_phase<pg8::EpiPlain, pg8::StaticOrder, true, true>((PG8_LAS unsigned char*)lds, g, S, E);
    __syncthreads();
}
DI void phase9(const Params& p) {
    const int lane = VTID & 63, w = VTID >> 6;
    const float* x = p.in[0]; const float* g1 = p.in[15]; const float* g2 = p.in[20];
    const bf16_t* MIX = (const bf16_t*)(p.ws + OFF_MIX);
    const bf16_t* F = (const bf16_t*)(p.ws + OFF_O);
    const float* RSTD = (const float*)(p.ws + OFF_GATES);
    for (int row = VBLK * 4 + w; row < T; row += VGRID * 4) {
        f32x4 fv[4], mv[4]; float ss = 0.f;
#pragma unroll
        for (int i = 0; i < 4; ++i) {
            const u32x2 u = *(const u32x2*)(F + (size_t)row * 1024 + i * 256 + lane * 4);
            fv[i][0] = bflo(u.x); fv[i][1] = bfhi(u.x); fv[i][2] = bflo(u.y); fv[i][3] = bfhi(u.y);
            const u32x2 um = *(const u32x2*)(MIX + (size_t)row * 1024 + i * 256 + lane * 4);
            mv[i][0] = bflo(um.x); mv[i][1] = bfhi(um.x); mv[i][2] = bflo(um.y); mv[i][3] = bfhi(um.y);
            ss += fv[i][0] * fv[i][0] + fv[i][1] * fv[i][1] + fv[i][2] * fv[i][2] + fv[i][3] * fv[i][3];
        }
        ss = wave_sum(ss);
        const float rstd = rsqrtf(ss * (1.f / 1024.f) + NORM_EPS);
        const float rstd1 = RSTD[row];
#pragma unroll
        for (int i = 0; i < 4; ++i) {
            const f32x4 ga = *(const f32x4*)(g1 + i * 256 + lane * 4);
            const f32x4 gb = *(const f32x4*)(g2 + i * 256 + lane * 4);
            f32x4 xv = *(const f32x4*)(x + (size_t)row * 1024 + i * 256 + lane * 4);
#pragma unroll
            for (int e = 0; e < 4; ++e) { xv[e] += mv[i][e] * rstd1 * ga[e]; xv[e] += fv[i][e] * rstd * gb[e]; }
            *(f32x4*)(p.out + (size_t)row * 1024 + i * 256 + lane * 4) = xv;
        }
    }
}

__global__ void __launch_bounds__(512, 2) mega(Params p) {
    extern __shared__ __attribute__((aligned(16))) unsigned char lds[];
    cg::grid_group grid = cg::this_grid();
    const bool fused = (p.ph_hi - p.ph_lo) > 1;
    XcdBarrier xb; xb.bar = (unsigned*)(p.ws + OFF_XB); xb.x = 0; xb.st = (volatile LAS unsigned*)(lds + LDS_XB);
    if (fused) {
        if (threadIdx.x == 0) { xb.st[0] = 0u; xb.st[1] = 0u; }
        __syncthreads();
        xb = xcd_barrier_post((unsigned*)(p.ws + OFF_XB), (volatile LAS unsigned*)(lds + LDS_XB));
    }
    if (p.ph_hi > 1000) grid.sync();
#ifndef ONLY_PH
#define ONLY_PH -1
#endif
#define PH_ON(n) (ONLY_PH < 0 || ONLY_PH == (n))
#define RUN_PHASE(n, call) if (p.ph_lo <= (n) && (n) < p.ph_hi) { if (PH_ON(n)) { call; } if ((n) + 1 < p.ph_hi) { xcd_barrier(xb); if (PROBE_MODE == 1) xcd_barrier(xb); } }
    RUN_PHASE(0, phase0(p, lds))
    RUN_PHASE(1, phase1(p, lds))
    RUN_PHASE(2, phase2(p, lds))
    RUN_PHASE(3, phase3(p, lds))
    RUN_PHASE(4, phase4(p, lds))
#if PROBE_MODE == 2
    RUN_PHASE(4, phase4(p, lds, 1))
#endif
#if PROBE_MODE == 8
    RUN_PHASE(4, phase4(p, lds, 1, 0, 1))
#endif
#if PROBE_MODE == 9
    RUN_PHASE(4, phase4(p, lds, 1, 0, 2))
#endif
#if PROBE_MODE == 6
    RUN_PHASE(4, phase4(p, lds, 1, 1))
#endif
#if PROBE_MODE == 7
    RUN_PHASE(4, phase4(p, lds, 1, 2))
#endif
    RUN_PHASE(5, phase5(p, lds))
    RUN_PHASE(6, phase6(p))
    RUN_PHASE(7, phase7(p, lds))
#if PROBE_MODE == 3
    RUN_PHASE(7, phase7(p, lds))
#endif
#if PROBE_MODE == 4
    RUN_PHASE(7, phase7(p, lds, 1))
#endif
#if PROBE_MODE == 5
    RUN_PHASE(7, phase7(p, lds, 2))
#endif
    RUN_PHASE(8, phase8(p, lds))
    RUN_PHASE(9, phase9(p))
}

extern "C" void kernel_launch(void* const* d_in, const int* in_sizes, int n_in, void* d_out, int out_size, void* d_ws, size_t ws_size, hipStream_t stream) {
    static int grid_blocks = 0;
    if (grid_blocks == 0) {
        if (n_in != 21 || ws_size < WS_END) { fprintf(stderr, "kernel_launch: unexpected n_in %d / ws %zu (need %zu)\n", n_in, ws_size, (size_t)WS_END); grid_blocks = -1; return; }
        int dev = 0, cus = 0, per_cu = 0;
        hipGetDevice(&dev);
        hipDeviceGetAttribute(&cus, hipDeviceAttributeMultiprocessorCount, dev);
        if (hipFuncSetAttribute((const void*)mega, hipFuncAttributeMaxDynamicSharedMemorySize, LDS_BYTES) != hipSuccess) { fprintf(stderr, "kernel_launch: hipFuncSetAttribute failed\n"); grid_blocks = -1; return; }
        hipOccupancyMaxActiveBlocksPerMultiprocessor(&per_cu, (const void*)mega, 512, LDS_BYTES);
        if (per_cu < 1) per_cu = 1;
        if (per_cu > 1) per_cu = 1;
        grid_blocks = cus * per_cu;
        if (grid_blocks > 256) grid_blocks = 256;
    }
    if (grid_blocks < 0) return;
    Params p{};
    for (int i = 0; i < 21; ++i) p.in[i] = (const float*)d_in[i];
    p.out = (float*)d_out; p.ws = (unsigned char*)d_ws;
#if MULTI_LAUNCH
    for (int ph = 0; ph < NPH; ++ph) {
        p.ph_lo = ph; p.ph_hi = ph + 1;
        hipLaunchKernelGGL(mega, dim3(grid_blocks), dim3(512), LDS_BYTES, stream, p);
    }
#else
    p.ph_lo = 0; p.ph_hi = NPH;
    if (hipMemsetAsync((unsigned char*)d_ws + OFF_XB, 0, XCD_BAR_WORDS * 4, stream) != hipSuccess) { fprintf(stderr, "kernel_launch: memset of barrier words failed\n"); return; }
    void* args[] = {&p};
    hipError_t e = hipLaunchCooperativeKernel((const void*)mega, dim3(grid_blocks), dim3(512), args, LDS_BYTES, stream);
    if (e != hipSuccess) fprintf(stderr, "cooperative launch failed: %s (grid %d)\n", hipGetErrorString(e), grid_blocks);
#endif
}
```

```cpp
#include <hip/hip_runtime.h>
#include <hip/hip_cooperative_groups.h>
#include <cstdio>
#include <cstdint>
namespace cg = cooperative_groups;

#ifndef MULTI_LAUNCH
#define MULTI_LAUNCH 0
#endif
#ifndef PROBE_MODE
#define PROBE_MODE 0
#endif

typedef unsigned short bf16_t;
typedef short bf16x8 __attribute__((ext_vector_type(8)));
typedef short s16x4 __attribute__((ext_vector_type(4)));
typedef float f32x16 __attribute__((ext_vector_type(16)));
typedef float f32x4 __attribute__((ext_vector_type(4)));
typedef float f32x2 __attribute__((ext_vector_type(2)));
typedef unsigned u32x4 __attribute__((ext_vector_type(4)));
typedef unsigned u32x2 __attribute__((ext_vector_type(2)));
typedef __bf16 bf16v2 __attribute__((ext_vector_type(2)));
typedef unsigned long long u64;

#define DI __device__ __forceinline__
#define MFMA(a, b, c) __builtin_amdgcn_mfma_f32_32x32x16_bf16((a), (b), (c), 0, 0, 0)

constexpr int T = 32768, S = 4096, DM = 1024;
constexpr int INC = 2840, INP = 3072, DFF = 2816;
constexpr int NPH = 10;
constexpr int HALF_LDS = 73728;
constexpr int LDS_BYTES = 2 * HALF_LDS + 256;
#define VTID ((int)(threadIdx.x & 255))
#define VHALF ((int)(threadIdx.x >> 8))
#define VBLK ((int)(blockIdx.x * 2 + (threadIdx.x >> 8)))
#define VGRID ((int)(gridDim.x * 2))
constexpr float NORM_EPS = 1e-6f;

constexpr size_t al256(size_t x) { return (x + 255) & ~(size_t)255; }
constexpr size_t OFF_CTL = 0;
constexpr size_t OFF_XB = 4096;
constexpr size_t OFF_WINT = 4096 + 16384;
constexpr size_t OFF_WOUTT = OFF_WINT + (size_t)INP * 1024 * 2;
constexpr size_t OFF_WGUT = OFF_WOUTT + (size_t)1024 * 1024 * 2;
constexpr size_t OFF_WDT = OFF_WGUT + (size_t)2 * DFF * 1024 * 2;
constexpr size_t OFF_W1T = OFF_WDT + (size_t)1024 * DFF * 2;
constexpr size_t OFF_W2T = OFF_W1T + (size_t)2 * 256 * 2048 * 2;
constexpr size_t OFF_B1 = OFF_W2T + (size_t)2 * 128 * 256 * 2;
constexpr size_t OFF_ROPE = OFF_B1 + 2 * 256 * 4;
constexpr size_t OFF_H = al256(OFF_ROPE + (size_t)4096 * 32 * 8);
constexpr size_t OFF_O = OFF_H + (size_t)T * 1024 * 2;
constexpr size_t OFF_MIX = OFF_O + (size_t)T * 1024 * 2;
constexpr size_t OFF_QKV = OFF_MIX + (size_t)T * 1024 * 2;
constexpr size_t SZ_H8 = (size_t)8 * 8 * 4096 * 64 * 2;
constexpr size_t SZ_G2 = (size_t)8 * 2 * 4096 * 64 * 2;
constexpr size_t OFF_QD = OFF_QKV;
constexpr size_t OFF_KD = OFF_QD + SZ_H8;
constexpr size_t OFF_VDT = OFF_KD + SZ_H8;
constexpr size_t OFF_QN = OFF_VDT + SZ_H8;
constexpr size_t OFF_KCT = OFF_QN + SZ_H8;
constexpr size_t OFF_VCT = OFF_KCT + SZ_G2;
constexpr size_t OFF_KS = OFF_VCT + SZ_G2;
constexpr size_t OFF_VST = OFF_KS + SZ_G2;
constexpr size_t OFF_KW = OFF_VST + SZ_G2;
constexpr size_t OFF_VWT = OFF_KW + SZ_G2;
constexpr size_t OFF_GATES = OFF_VWT + SZ_G2;
constexpr size_t OFF_HID = OFF_GATES + (size_t)T * 24 * 4;
constexpr size_t OFF_KCMP = OFF_HID + (size_t)2 * 16 * 256 * 256 * 2;
constexpr size_t OFF_VCMPT = OFF_KCMP + (size_t)16 * 256 * 64 * 2;
constexpr size_t OFF_QKV_END = OFF_VCMPT + (size_t)16 * 256 * 64 * 2;
constexpr size_t OFF_ACT = OFF_QKV;
constexpr size_t OFF_ACT_END = OFF_ACT + (size_t)T * DFF * 2;
constexpr size_t WS_END = OFF_ACT_END > OFF_QKV_END ? OFF_ACT_END : OFF_QKV_END;

struct Params {
    const float* in[21];
    float* out;
    unsigned char* ws;
    int ph_lo, ph_hi;
};

DI unsigned pk_bf16(float a, float b) { f32x2 v = {a, b}; return __builtin_bit_cast(unsigned, __builtin_convertvector(v, bf16v2)); }
DI bf16_t f2bf(float a) { return (bf16_t)(pk_bf16(a, 0.f) & 0xffffu); }
DI float bflo(unsigned u) { return __uint_as_float(u << 16); }
DI float bfhi(unsigned u) { return __uint_as_float(u & 0xffff0000u); }
DI u32x4 pk8(const float (&v)[8]);
DI int crow(int i, int h) { return (i & 3) + 8 * (i >> 2) + 4 * h; }
DI float wave_sum(float v) {
    v += __shfl_xor(v, 32); v += __shfl_xor(v, 16); v += __shfl_xor(v, 8);
    v += __shfl_xor(v, 4); v += __shfl_xor(v, 2); v += __shfl_xor(v, 1);
    return v;
}
DI float fast_exp2(float x) { return __builtin_amdgcn_exp2f(x); }
DI float xhalf_max(float x) { auto rr = __builtin_amdgcn_permlane32_swap(__float_as_uint(x), __float_as_uint(x), false, false); return fmaxf(__uint_as_float(rr[0]), __uint_as_float(rr[1])); }
DI float xhalf_sum(float x) { auto rr = __builtin_amdgcn_permlane32_swap(__float_as_uint(x), __float_as_uint(x), false, false); return __uint_as_float(rr[0]) + __uint_as_float(rr[1]); }
DI float sigmoidf(float x) { return 1.f / (1.f + __expf(-x)); }


#define XB_TMO      128
#define XB_XCNT(j)  (256  + 64 * (j))
#define XB_XSUB(j)  (1280 + 64 * (j))
#define XB_XGEN(j)  (2304 + 64 * (j))
#define XB_TOP      3328
#define XB_TOPGEN   3392
#define XCD_BAR_WORDS 3456
#define XB_SPIN_CAP (1u << 18)
#define LAS __attribute__((address_space(3)))
DI unsigned xb_ld(unsigned* p) { return __hip_atomic_load(p, __ATOMIC_RELAXED, __HIP_MEMORY_SCOPE_AGENT); }
DI unsigned xb_add(unsigned* p, unsigned v) { return __hip_atomic_fetch_add(p, v, __ATOMIC_RELAXED, __HIP_MEMORY_SCOPE_AGENT); }
DI unsigned xb_xcc_id() { return (unsigned)__builtin_amdgcn_s_getreg((3 << 11) | 20) & 0xFu; }
#define XB_SPIN(cond, bar) do { unsigned _sp = 0; while (cond) { __builtin_amdgcn_s_sleep(1); \
    if ((++_sp & 255u) == 0u) { if (xb_ld(&(bar)[XB_TMO])) break; if (_sp > XB_SPIN_CAP) { atomicAdd(&(bar)[XB_TMO], 1u); break; } } } } while (0)
struct XcdBarrier { unsigned* bar; unsigned x; volatile LAS unsigned* st; };
DI XcdBarrier xcd_barrier_post(unsigned* bar, volatile LAS unsigned* st) {
    XcdBarrier b; b.bar = bar; b.x = xb_xcc_id(); b.st = st;
    if (threadIdx.x == 0) (void)xb_add(&bar[XB_XCNT(b.x)], 1u);
    return b;
}
DI void xcd_barrier_complete(unsigned* bar, unsigned x, unsigned& nloc, unsigned& nx) {
    const unsigned G = gridDim.x * gridDim.y * gridDim.z;
    unsigned sum, cnt, mine, sp = 0u;
    for (;;) {
        sum = 0u; cnt = 0u; mine = 0u;
#pragma unroll
        for (unsigned j = 0; j < 16; ++j) { const unsigned c = xb_ld(&bar[XB_XCNT(j)]); sum += c; cnt += (c > 0u) ? 1u : 0u; mine = (j == x) ? c : mine; }
        if (sum == G) break;
        __builtin_amdgcn_s_sleep(1);
        if ((++sp & 255u) == 0u) { if (xb_ld(&bar[XB_TMO])) break; if (sp > XB_SPIN_CAP) { atomicAdd(&bar[XB_TMO], 1u); break; } }
    }
    nloc = mine > 0u ? mine : 1u; nx = cnt > 0u ? cnt : 1u;
}
DI void xcd_barrier(const XcdBarrier& b) {
    asm volatile("s_waitcnt vmcnt(0)" ::: "memory");
    __syncthreads();
    if (threadIdx.x == 0) {
        unsigned* bar = b.bar;
        __builtin_amdgcn_s_waitcnt(0);
        unsigned nloc = b.st[0], nx = b.st[1];
        if (nloc == 0u) { xcd_barrier_complete(bar, b.x, nloc, nx); b.st[0] = nloc; b.st[1] = nx; }
        const unsigned old = xb_add(&bar[XB_XSUB(b.x)], 1u);
        const unsigned gen = old / nloc;
        if (old + 1u == (gen + 1u) * nloc) {
            __builtin_amdgcn_fence(__ATOMIC_RELEASE, "agent");
            asm volatile("s_waitcnt vmcnt(0)" ::: "memory");
            const unsigned og = xb_add(&bar[XB_TOP], 1u);
            const unsigned tg = og / nx;
            if (og + 1u == (tg + 1u) * nx) xb_add(&bar[XB_TOPGEN], 1u);
            else XB_SPIN(xb_ld(&bar[XB_TOPGEN]) == tg, bar);
            __builtin_amdgcn_fence(__ATOMIC_ACQUIRE, "agent");
            xb_add(&bar[XB_XGEN(b.x)], 1u);
            asm volatile("s_waitcnt vmcnt(0)" ::: "memory");
        } else {
            XB_SPIN(xb_ld(&bar[XB_XGEN(b.x)]) == gen, bar);
            __builtin_amdgcn_fence(__ATOMIC_ACQUIRE, "agent");
            asm volatile("s_waitcnt vmcnt(0)" ::: "memory");
        }
    }
    __syncthreads();
}
constexpr int LDS_XB = 2 * 73728;

DI int wdst_row(int n, int mode) {
    int dr = n;
    if (mode == 1 || mode == 2) dr = (n >> 2) * 8 + (n & 3) + (mode == 2 ? 4 : 0);
    else if (mode == 3) {
        const bool rope = (n < 1024) || (n >= 1536 && n < 2176) || (n >= 2304 && n < 2432) || (n >= 2560 && n < 2688);
        if (rope) { const int d = n & 63; dr = (n & ~63) + 8 * ((d & 31) >> 2) + (d & 3) + 4 * (d >> 5); }
    }
    return dr;
}
DI void transpose_tile(const float* __restrict__ src, int K, int N, bf16_t* __restrict__ dst, int ldd, int mode, int tile, float* tl, bool valid) {
    const int nbN = (N + 63) >> 6;
    const int kb = tile / nbN, nb = tile - kb * nbN;
    const int t = VTID;
    if (valid) {
#pragma unroll
        for (int i = 0; i < 4; ++i) {
            const int row = (t >> 4) + 16 * i, c4 = (t & 15) * 4, n = nb * 64 + c4;
            f32x4 v = {0.f, 0.f, 0.f, 0.f};
            if (n < N) v = *(const f32x4*)(src + (size_t)(kb * 64 + row) * N + n);
            float* q = tl + row * 65 + c4;
            q[0] = v[0]; q[1] = v[1]; q[2] = v[2]; q[3] = v[3];
        }
    }
    __syncthreads();
    if (valid) {
        const int nl = t >> 2, kc = (t & 3) * 16, n = nb * 64 + nl;
        if (n < N) {
            float a[8], b[8];
#pragma unroll
            for (int k = 0; k < 8; ++k) { a[k] = tl[(kc + k) * 65 + nl]; b[k] = tl[(kc + 8 + k) * 65 + nl]; }
            bf16_t* d = dst + (size_t)wdst_row(n, mode) * ldd + kb * 64 + kc;
            *(u32x4*)d = pk8(a); *(u32x4*)(d + 8) = pk8(b);
        }
    }
    __syncthreads();
}

DI void phase0(const Params& p, unsigned char* lds) {
    const int tid = VTID, lane = tid & 63, w = tid >> 6;
    const int G = VGRID;
    unsigned char* ws = p.ws;
    float* tl = (float*)(lds + VHALF * HALF_LDS);
    if (VBLK == 0) {
        if (tid < 64) {
            float a = p.in[3][lane] * p.in[4][lane];
            float b = p.in[5][lane] * p.in[6][lane];
            a = wave_sum(a); b = wave_sum(b);
            if (lane == 0) {
                ((float*)(ws + OFF_CTL))[16] = expf(a) - expf(b) + 0.2f;
                ((unsigned*)(ws + OFF_CTL))[0] = 0u; ((unsigned*)(ws + OFF_CTL))[1] = 0u; ((unsigned*)(ws + OFF_CTL))[2] = 0u; ((unsigned*)(ws + OFF_CTL))[3] = 0u;
            }
        }
    }
    {
        const int c0 = 720, c1 = c0 + 256, c2 = c1 + 704, c3 = c2 + 704, c4 = c3 + 704, c5 = c4 + 128, c6 = c5 + 128, c7 = c6 + 4, c8 = c7 + 4;
        for (int tb = 0; tb < c8; tb += G) {
            const bool valid = tb + VBLK < c8; const int t = valid ? tb + VBLK : c8 - 1;
            if (t < c0) transpose_tile(p.in[2], 1024, INC, (bf16_t*)(ws + OFF_WINT), 1024, 3, t, tl, valid);
            else if (t < c1) transpose_tile(p.in[14], 1024, 1024, (bf16_t*)(ws + OFF_WOUTT), 1024, 0, t - c0, tl, valid);
            else if (t < c2) transpose_tile(p.in[17], 1024, DFF, (bf16_t*)(ws + OFF_WGUT), 1024, 1, t - c1, tl, valid);
            else if (t < c3) transpose_tile(p.in[18], 1024, DFF, (bf16_t*)(ws + OFF_WGUT), 1024, 2, t - c2, tl, valid);
            else if (t < c4) transpose_tile(p.in[19], DFF, 1024, (bf16_t*)(ws + OFF_WDT), DFF, 0, t - c3, tl, valid);
            else if (t < c5) transpose_tile(p.in[9], 2048, 256, (bf16_t*)(ws + OFF_W1T), 2048, 0, t - c4, tl, valid);
            else if (t < c6) transpose_tile(p.in[12], 2048, 256, (bf16_t*)(ws + OFF_W1T) + 256 * 2048, 2048, 0, t - c5, tl, valid);
            else if (t < c7) transpose_tile(p.in[10], 256, 64, (bf16_t*)(ws + OFF_W2T), 256, 0, t - c6, tl, valid);
            else transpose_tile(p.in[13], 256, 64, (bf16_t*)(ws + OFF_W2T) + 128 * 256, 256, 0, t - c7, tl, valid);
        }
    }
    for (int t = VBLK; t < 8; t += G) {
        const int kv = t >> 2, cgp = t & 3;
        const float* pos = p.in[kv ? 11 : 8];
        const float* w1 = p.in[kv ? 12 : 9];
        const int c = cgp * 64 + (tid & 63), part = tid >> 6;
        float acc = 0.f;
        for (int k = part * 512; k < part * 512 + 512; ++k) acc += pos[k] * w1[(size_t)k * 256 + c];
        __syncthreads();
        tl[part * 64 + (tid & 63)] = acc;
        __syncthreads();
        if (tid < 64) ((float*)(ws + OFF_B1))[kv * 256 + c] = (tl[tid] + tl[64 + tid]) + (tl[128 + tid] + tl[192 + tid]);
        __syncthreads();
    }
    {
        f32x2* tab = (f32x2*)(ws + OFF_ROPE);
        for (int i = VBLK * 256 + tid; i < 4096 * 32; i += G * 256) {
            const int pos = i >> 5, j = i & 31;
            const float inv = 1.0f / powf(10000.f, (float)(2 * j) / 64.f);
            const float ang = (float)pos * inv;
            f32x2 cs; cs.x = cosf(ang); cs.y = sinf(ang);
            tab[i] = cs;
        }
    }
    {
        const float* x = p.in[0]; const float* g = p.in[1];
        bf16_t* H = (bf16_t*)(ws + OFF_H);
        for (int row = VBLK * 4 + w; row < T; row += G * 4) {
            const float* xr = x + (size_t)row * 1024;
            f32x4 v[4]; float ss = 0.f;
#pragma unroll
            for (int i = 0; i < 4; ++i) { v[i] = *(const f32x4*)(xr + i * 256 + lane * 4); ss += v[i][0] * v[i][0] + v[i][1] * v[i][1] + v[i][2] * v[i][2] + v[i][3] * v[i][3]; }
            ss = wave_sum(ss);
            const float rstd = rsqrtf(ss * (1.f / 1024.f) + NORM_EPS);
#pragma unroll
            for (int i = 0; i < 4; ++i) {
                const f32x4 gg = *(const f32x4*)(g + i * 256 + lane * 4);
                u32x2 o; o.x = pk_bf16(v[i][0] * rstd * gg[0], v[i][1] * rstd * gg[1]); o.y = pk_bf16(v[i][2] * rstd * gg[2], v[i][3] * rstd * gg[3]);
                *(u32x2*)(H + (size_t)row * 1024 + i * 256 + lane * 4) = o;
            }
        }
    }
}

constexpr int GP = 144;
constexpr int GT = 128 * GP;
constexpr int DT = 16384;
constexpr int DSTAGE = 2 * DT;
#define LAS3 __attribute__((address_space(3)))
template <bool SWAP>
DI void gemm_compute(const unsigned char* base, const int (&ao)[4], const int (&bo)[4], f32x16 (&acc)[2][2]) {
#pragma unroll
    for (int s = 0; s < 4; ++s) {
        const bf16x8 a0 = *(const bf16x8*)(base + ao[s]), a1 = *(const bf16x8*)(base + ao[s] + 32 * 128);
        const bf16x8 b0 = *(const bf16x8*)(base + DT + bo[s]), b1 = *(const bf16x8*)(base + DT + bo[s] + 32 * 128);
        if (SWAP) {
            acc[0][0] = MFMA(b0, a0, acc[0][0]); acc[0][1] = MFMA(b1, a0, acc[0][1]);
            acc[1][0] = MFMA(b0, a1, acc[1][0]); acc[1][1] = MFMA(b1, a1, acc[1][1]);
        } else {
            acc[0][0] = MFMA(a0, b0, acc[0][0]); acc[0][1] = MFMA(a0, b1, acc[0][1]);
            acc[1][0] = MFMA(a1, b0, acc[1][0]); acc[1][1] = MFMA(a1, b1, acc[1][1]);
        }
    }
}
DI void gemm_dma(const bf16_t* ga, const bf16_t* gb, int lda, int ldb, int k0, unsigned char* stage_w) {
#pragma unroll
    for (int i = 0; i < 4; ++i) {
        __builtin_amdgcn_global_load_lds((const unsigned*)(ga + (size_t)(32 * i) * lda + k0), (LAS3 unsigned*)(stage_w + i * 4096), 16, 0, 0);
        __builtin_amdgcn_global_load_lds((const unsigned*)(gb + (size_t)(32 * i) * ldb + k0), (LAS3 unsigned*)(stage_w + DT + i * 4096), 16, 0, 0);
    }
}
template <bool SWAP>
DI void gemm_main(const bf16_t* __restrict__ Ag, int lda, const bf16_t* __restrict__ Bg, int ldb, int K, f32x16 (&acc)[2][2], unsigned char* lds, int probe = 0) {
    const int tid = VTID, lane = tid & 63, w = __builtin_amdgcn_readfirstlane(tid >> 6), wr = w >> 1, wc = w & 1, r = lane & 31, h = lane >> 5;
    const int row0 = 8 * w + (lane >> 3), kch = (lane & 7) ^ ((row0 >> 1) & 7);
    const bf16_t* ga = Ag + (size_t)row0 * lda + kch * 8;
    const bf16_t* gb = Bg + (size_t)row0 * ldb + kch * 8;
    unsigned char* st0 = lds + w * 1024;
    unsigned char* st1 = lds + DSTAGE + w * 1024;
    int ao[4], bo[4];
    {
        const int ra = wr * 64 + r, rb = wc * 64 + r;
        const int xa = h ^ ((ra >> 1) & 7), xb = h ^ ((rb >> 1) & 7);
#pragma unroll
        for (int s = 0; s < 4; ++s) { ao[s] = ra * 128 + ((xa ^ (2 * s)) << 4); bo[s] = rb * 128 + ((xb ^ (2 * s)) << 4); }
    }
    const int nk = K >> 6;
    if (probe != 1) gemm_dma(ga, gb, lda, ldb, 0, st0);
    __syncthreads();
    for (int kt = 0; kt < nk; kt += 2) {
        if (probe != 1) gemm_dma(ga, gb, lda, ldb, (kt + 1) * 64, st1);
        if (probe != 2) gemm_compute<SWAP>(lds, ao, bo, acc);
        __syncthreads();
        if (kt + 2 < nk && probe != 1) gemm_dma(ga, gb, lda, ldb, (kt + 2) * 64, st0);
        if (probe != 2) gemm_compute<SWAP>(lds + DSTAGE, ao, bo, acc);
        __syncthreads();
    }
}
DI void zero_acc(f32x16 (&acc)[2][2]) {
#pragma unroll
    for (int a = 0; a < 2; ++a)
#pragma unroll
        for (int b = 0; b < 2; ++b)
#pragma unroll
            for (int i = 0; i < 16; ++i) acc[a][b][i] = 0.f;
}
DI void tile_map(int t, int NT, int& mt, int& nt) {
    const int xcd = t & 7, j = t >> 3;
    const int grp = j / (8 * NT), rem = j - grp * 8 * NT;
    nt = rem >> 3; mt = xcd * 32 + grp * 8 + (rem & 7);
}
constexpr int CP = 132;
template <bool SWAP>
DI void acc_to_lds(const f32x16 (&acc)[2][2], unsigned char* lds) {
    const int lane = VTID & 63, w = VTID >> 6, wr = w >> 1, wc = w & 1, r = lane & 31, h = lane >> 5;
    float* base = (float*)lds + (SWAP ? ((wc * 64 + 4 * h) * CP + wr * 64 + r) : ((wr * 64 + 4 * h) * CP + wc * 64 + r));
#pragma unroll
    for (int mt = 0; mt < 2; ++mt)
#pragma unroll
        for (int nt = 0; nt < 2; ++nt)
#pragma unroll
            for (int i = 0; i < 16; ++i) {
                const int rr = (i & 3) + 8 * (i >> 2);
                if (SWAP) base[(nt * 32 + rr) * CP + mt * 32] = acc[mt][nt][i];
                else base[(mt * 32 + rr) * CP + nt * 32] = acc[mt][nt][i];
            }
}
DI void ld8(const float* q, float (&v)[8]) {
    const f32x4 a = *(const f32x4*)q, b = *(const f32x4*)(q + 4);
    v[0] = a[0]; v[1] = a[1]; v[2] = a[2]; v[3] = a[3]; v[4] = b[0]; v[5] = b[1]; v[6] = b[2]; v[7] = b[3];
}
DI u32x4 pk8(const float (&v)[8]) {
    u32x4 o; o.x = pk_bf16(v[0], v[1]); o.y = pk_bf16(v[2], v[3]); o.z = pk_bf16(v[4], v[5]); o.w = pk_bf16(v[6], v[7]);
    return o;
}
DI void out_plain(const unsigned char* lds, bf16_t* dst, size_t ldd, int nch_log2) {
    const float* Ct = (const float*)lds;
    const int total = 128 << nch_log2;
#pragma unroll 1
    for (int c = VTID; c < total; c += 256) {
        const int a = c >> nch_log2, ch = c & ((1 << nch_log2) - 1);
        float v[8]; ld8(Ct + a * CP + ch * 8, v);
        *(u32x4*)(dst + (size_t)a * ldd + ch * 8) = pk8(v);
    }
}

namespace pg8 {
#define PG8_LAS __attribute__((address_space(3)))
typedef unsigned short bf16_t;
typedef short bf16x8 __attribute__((ext_vector_type(8)));
typedef float f32x4 __attribute__((ext_vector_type(4)));
typedef unsigned u32x4 __attribute__((ext_vector_type(4)));
constexpr int BM = 256, BK = 64, HALF = 128, HTB = HALF * BK * 2  , STAGE_BYTES = 8 * HTB, NXCD = 8, WGM = 8;

__host__ __device__ __forceinline__ int lds_byte(int r, int c) { const int st = (r >> 4) * 2 + (c >> 5), rr = r & 15, cc = c & 31, ob = rr * 64 + cc * 2; return st * 1024 + (ob ^ (((ob >> 9) & 1) << 5)); }
__host__ __device__ __forceinline__ void stage_rc(int b, int& R, int& C) { const int st = b / 1024, sb = b % 1024, swz = sb ^ (((sb >> 9) & 1) << 5); R = (st >> 1) * 16 + swz / 64; C = (st & 1) * 32 + (swz % 64) / 2; }
__host__ __device__ __forceinline__ int perm32(int rho) { const int n = rho >> 4, i = rho & 15; return 8 * (i >> 2) + 4 * n + (i & 3); }

struct Unit { int pm, pn; };
struct Gemm { const bf16_t* A; const bf16_t* Bt; int M, N, K; };

struct StaticOrder {
    int nM, nN, nwg, G, c;
    __host__ __device__ void init(int M, int N, int G_, int c_) { nM = M / BM; nN = N / BM; nwg = nM * nN; G = G_; c = c_; }
    __host__ __device__ bool next(int i, Unit& u) const {
        const long L = (long)i * G + c; if (L >= nwg) return false;
        int wgid = (int)L; { const int q = nwg / NXCD, r = nwg % NXCD, xcd = wgid % NXCD, off = wgid / NXCD; wgid = (xcd < r ? xcd * (q + 1) : r * (q + 1) + (xcd - r) * q) + off; }
        const int nig = WGM * nN, gid = wgid / nig, fm = gid * WGM, gsz = (nM - fm) < WGM ? (nM - fm) : WGM;
        u.pm = fm + ((wgid % nig) % gsz); u.pn = (wgid % nig) / gsz; return true;
    }
    __device__ __forceinline__ void a_ready(const Unit&) const {}
    __device__ __forceinline__ void done(const Unit&) const {}
};

__device__ __forceinline__ unsigned cvt_pk_bf16(float lo, float hi) { unsigned r; asm volatile("v_cvt_pk_bf16_f32 %0, %1, %2" : "=v"(r) : "v"(lo), "v"(hi)); return r; }
typedef float f32x2 __attribute__((ext_vector_type(2)));
template <class Epi, class Sched, bool ALIGN_EPI = false, bool SP2 = false>
__device__ __forceinline__ void gemm_phase(PG8_LAS unsigned char* lds, const Gemm g, const Sched& S, const Epi& E) {
    const int tid = threadIdx.x, wid = __builtin_amdgcn_readfirstlane(tid >> 6), lane = tid & 63, wr = wid >> 2, wc = wid & 3, fr = lane & 15, fq = lane >> 4;
    const int K = g.K, nt = K / BK;
    unsigned voffA[2], voffB[2];
#pragma unroll
    for (int i = 0; i < 2; ++i) { int R, C; stage_rc(tid * 16 + i * 8192, R, C); const int Rb = Epi::PERM ? ((R & ~31) + perm32(R & 31)) : R;
        voffA[i] = (unsigned)(R * K + C) * 2u; voffB[i] = (unsigned)(Rb * K + C) * 2u; }
    const size_t kstep = (size_t)(BK * 2);
    const size_t hstep = (size_t)HALF * K * 2;
    const size_t tstep = 2 * hstep;
    const unsigned ldsw = (unsigned)wid * 1024u;
    const int aoff = lds_byte(wr * 64 + fr, fq * 8), boff = lds_byte(wc * 32 + fr, fq * 8);
#define PG8_SA(b, h) (((b) * 2 + (h)) * HTB)
#define PG8_SB(b, h) ((4 + (b) * 2 + (h)) * HTB)
#define PG8_STAGE(bufoff, gbase, voff) do { _Pragma("unroll") for (int _i = 0; _i < 2; ++_i) \
        __builtin_amdgcn_global_load_lds((const unsigned*)((const char*)(gbase) + (voff)[_i]), (PG8_LAS unsigned*)(lds + (bufoff) + ldsw + _i * 8192), 16, 0, 0); } while (0)
#define PG8_LDA(dst, b, h) do { _Pragma("unroll") for (int m = 0; m < 4; ++m) _Pragma("unroll") for (int k = 0; k < 2; ++k) dst[m][k] = *(const PG8_LAS bf16x8*)(lds + PG8_SA(b, h) + aoff + m * 2048 + k * 1024); } while (0)
#define PG8_LDB(dst, b, h) do { _Pragma("unroll") for (int n = 0; n < 2; ++n) _Pragma("unroll") for (int k = 0; k < 2; ++k) dst[n][k] = *(const PG8_LAS bf16x8*)(lds + PG8_SB(b, h) + boff + n * 2048 + k * 1024); } while (0)
#define PG8_MMA(ai, bj, At, Bt) do { __builtin_amdgcn_s_setprio(1); _Pragma("unroll") for (int m = 0; m < 4; ++m) _Pragma("unroll") for (int n = 0; n < 2; ++n) _Pragma("unroll") for (int k = 0; k < 2; ++k) \
        acc[ai][bj][m][n] = __builtin_amdgcn_mfma_f32_16x16x32_bf16(Bt[n][k], At[m][k], acc[ai][bj][m][n], 0, 0, 0); __builtin_amdgcn_s_setprio(0); } while (0)
#define PG8_WAIT_V(n) asm volatile("s_waitcnt vmcnt(" #n ")" ::: "memory")
#define PG8_WAIT_L(n) asm volatile("s_waitcnt lgkmcnt(" #n ")" ::: "memory")
#define PG8_BAR __builtin_amdgcn_s_barrier()
#define PG8_SCHED __builtin_amdgcn_sched_barrier(0)
    Unit cur, nxt; int ui = 0;
    if (!S.next(0, cur)) return;
    f32x4 acc[2][2][4][2];
#pragma unroll
    for (int a = 0; a < 2; ++a)
#pragma unroll
        for (int b = 0; b < 2; ++b)
#pragma unroll
            for (int m = 0; m < 4; ++m)
#pragma unroll
                for (int n = 0; n < 2; ++n) acc[a][b][m][n] = (f32x4){0.f, 0.f, 0.f, 0.f};
    bf16x8 At[4][2], B0[2][2], B1[2][2];
    const char* cA = (const char*)g.A + (size_t)cur.pm * tstep; const char* cB = (const char*)g.Bt + (size_t)cur.pn * tstep;
    S.a_ready(cur);
    if constexpr (SP2) {
        PG8_STAGE(PG8_SB(0, 0), cB, voffB); PG8_STAGE(PG8_SB(0, 1), cB + hstep, voffB); PG8_STAGE(PG8_SA(0, 0), cA, voffA); PG8_STAGE(PG8_SA(0, 1), cA + hstep, voffA);
        if (wr == 1) PG8_BAR;
        PG8_WAIT_V(2); PG8_BAR;
        PG8_STAGE(PG8_SB(1, 0), cB + kstep, voffB); PG8_STAGE(PG8_SA(1, 0), cA + kstep, voffA); PG8_STAGE(PG8_SB(1, 1), cB + hstep + kstep, voffB);
        PG8_WAIT_V(6); PG8_BAR;
    } else {
        PG8_STAGE(PG8_SB(0, 0), cB, voffB); PG8_STAGE(PG8_SA(0, 0), cA, voffA); PG8_STAGE(PG8_SB(0, 1), cB + hstep, voffB); PG8_STAGE(PG8_SA(0, 1), cA + hstep, voffA);
        if (wr == 1) PG8_BAR;
        PG8_WAIT_V(4); PG8_BAR;
        PG8_STAGE(PG8_SB(1, 0), cB + kstep, voffB); PG8_STAGE(PG8_SA(1, 0), cA + kstep, voffA); PG8_STAGE(PG8_SB(1, 1), cB + hstep + kstep, voffB);
        PG8_WAIT_V(6); PG8_BAR;
    }
    for (;;) {
        const bool has_next = S.next(ui + 1, nxt);
        const char* nA = has_next ? (const char*)g.A + (size_t)nxt.pm * tstep : cA; const char* nB = has_next ? (const char*)g.Bt + (size_t)nxt.pn * tstep : cB;
        for (int t = 0; t < nt; t += 2) {
            const bool last = (t == nt - 2);
            const char* a1 = cA + (size_t)(t + 1) * kstep;
            const char* a2 = last ? nA : cA + (size_t)(t + 2) * kstep; const char* b2 = last ? nB : cB + (size_t)(t + 2) * kstep;
            const char* a3 = a2 + kstep; const char* b3 = b2 + kstep;
            if (last && has_next) S.a_ready(nxt);
            if constexpr (SP2) {
            PG8_LDB(B0, 0, 0); PG8_LDB(B1, 0, 1); PG8_SCHED; PG8_LDA(At, 0, 0); PG8_STAGE(PG8_SA(1, 1), a1 + hstep, voffA);
            PG8_WAIT_V(8); PG8_WAIT_L(0); PG8_BAR; PG8_MMA(0, 0, At, B0); PG8_MMA(0, 1, At, B1); PG8_BAR; PG8_SCHED;
            PG8_LDA(At, 0, 1); PG8_STAGE(PG8_SB(0, 0), b2, voffB); PG8_STAGE(PG8_SB(0, 1), b2 + hstep, voffB); PG8_STAGE(PG8_SA(0, 0), a2, voffA);
            PG8_WAIT_V(8); PG8_WAIT_L(0); PG8_BAR; PG8_MMA(1, 0, At, B0); PG8_MMA(1, 1, At, B1); PG8_BAR; PG8_SCHED;
            PG8_LDB(B0, 1, 0); PG8_LDB(B1, 1, 1); PG8_SCHED; PG8_LDA(At, 1, 0); PG8_STAGE(PG8_SA(0, 1), a2 + hstep, voffA);
            PG8_WAIT_V(8); PG8_WAIT_L(0); PG8_BAR; PG8_MMA(0, 0, At, B0); PG8_MMA(0, 1, At, B1); PG8_BAR; PG8_SCHED;
            PG8_LDA(At, 1, 1); PG8_STAGE(PG8_SB(1, 0), b3, voffB); PG8_STAGE(PG8_SB(1, 1), b3 + hstep, voffB); PG8_STAGE(PG8_SA(1, 0), a3, voffA);
            PG8_WAIT_V(8); PG8_WAIT_L(0); PG8_BAR; PG8_MMA(1, 0, At, B0); PG8_MMA(1, 1, At, B1); PG8_BAR; PG8_SCHED;
            } else {
            PG8_LDB(B0, 0, 0); PG8_SCHED; PG8_LDA(At, 0, 0); PG8_STAGE(PG8_SA(1, 1), a1 + hstep, voffA);
            PG8_WAIT_L(8); PG8_BAR; PG8_WAIT_L(0); PG8_MMA(0, 0, At, B0); PG8_BAR; PG8_SCHED;
            PG8_LDB(B1, 0, 1); PG8_STAGE(PG8_SB(0, 0), b2, voffB);
            PG8_BAR; PG8_WAIT_L(0); PG8_MMA(0, 1, At, B1); PG8_BAR;
            PG8_LDA(At, 0, 1); PG8_STAGE(PG8_SA(0, 0), a2, voffA);
            PG8_BAR; PG8_WAIT_L(0); PG8_MMA(1, 0, At, B0); PG8_BAR; PG8_SCHED;
            PG8_STAGE(PG8_SB(0, 1), b2 + hstep, voffB);
            PG8_WAIT_V(6); PG8_BAR; PG8_MMA(1, 1, At, B1); PG8_BAR;
            PG8_LDB(B0, 1, 0); PG8_SCHED; PG8_LDA(At, 1, 0); PG8_STAGE(PG8_SA(0, 1), a2 + hstep, voffA);
            PG8_WAIT_L(8); PG8_BAR; PG8_WAIT_L(0); PG8_MMA(0, 0, At, B0); PG8_BAR; PG8_SCHED;
            PG8_LDB(B1, 1, 1); PG8_STAGE(PG8_SB(1, 0), b3, voffB);
            PG8_BAR; PG8_WAIT_L(0); PG8_MMA(0, 1, At, B1); PG8_BAR;
            PG8_LDA(At, 1, 1); PG8_STAGE(PG8_SA(1, 0), a3, voffA);
            PG8_BAR; PG8_WAIT_L(0); PG8_MMA(1, 0, At, B0); PG8_BAR; PG8_SCHED;
            PG8_STAGE(PG8_SB(1, 1), b3 + hstep, voffB);
            PG8_WAIT_V(6); PG8_BAR; PG8_MMA(1, 1, At, B1); PG8_BAR;
            }
        }
        if constexpr (ALIGN_EPI) { if (wr == 0) PG8_BAR; }
        if constexpr (!Epi::AFTER_DRAIN) { E(acc, cur, wr, wc, fr, fq); S.done(cur); }
        if (!has_next) break;
#pragma unroll
        for (int a = 0; a < 2; ++a)
#pragma unroll
            for (int b = 0; b < 2; ++b)
#pragma unroll
                for (int m = 0; m < 4; ++m)
#pragma unroll
                    for (int n = 0; n < 2; ++n) acc[a][b][m][n] = (f32x4){0.f, 0.f, 0.f, 0.f};
        cur = nxt; cA = nA; cB = nB; ++ui;
        if constexpr (ALIGN_EPI) { if (wr == 1) PG8_BAR; }
    }
    PG8_WAIT_V(0);
    if constexpr (!ALIGN_EPI) { if (wr == 0) PG8_BAR; }
    PG8_BAR;
    if constexpr (Epi::AFTER_DRAIN) { E.fused(acc, cur, wr, wc, fr, fq, lds, wid, lane); S.done(cur); }
#undef PG8_SA
#undef PG8_SB
#undef PG8_STAGE
#undef PG8_LDA
#undef PG8_LDB
#undef PG8_MMA
#undef PG8_WAIT_V
#undef PG8_WAIT_L
#undef PG8_BAR
#undef PG8_SCHED
}


struct EpiPlain {
    static constexpr bool PERM = true, AFTER_DRAIN = false;
    bf16_t* O; int ldc;
    __device__ __forceinline__ void operator()(const f32x4 (&acc)[2][2][4][2], const Unit& u, int wr, int wc, int fr, int fq) const {
        bf16_t* base = O + (size_t)(u.pm * BM + wr * 64 + fr) * ldc + u.pn * BM + wc * 32 + 8 * fq;
#pragma unroll
        for (int ai = 0; ai < 2; ++ai)
#pragma unroll
            for (int m = 0; m < 4; ++m) {
                bf16_t* rowp = base + (size_t)(ai * HALF + m * 16) * ldc;
#pragma unroll
                for (int bj = 0; bj < 2; ++bj) {
                    const f32x4 v0 = acc[ai][bj][m][0], v1 = acc[ai][bj][m][1];
                    u32x4 w; w.x = cvt_pk_bf16(v0[0], v0[1]); w.y = cvt_pk_bf16(v0[2], v0[3]); w.z = cvt_pk_bf16(v1[0], v1[1]); w.w = cvt_pk_bf16(v1[2], v1[3]);
                    *(u32x4*)(rowp + bj * HALF) = w;
                }
            }
    }
};
struct EpiSwiGLU {
    static constexpr bool PERM = true, AFTER_DRAIN = false;
    bf16_t* ACT; int ldc;
    __device__ __forceinline__ void operator()(const f32x4 (&acc)[2][2][4][2], const Unit& u, int wr, int wc, int fr, int fq) const {
        bf16_t* base = ACT + (size_t)(u.pm * BM + wr * 64 + fr) * ldc + ((u.pn * BM + wc * 32 + 8 * fq) >> 1);
#pragma unroll
        for (int ai = 0; ai < 2; ++ai)
#pragma unroll
            for (int m = 0; m < 4; ++m) {
                bf16_t* rowp = base + (size_t)(ai * HALF + m * 16) * ldc;
#pragma unroll
                for (int bj = 0; bj < 2; ++bj) {
                    const f32x4 g = acc[ai][bj][m][0], up = acc[ai][bj][m][1];
                    float a[4];
#pragma unroll
                    for (int e = 0; e < 4; ++e) a[e] = g[e] * __builtin_amdgcn_rcpf(1.f + __expf(-g[e])) * up[e];
                    typedef unsigned u32x2v __attribute__((ext_vector_type(2)));
                    u32x2v w; w.x = cvt_pk_bf16(a[0], a[1]); w.y = cvt_pk_bf16(a[2], a[3]);
                    *(u32x2v*)(rowp + bj * (HALF / 2)) = w;
                }
            }
    }
};
struct EpiInproj {
    static constexpr bool PERM = true, AFTER_DRAIN = false;
    unsigned char* ws; size_t off_qd, off_kd, off_vdt, off_qn, off_kct, off_vct, off_ks, off_vst, off_kw, off_vwt, off_gates, off_rope;
    __device__ __forceinline__ void operator()(const f32x4 (&acc)[2][2][4][2], const Unit& u, int wr, int wc, int fr, int fq) const {
        typedef unsigned u32x2v __attribute__((ext_vector_type(2)));
        typedef float f32x2v __attribute__((ext_vector_type(2)));
        const int row0 = u.pm * BM + wr * 64 + fr;
        const int b = row0 >> 12, pos0 = row0 & 4095;
#pragma unroll
        for (int bj = 0; bj < 2; ++bj) {
            const int cb = u.pn * BM + bj * HALF;
            const int cl = wc * 32 + 8 * fq;
            int kind = 4; size_t off = 0; int hidx = 0;
            if (cb < 512) { kind = 0; off = off_qd; hidx = b * 8 + ((cb + cl) >> 6); }
            else if (cb < 1024) { kind = 0; off = off_kd; hidx = b * 8 + ((cb - 512 + cl) >> 6); }
            else if (cb < 1536) { kind = 2; off = off_vdt; hidx = b * 4 + ((cb - 1024) >> 7); }
            else if (cb < 2048) { kind = 0; off = off_qn; hidx = b * 8 + ((cb - 1536 + cl) >> 6); }
            else if (cb == 2048) { kind = 0; off = off_kct; hidx = b * 2 + (cl >> 6); }
            else if (cb == 2176) { kind = 1; off = off_vct; hidx = b * 2 + (cl >> 6); }
            else if (cb == 2304) { kind = 0; off = off_ks; hidx = b * 2 + (cl >> 6); }
            else if (cb == 2432) { kind = 3; off = off_vst; hidx = b * 2 + (cl >> 6); }
            else if (cb == 2560) { kind = 0; off = off_kw; hidx = b * 2 + (cl >> 6); }
            else if (cb == 2688) { kind = 3; off = off_vwt; hidx = b * 2 + (cl >> 6); }
            else if (cb == 2816) kind = 5;
            if (kind == 0) {
                const int g4 = 4 * (((cl & 63) >> 3));
                bf16_t* dst = (bf16_t*)(ws + off) + ((size_t)hidx * 4096 + pos0) * 64 + g4;
                const f32x2v* tab = (const f32x2v*)(ws + off_rope) + (size_t)pos0 * 32 + g4;
#pragma unroll
                for (int ai = 0; ai < 2; ++ai)
#pragma unroll
                    for (int m = 0; m < 4; ++m) {
                        const int dp = ai * HALF + m * 16;
                        const f32x4 x1 = acc[ai][bj][m][0], x2 = acc[ai][bj][m][1];
                        const f32x4 t01 = *(const f32x4*)(tab + (size_t)dp * 32), t23 = *(const f32x4*)(tab + (size_t)dp * 32 + 2);
                        const float c0 = t01[0], s0 = t01[1], c1 = t01[2], s1 = t01[3], c2 = t23[0], s2 = t23[1], c3 = t23[2], s3 = t23[3];
                        u32x2v lo, hi;
                        lo.x = cvt_pk_bf16(x1[0] * c0 - x2[0] * s0, x1[1] * c1 - x2[1] * s1); lo.y = cvt_pk_bf16(x1[2] * c2 - x2[2] * s2, x1[3] * c3 - x2[3] * s3);
                        hi.x = cvt_pk_bf16(x1[0] * s0 + x2[0] * c0, x1[1] * s1 + x2[1] * c1); hi.y = cvt_pk_bf16(x1[2] * s2 + x2[2] * c2, x1[3] * s3 + x2[3] * c3);
                        *(u32x2v*)(dst + (size_t)dp * 64) = lo; *(u32x2v*)(dst + (size_t)dp * 64 + 32) = hi;
                    }
            } else if (kind == 1) {
                bf16_t* dst = (bf16_t*)(ws + off) + ((size_t)hidx * 4096 + pos0) * 64 + (cl & 63);
#pragma unroll
                for (int ai = 0; ai < 2; ++ai)
#pragma unroll
                    for (int m = 0; m < 4; ++m) {
                        const f32x4 v0 = acc[ai][bj][m][0], v1 = acc[ai][bj][m][1];
                        u32x4 w; w.x = cvt_pk_bf16(v0[0], v0[1]); w.y = cvt_pk_bf16(v0[2], v0[3]); w.z = cvt_pk_bf16(v1[0], v1[1]); w.w = cvt_pk_bf16(v1[2], v1[3]);
                        *(u32x4*)(dst + (size_t)(ai * HALF + m * 16) * 64) = w;
                    }
            } else if (kind == 2 || kind == 3) {
                const int dv = (kind == 2) ? 128 : 64;
                const int e0 = (kind == 2) ? cl : (cl & 63);
#pragma unroll
                for (int ai = 0; ai < 2; ++ai) {
                    const int pa = pos0 + ai * HALF;
                    bf16_t* dst = (bf16_t*)(ws + off) + (((size_t)hidx * 64 + (pa >> 6)) * dv + e0) * 64 + (pa & 63);
#pragma unroll
                    for (int m = 0; m < 4; ++m)
#pragma unroll
                        for (int n = 0; n < 2; ++n)
#pragma unroll
                            for (int j = 0; j < 4; ++j) {
                                const unsigned pk = cvt_pk_bf16(acc[ai][bj][m][n][j], 0.f);
                                dst[(4 * n + j) * 64 + 16 * m] = (bf16_t)(pk & 0xffffu);
                            }
                }
            } else if (kind == 5) {
                if (wc == 0 && fq < 3) {
                    float* gates = (float*)(ws + off_gates) + (size_t)row0 * 24 + 8 * fq;
#pragma unroll
                    for (int ai = 0; ai < 2; ++ai)
#pragma unroll
                        for (int m = 0; m < 4; ++m) {
                            f32x4 a = acc[ai][bj][m][0], c = acc[ai][bj][m][1];
#pragma unroll
                            for (int e = 0; e < 4; ++e) { a[e] = 1.f / (1.f + __expf(-a[e])); c[e] = 1.f / (1.f + __expf(-c[e])); }
                            float* gp = gates + (size_t)(ai * HALF + m * 16) * 24;
                            *(f32x4*)gp = a; *(f32x4*)(gp + 4) = c;
                        }
                }
            }
        }
    }
};
}

DI void epi_inproj(const Params& p, const unsigned char* lds, int m0, int n0) {
    unsigned char* ws = p.ws;
    const float* Ct = (const float*)lds;
    const int b = m0 >> 12, pos0 = m0 & 4095;
    int tid = VTID; asm volatile("" : "+v"(tid));
    if (n0 == 2816) {
        float* gates = (float*)(ws + OFF_GATES);
#pragma unroll 1
        for (int c = tid; c < 128 * 3; c += 256) {
            const int a = c / 3, ch = c - a * 3;
            float v[8]; ld8(Ct + a * CP + ch * 8, v);
            f32x4 o0, o1;
            o0[0] = sigmoidf(v[0]); o0[1] = sigmoidf(v[1]); o0[2] = sigmoidf(v[2]); o0[3] = sigmoidf(v[3]);
            o1[0] = sigmoidf(v[4]); o1[1] = sigmoidf(v[5]); o1[2] = sigmoidf(v[6]); o1[3] = sigmoidf(v[7]);
            float* g = gates + (size_t)(m0 + a) * 24 + ch * 8;
            *(f32x4*)g = o0; *(f32x4*)(g + 4) = o1;
        }
        return;
    }
    const bool tr = (n0 >= 1024 && n0 < 1536) || n0 == 2432 || n0 == 2688;
    if (tr) {
        bf16_t* dst; int hshift, hbase, nbase;
        if (n0 < 1536) { dst = (bf16_t*)(ws + OFF_VDT); hshift = 7; hbase = b * 4; nbase = 1024; }
        else if (n0 == 2432) { dst = (bf16_t*)(ws + OFF_VST); hshift = 6; hbase = b * 2; nbase = 2432; }
        else { dst = (bf16_t*)(ws + OFF_VWT); hshift = 6; hbase = b * 2; nbase = 2688; }
#pragma unroll 1
        for (int c = tid; c < 2048; c += 256) {
            const int a = c >> 4, ch = c & 15;
            const int cr = n0 + a - nbase;
            const int hidx = hbase + (cr >> hshift), e = cr & ((1 << hshift) - 1);
            float v[8]; ld8(Ct + a * CP + ch * 8, v);
            const int pos = pos0 + ch * 8;
            *(u32x4*)(dst + ((((size_t)hidx * 64 + (pos >> 6)) << hshift) + e) * 64 + (pos & 63)) = pk8(v);
        }
        return;
    }
    if (n0 == 2176) {
        bf16_t* dst = (bf16_t*)(ws + OFF_VCT);
#pragma unroll 1
        for (int c = tid; c < 2048; c += 256) {
            const int a = c >> 4, ch = c & 15;
            const int hidx = b * 2 + (ch >> 3);
            float v[8]; ld8(Ct + a * CP + ch * 8, v);
            *(u32x4*)(dst + ((size_t)hidx * 4096 + pos0 + a) * 64 + (ch & 7) * 8) = pk8(v);
        }
        return;
    }
    {
        bf16_t* dst; int hbase;
        if (n0 < 512) { dst = (bf16_t*)(ws + OFF_QD); hbase = b * 8 + (n0 >> 6); }
        else if (n0 < 1024) { dst = (bf16_t*)(ws + OFF_KD); hbase = b * 8 + ((n0 - 512) >> 6); }
        else if (n0 < 2048) { dst = (bf16_t*)(ws + OFF_QN); hbase = b * 8 + ((n0 - 1536) >> 6); }
        else if (n0 == 2048) { dst = (bf16_t*)(ws + OFF_KCT); hbase = b * 2; }
        else if (n0 == 2304) { dst = (bf16_t*)(ws + OFF_KS); hbase = b * 2; }
        else { dst = (bf16_t*)(ws + OFF_KW); hbase = b * 2; }
        const float* tab = (const float*)(ws + OFF_ROPE);
#pragma unroll 1
        for (int c = tid; c < 1024; c += 256) {
            const int a = c >> 3, hd = (c >> 2) & 1, cc = c & 3;
            float x1[8], x2[8], cs[16];
            ld8(Ct + a * CP + hd * 64 + cc * 8, x1); ld8(Ct + a * CP + hd * 64 + 32 + cc * 8, x2);
            const int pos = pos0 + a;
            const float* tp = tab + ((size_t)pos * 32 + cc * 8) * 2;
            {
                const f32x4 t0 = *(const f32x4*)tp, t1 = *(const f32x4*)(tp + 4), t2 = *(const f32x4*)(tp + 8), t3 = *(const f32x4*)(tp + 12);
                cs[0] = t0[0]; cs[1] = t0[1]; cs[2] = t0[2]; cs[3] = t0[3]; cs[4] = t1[0]; cs[5] = t1[1]; cs[6] = t1[2]; cs[7] = t1[3];
                cs[8] = t2[0]; cs[9] = t2[1]; cs[10] = t2[2]; cs[11] = t2[3]; cs[12] = t3[0]; cs[13] = t3[1]; cs[14] = t3[2]; cs[15] = t3[3];
            }
            float y1[8], y2[8];
#pragma unroll
            for (int e = 0; e < 8; ++e) { const float cv = cs[2 * e], sv = cs[2 * e + 1]; y1[e] = x1[e] * cv - x2[e] * sv; y2[e] = x1[e] * sv + x2[e] * cv; }
            bf16_t* d = dst + ((size_t)(hbase + hd) * 4096 + pos) * 64 + cc * 8;
            *(u32x4*)d = pk8(y1); *(u32x4*)(d + 32) = pk8(y2);
        }
    }
}
DI void phase1(const Params& p, unsigned char* lds) {
    pg8::Gemm g; g.A = (const bf16_t*)(p.ws + OFF_H); g.Bt = (const bf16_t*)(p.ws + OFF_WINT); g.M = T; g.N = INP; g.K = 1024;
    pg8::StaticOrder S; S.init(T, INP, (int)gridDim.x, (int)blockIdx.x);
    pg8::EpiInproj E; E.ws = p.ws; E.off_qd = OFF_QD; E.off_kd = OFF_KD; E.off_vdt = OFF_VDT; E.off_qn = OFF_QN; E.off_kct = OFF_KCT; E.off_vct = OFF_VCT;
    E.off_ks = OFF_KS; E.off_vst = OFF_VST; E.off_kw = OFF_KW; E.off_vwt = OFF_VWT; E.off_gates = OFF_GATES; E.off_rope = OFF_ROPE;
    pg8::gemm_phase<pg8::EpiInproj, pg8::StaticOrder, true, true>((PG8_LAS unsigned char*)lds, g, S, E);
    __syncthreads();
}

DI void phase2(const Params& p, unsigned char* lds) {
    unsigned char* hl = lds + VHALF * HALF_LDS;
    for (int t = blockIdx.x; t < 128; t += gridDim.x) {
        const int kv = t >> 6, bg = (t >> 2) & 15, mt = (t >> 1) & 1, nt = t & 1, kh = VHALF * 1024;
        const bf16_t* A = (const bf16_t*)(p.ws + (kv ? OFF_VCT : OFF_KCT)) + (size_t)bg * 4096 * 64 + (size_t)mt * 128 * 1024 + kh;
        const bf16_t* B = (const bf16_t*)(p.ws + OFF_W1T) + (size_t)kv * 256 * 2048 + (size_t)nt * 128 * 2048 + kh;
        f32x16 acc[2][2]; zero_acc(acc);
        gemm_main<false>(A, 1024, B, 2048, 1024, acc, hl);
        acc_to_lds<false>(acc, hl);
        __syncthreads();
        const float* b1 = (const float*)(p.ws + OFF_B1) + kv * 256 + nt * 128;
        bf16_t* HID = (bf16_t*)(p.ws + OFF_HID) + (size_t)(kv * 16 + bg) * 65536 + (size_t)mt * 128 * 256 + nt * 128;
        const float* C0 = (const float*)lds; const float* C1 = (const float*)(lds + HALF_LDS);
#pragma unroll 1
        for (int c = threadIdx.x; c < 2048; c += 512) {
            const int a = c >> 4, ch = c & 15;
            float v[8], v2[8], bb[8]; ld8(C0 + a * CP + ch * 8, v); ld8(C1 + a * CP + ch * 8, v2); ld8(b1 + ch * 8, bb);
#pragma unroll
            for (int e = 0; e < 8; ++e) { const float z = (v[e] + v2[e]) + bb[e]; v[e] = z * sigmoidf(z); }
            *(u32x4*)(HID + (size_t)a * 256 + ch * 8) = pk8(v);
        }
        __syncthreads();
    }
}
DI void phase3(const Params& p, unsigned char* lds) {
    unsigned char* hl = lds + VHALF * HALF_LDS;
    for (int t = blockIdx.x; t < 64; t += gridDim.x) {
        const int kv = t >> 5, bg = (t >> 1) & 15, mt = t & 1, kh = VHALF * 128;
        const bf16_t* A = (const bf16_t*)(p.ws + OFF_HID) + (size_t)(kv * 16 + bg) * 65536 + (size_t)mt * 128 * 256 + kh;
        const bf16_t* B = (const bf16_t*)(p.ws + OFF_W2T) + (size_t)kv * 128 * 256 + kh;
        f32x16 acc[2][2]; zero_acc(acc);
        if (kv == 0) { gemm_main<false>(A, 256, B, 256, 128, acc, hl); acc_to_lds<false>(acc, hl); }
        else { gemm_main<true>(A, 256, B, 256, 128, acc, hl); acc_to_lds<true>(acc, hl); }
        __syncthreads();
        const float* C0 = (const float*)lds; const float* C1 = (const float*)(lds + HALF_LDS);
        if (kv == 0) {
            bf16_t* KC = (bf16_t*)(p.ws + OFF_KCMP) + (size_t)bg * 256 * 64 + (size_t)mt * 128 * 64;
#pragma unroll 1
            for (int c = threadIdx.x; c < 128 * 8; c += 512) {
                const int a = c >> 3, ch = c & 7;
                float v[8], v2[8]; ld8(C0 + a * CP + ch * 8, v); ld8(C1 + a * CP + ch * 8, v2);
#pragma unroll
                for (int e = 0; e < 8; ++e) v[e] += v2[e];
                *(u32x4*)(KC + (size_t)a * 64 + ch * 8) = pk8(v);
            }
        } else {
            bf16_t* VC = (bf16_t*)(p.ws + OFF_VCMPT) + (size_t)bg * 64 * 256;
#pragma unroll 1
            for (int c = threadIdx.x; c < 64 * 16; c += 512) {
                const int a = c >> 4, ch = c & 15;
                const int n = mt * 128 + ch * 8;
                float v[8], v2[8]; ld8(C0 + a * CP + ch * 8, v); ld8(C1 + a * CP + ch * 8, v2);
#pragma unroll
                for (int e = 0; e < 8; ++e) v[e] += v2[e];
                *(u32x4*)(VC + ((size_t)(n >> 6) * 64 + a) * 64 + (n & 63)) = pk8(v);
            }
        }
        __syncthreads();
    }
}

constexpr int KP = 144;
constexpr int VP = 144;
constexpr int KT_BYTES = 64 * KP;
constexpr float SM_C = 0.125f * 1.4426950408889634f;
#define NEG_INF (-__builtin_inff())

template <int DV> struct KVStage { u32x4 k[1]; u32x4 v[DV / 64]; };

template <int DV, bool HAS_V>
DI void kv_gload(KVStage<DV>& st, const bf16_t* __restrict__ Kb, const bf16_t* __restrict__ VTb, int ldv, int key0) {
    const int tid = threadIdx.x;
    st.k[0] = *(const u32x4*)(Kb + (size_t)(key0 + (tid >> 3)) * 64 + (tid & 7) * 8);
    if (HAS_V) {
#pragma unroll
        for (int i = 0; i < DV / 64; ++i) { const int c = tid + 512 * i; st.v[i] = *(const u32x4*)(VTb + (size_t)(key0 >> 6) * (DV * 64) + c * 8); }
    }
}
template <int DV, bool HAS_V>
DI void kv_sstore(const KVStage<DV>& st, unsigned char* buf) {
    const int tid = threadIdx.x;
    *(u32x4*)(buf + (tid >> 3) * KP + (tid & 7) * 16) = st.k[0];
    if (HAS_V) {
#pragma unroll
        for (int i = 0; i < DV / 64; ++i) {
            const int c = tid + 512 * i, kc = c & 7; unsigned char* q = buf + KT_BYTES + (c >> 3) * VP + (kc >> 1) * 32 + (kc & 1) * 8;
            u32x2 lo, hi; lo.x = st.v[i].x; lo.y = st.v[i].y; hi.x = st.v[i].z; hi.y = st.v[i].w;
            *(u32x2*)q = lo; *(u32x2*)(q + 16) = hi;
        }
    }
}
template <int DV, bool HAS_V, class Next, class Body>
DI void kv_loop(unsigned char* lds, const bf16_t* Kb, const bf16_t* VTb, int ldv, int nt, int j0, Next next, Body body, int probe = 0) {
    constexpr int SB = KT_BYTES + (HAS_V ? DV * VP : 0);
    KVStage<DV> st;
    int jn = j0;
    if (probe != 1) { kv_gload<DV, HAS_V>(st, Kb, VTb, ldv, jn * 64); kv_sstore<DV, HAS_V>(st, lds); }
    __syncthreads();
    for (int i = 0; i < nt; ++i) {
        const int j = jn;
        const bool more = (i + 1 < nt);
        if (more) { jn = next(j); if (probe != 1) kv_gload<DV, HAS_V>(st, Kb, VTb, ldv, jn * 64); }
        if (probe != 2) body(j, (const unsigned char*)(lds + (i & 1) * SB));
        if (more && probe != 1) kv_sstore<DV, HAS_V>(st, lds + ((i + 1) & 1) * SB);
        __syncthreads();
    }
}
DI void attn_scores(const unsigned char* kb, const bf16x8 (&qf)[4], int r, int h, f32x16& s0, f32x16& s1) {
#pragma unroll
    for (int i = 0; i < 16; ++i) { s0[i] = 0.f; s1[i] = 0.f; }
#pragma unroll
    for (int s = 0; s < 4; ++s) {
        const bf16x8 k0 = *(const bf16x8*)(kb + r * KP + s * 32 + h * 16);
        const bf16x8 k1 = *(const bf16x8*)(kb + (32 + r) * KP + s * 32 + h * 16);
        s0 = MFMA(k0, qf[s], s0); s1 = MFMA(k1, qf[s], s1);
    }
}
DI void pack_p(const f32x16& p0, const f32x16& p1, bf16x8 (&pf)[2][2]) {
#pragma unroll
    for (int sp = 0; sp < 2; ++sp) {
        u32x4 a, b;
        a.x = pk_bf16(p0[8 * sp + 0], p0[8 * sp + 1]); a.y = pk_bf16(p0[8 * sp + 2], p0[8 * sp + 3]);
        a.z = pk_bf16(p0[8 * sp + 4], p0[8 * sp + 5]); a.w = pk_bf16(p0[8 * sp + 6], p0[8 * sp + 7]);
        b.x = pk_bf16(p1[8 * sp + 0], p1[8 * sp + 1]); b.y = pk_bf16(p1[8 * sp + 2], p1[8 * sp + 3]);
        b.z = pk_bf16(p1[8 * sp + 4], p1[8 * sp + 5]); b.w = pk_bf16(p1[8 * sp + 6], p1[8 * sp + 7]);
        pf[0][sp] = __builtin_bit_cast(bf16x8, a); pf[1][sp] = __builtin_bit_cast(bf16x8, b);
    }
}
template <int DV>
DI void attn_pv(const unsigned char* vb, const bf16x8 (&pf)[2][2], int r, int h, f32x16 (&o)[DV / 32]) {
#pragma unroll
    for (int dt = 0; dt < DV / 32; ++dt)
#pragma unroll
        for (int mt = 0; mt < 2; ++mt)
#pragma unroll
            for (int sp = 0; sp < 2; ++sp) {
                const bf16x8 vf = *(const bf16x8*)(vb + (dt * 32 + r) * VP + (2 * mt + sp) * 32 + h * 16);
                o[dt] = MFMA(vf, pf[mt][sp], o[dt]);
            }
}
constexpr float SM_THR = 7.2f;
typedef float f32x8 __attribute__((ext_vector_type(8)));
DI float hsum16(const f32x16& v) {
    const f32x8 a = __builtin_shufflevector(v, v, 0, 1, 2, 3, 4, 5, 6, 7) + __builtin_shufflevector(v, v, 8, 9, 10, 11, 12, 13, 14, 15);
    const f32x4 b = __builtin_shufflevector(a, a, 0, 1, 2, 3) + __builtin_shufflevector(a, a, 4, 5, 6, 7);
    return (b[0] + b[1]) + (b[2] + b[3]);
}
template <int DV>
DI void attn_softmax_pv(f32x16& s0, f32x16& s1, float& m, f32x16& lv, f32x16 (&o)[DV / 32], const unsigned char* vb, int r, int h, bool on = true) {
    s0 = s0 * SM_C; s1 = s1 * SM_C;
    const f32x16 t = __builtin_elementwise_max(s0, s1);
    float mx = fmaxf(fmaxf(fmaxf(t[0], t[1]), fmaxf(t[2], t[3])), fmaxf(fmaxf(t[4], t[5]), fmaxf(t[6], t[7])));
    mx = fmaxf(mx, fmaxf(fmaxf(fmaxf(t[8], t[9]), fmaxf(t[10], t[11])), fmaxf(fmaxf(t[12], t[13]), fmaxf(t[14], t[15]))));
    mx = on ? mx : NEG_INF;
    mx = xhalf_max(mx);
    if (!__all(mx - m <= SM_THR)) {
        const float mn = fmaxf(m, mx);
        const float alpha = fast_exp2(m - mn);
        lv = lv * alpha; m = mn;
#pragma unroll
        for (int dt = 0; dt < DV / 32; ++dt) o[dt] = o[dt] * alpha;
    }
    const float msub = on ? m : __builtin_inff();
    s0 = s0 - msub; s1 = s1 - msub;
#pragma unroll
    for (int i = 0; i < 16; ++i) { s0[i] = fast_exp2(s0[i]); s1[i] = fast_exp2(s1[i]); }
    lv = lv + (s0 + s1);
    bf16x8 pf[2][2]; pack_p(s0, s1, pf);
    attn_pv<DV>(vb, pf, r, h, o);
}

DI void diff_unit(const Params& p, int u, unsigned char* lds, int probe = 0) {
    int tid_ = threadIdx.x; asm volatile("" : "+v"(tid_));
    const int lane = tid_ & 63, w = tid_ >> 6, r = lane & 31, h = lane >> 5;
    const int qt = 15 - (u >> 5), bh = u & 31, b = bh >> 2, hh = bh & 3;
    const int q0 = qt * 256, wq0 = q0 + 32 * w, qpos = wq0 + r;
    const int ntl = 4 * qt + 4;
    const float lam = ((const float*)(p.ws + OFF_CTL))[16];
    const bf16_t* VTb = (const bf16_t*)(p.ws + OFF_VDT) + (size_t)(b * 4 + hh) * 128 * 4096;
#pragma unroll 1
    for (int mp = 0; mp < 2; ++mp) {
        const size_t hoff = ((size_t)(b * 8 + hh * 2 + mp) * 4096) * 64;
        const bf16_t* Qb = (const bf16_t*)(p.ws + OFF_QD) + hoff;
        const bf16_t* Kb = (const bf16_t*)(p.ws + OFF_KD) + hoff;
        bf16x8 qf[4];
#pragma unroll
        for (int s = 0; s < 4; ++s) qf[s] = *(const bf16x8*)(Qb + (size_t)qpos * 64 + s * 16 + h * 8);
#pragma unroll
        for (int s = 0; s < 4; ++s) asm volatile("" : "+v"(qf[s]));
        f32x16 o[4];
#pragma unroll
        for (int dt = 0; dt < 4; ++dt)
#pragma unroll
            for (int i = 0; i < 16; ++i) o[dt][i] = 0.f;
        float m = -1e30f; f32x16 lv;
#pragma unroll
        for (int i = 0; i < 16; ++i) lv[i] = 0.f;
        kv_loop<128, true>(lds, Kb, VTb, 4096, ntl, 0, [](int j) { return j + 1; }, [&](int j, const unsigned char* sb) {
            const int k0 = j * 64;
            if (k0 <= wq0 + 31) {
                f32x16 s0, s1; attn_scores(sb, qf, r, h, s0, s1);
                if (k0 + 63 > wq0) {
#pragma unroll
                    for (int i = 0; i < 16; ++i) {
                        const int kl = k0 + crow(i, h);
                        if (kl > qpos) s0[i] = NEG_INF;
                        if (kl + 32 > qpos) s1[i] = NEG_INF;
                    }
                }
                attn_softmax_pv<128>(s0, s1, m, lv, o, sb + KT_BYTES, r, h);
            }
        }, probe);
        const float l = xhalf_sum(hsum16(lv));
        if (probe) {
            float chk = l + m;
#pragma unroll
            for (int dt = 0; dt < 4; ++dt)
#pragma unroll
                for (int i = 0; i < 16; ++i) chk += o[dt][i];
            if (chk == 1.2345e-30f) ((float*)(p.ws + OFF_CTL))[32] = chk;
            continue;
        }
        const float inv = 1.f / l;
        bf16_t* O = (bf16_t*)(p.ws + OFF_O) + ((size_t)b * 4096 + qpos) * 1024 + hh * 128;
        if (mp == 0) {
#pragma unroll
            for (int dt = 0; dt < 4; ++dt)
#pragma unroll
                for (int g4 = 0; g4 < 4; ++g4) {
                    u32x2 ov; ov.x = pk_bf16(o[dt][4 * g4] * inv, o[dt][4 * g4 + 1] * inv); ov.y = pk_bf16(o[dt][4 * g4 + 2] * inv, o[dt][4 * g4 + 3] * inv);
                    *(u32x2*)(O + dt * 32 + 8 * g4 + 4 * h) = ov;
                }
        } else {
            float ss = 0.f;
            const float li = lam * inv;
#pragma unroll
            for (int dt = 0; dt < 4; ++dt)
#pragma unroll
                for (int g4 = 0; g4 < 4; ++g4) {
                    const u32x2 pv = *(const u32x2*)(O + dt * 32 + 8 * g4 + 4 * h);
                    const float v0 = bflo(pv.x) - li * o[dt][4 * g4], v1 = bfhi(pv.x) - li * o[dt][4 * g4 + 1];
                    const float v2 = bflo(pv.y) - li * o[dt][4 * g4 + 2], v3 = bfhi(pv.y) - li * o[dt][4 * g4 + 3];
                    o[dt][4 * g4] = v0; o[dt][4 * g4 + 1] = v1; o[dt][4 * g4 + 2] = v2; o[dt][4 * g4 + 3] = v3;
                    ss += (v0 * v0 + v1 * v1) + (v2 * v2 + v3 * v3);
                }
            ss = xhalf_sum(ss);
            const float rstd = rsqrtf(ss * (1.f / 128.f) + NORM_EPS) * 0.8f;
            const float* sub = p.in[7];
#pragma unroll
            for (int dt = 0; dt < 4; ++dt)
#pragma unroll
                for (int g4 = 0; g4 < 4; ++g4) {
                    const int d = dt * 32 + 8 * g4 + 4 * h;
                    const f32x4 sg = *(const f32x4*)(sub + d);
                    u32x2 ov; ov.x = pk_bf16(o[dt][4 * g4] * rstd * sg[0], o[dt][4 * g4 + 1] * rstd * sg[1]);
                    ov.y = pk_bf16(o[dt][4 * g4 + 2] * rstd * sg[2], o[dt][4 * g4 + 3] * rstd * sg[3]);
                    *(u32x2*)(O + d) = ov;
                }
        }
    }
}

constexpr int NSA_IMPW = 36864;
constexpr int NSA_SEL = NSA_IMPW + 65536;
constexpr int NSA_UN = NSA_SEL + 512;
constexpr int NSA_FT = NSA_UN + 64;
constexpr int LDS_UNIT = 2 * 73728 + 16;
DI void nsa_unit(const Params& p, int u, unsigned char* lds, int probe = 0) {
    int tid_ = threadIdx.x; asm volatile("" : "+v"(tid_));
    const int lane = tid_ & 63, w = tid_ >> 6, r = lane & 31, h = lane >> 5;
    const int qt = 63 - (u >> 4), bg = u & 15, b = bg >> 1, g = bg & 1;
    const int hq = w >> 2, q0 = qt * 64, qb = q0 + 32 * hq, qpos = qb + r, head = g * 4 + (w & 3);
    float* IMPW = (float*)(lds + NSA_IMPW);
    u64* SEL = (u64*)(lds + NSA_SEL);
    u64* UN = (u64*)(lds + NSA_UN);
    const bf16_t* Qb = (const bf16_t*)(p.ws + OFF_QN) + ((size_t)(b * 8 + head) * 4096) * 64;
    bf16x8 qf[4];
#pragma unroll
    for (int s = 0; s < 4; ++s) qf[s] = *(const bf16x8*)(Qb + (size_t)qpos * 64 + s * 16 + h * 8);
#pragma unroll
    for (int s = 0; s < 4; ++s) asm volatile("" : "+v"(qf[s]));
    const float* gp = (const float*)(p.ws + OFF_GATES) + ((size_t)b * 4096 + qpos) * 24 + head * 3;
    auto inc = [](int j) { return j + 1; };
    f32x16 oacc[2];

    float* FT = (float*)(lds + NSA_FT);
    {
        const bf16_t* Kc = (const bf16_t*)(p.ws + OFF_KCMP) + (size_t)bg * 256 * 64;
        const bf16_t* VcT = (const bf16_t*)(p.ws + OFF_VCMPT) + (size_t)bg * 64 * 256;
        const int nmax = ((q0 + 32) >> 4) + 1, ntc = (nmax + 63) >> 6;
        const int nvalid = qpos >= 31 ? ((qpos - 31) >> 4) + 1 : 0;
        float m = -1e30f, l = 0.f, carry = 0.f;
        f32x16 oc[2];
#pragma unroll
        for (int dt = 0; dt < 2; ++dt)
#pragma unroll
            for (int i = 0; i < 16; ++i) oc[dt][i] = 0.f;
        kv_loop<64, true>(lds, Kc, VcT, 256, ntc, 0, inc, [&](int j, const unsigned char* sb) {
            f32x16 s0, s1; attn_scores(sb, qf, r, h, s0, s1);
            float mx = NEG_INF;
#pragma unroll
            for (int i = 0; i < 16; ++i) {
                const int n = j * 64 + crow(i, h);
                if (n >= nvalid) s0[i] = NEG_INF;
                if (n + 32 >= nvalid) s1[i] = NEG_INF;
                mx = fmaxf(mx, fmaxf(s0[i], s1[i]));
            }
            mx = xhalf_max(mx);
            const float mn = fmaxf(m, mx);
            const float alpha = fast_exp2((m - mn) * SM_C), nb = -mn * SM_C;
            m = mn; l *= alpha; carry *= alpha;
#pragma unroll
            for (int dt = 0; dt < 2; ++dt) oc[dt] = oc[dt] * alpha;
            if (h == 0) FT[(w * 32 + r) * 4 + j] = mn;
            float rs = 0.f;
#pragma unroll
            for (int i = 0; i < 16; ++i) {
                s0[i] = fast_exp2(__builtin_fmaf(s0[i], SM_C, nb)); s1[i] = fast_exp2(__builtin_fmaf(s1[i], SM_C, nb));
                rs += s0[i] + s1[i];
            }
            l += xhalf_sum(rs);
#pragma unroll
            for (int mt = 0; mt < 2; ++mt)
#pragma unroll
                for (int a = 0; a < 4; ++a) {
                    const float x0 = mt ? s1[4 * a] : s0[4 * a], x1 = mt ? s1[4 * a + 1] : s0[4 * a + 1];
                    const float x2 = mt ? s1[4 * a + 2] : s0[4 * a + 2], x3 = mt ? s1[4 * a + 3] : s0[4 * a + 3];
                    float mainv = ((x0 + x1) + x2) + 0.5f * x3;
                    const float cr = 0.5f * x3;
                    const float other = __shfl_xor(cr, 32);
                    mainv += h ? other : carry;
                    carry = other;
                    IMPW[(w * 32 + r) * 64 + 16 * j + 8 * mt + 2 * a + h] = mainv;
                }
            bf16x8 pf[2][2]; pack_p(s0, s1, pf);
            attn_pv<64>(sb + KT_BYTES, pf, r, h, oc);
        }, probe);
        const float invl = l > 0.f ? 1.f / l : 0.f;
        if (h == 0) {
#pragma unroll
            for (int t = 0; t < 4; ++t)
                if (t < ntc) { const float mt_ = FT[(w * 32 + r) * 4 + t]; FT[(w * 32 + r) * 4 + t] = fast_exp2((mt_ - m) * SM_C) * invl; }
        }
        const float g0 = gp[0] * invl;
#pragma unroll
        for (int dt = 0; dt < 2; ++dt)
#pragma unroll
            for (int i = 0; i < 16; ++i) oacc[dt][i] = g0 * oc[dt][i];
        __syncthreads();
    }
    {
        unsigned uk8[8]; bool val8[8];
        const int j = lane;
#pragma unroll
        for (int qq = 0; qq < 8; ++qq) {
            const int rr = 8 * w + qq, qp = q0 + rr, cur = qp >> 6;
            const bool valid = j <= cur;
            float v = 0.f;
            if (valid) {
                const float* ip = IMPW + ((rr >> 5) * 4 * 32 + (rr & 31)) * 64 + j;
                const float* fp = FT + ((rr >> 5) * 4 * 32 + (rr & 31)) * 4 + (j >> 4);
                v = ((ip[0] * fp[0] + ip[2048] * fp[128]) + ip[4096] * fp[256]) + ip[6144] * fp[384];
            }
            const bool forced = (j == 0) || (j == cur) || (j == cur - 1);
            const float key = forced ? __builtin_inff() : (valid ? v : NEG_INF);
            const unsigned kb_ = __float_as_uint(key);
            uk8[qq] = (kb_ & 0x80000000u) ? ~kb_ : (kb_ | 0x80000000u);
            val8[qq] = valid;
        }
        unsigned thr8[8];
#pragma unroll
        for (int qq = 0; qq < 8; ++qq) thr8[qq] = 0u;
#pragma unroll
        for (int bit = 31; bit >= 0; --bit) {
#pragma unroll
            for (int qq = 0; qq < 8; ++qq) {
                const unsigned cand = thr8[qq] | (1u << bit);
                if (__popcll(__ballot(uk8[qq] >= cand)) >= 16) thr8[qq] = cand;
            }
        }
        u64 un = 0;
#pragma unroll
        for (int qq = 0; qq < 8; ++qq) {
            const unsigned uk = uk8[qq], thr = thr8[qq];
            const u64 gtm = __ballot(uk > thr), eqm = __ballot(uk == thr);
            const int need = 16 - (int)__popcll(gtm);
            const int below = (int)__builtin_amdgcn_mbcnt_hi((unsigned)(eqm >> 32), __builtin_amdgcn_mbcnt_lo((unsigned)eqm, 0u));
            const bool sel = ((uk > thr) || (uk == thr && below < need)) && val8[qq];
            const u64 mask = __ballot(sel);
            if (lane == 0) SEL[8 * w + qq] = mask;
            un |= mask;
        }
        if (lane == 0) UN[w] = un;
        __syncthreads();
    }
    const u64 mysel = SEL[32 * hq + r];
    const u64 U = ((UN[0] | UN[1]) | (UN[2] | UN[3])) | ((UN[4] | UN[5]) | (UN[6] | UN[7]));
    unsigned char* ql = lds + NSA_IMPW + (w * 32 + r) * 144 + h * 16;
#pragma unroll
    for (int s = 0; s < 4; ++s) *(bf16x8*)(ql + s * 32) = qf[s];
    {
        const bf16_t* Ks = (const bf16_t*)(p.ws + OFF_KS) + (size_t)bg * 4096 * 64;
        const bf16_t* VsT = (const bf16_t*)(p.ws + OFF_VST) + (size_t)bg * 64 * 4096;
        const int nts = __popcll(U), j0 = __ffsll((long long)U) - 1;
        f32x16 o[2];
#pragma unroll
        for (int dt = 0; dt < 2; ++dt)
#pragma unroll
            for (int i = 0; i < 16; ++i) o[dt][i] = 0.f;
        float m = -1e30f; f32x16 lv;
#pragma unroll
        for (int i = 0; i < 16; ++i) lv[i] = 0.f;
        kv_loop<64, true>(lds, Ks, VsT, 4096, nts, j0, [U](int j) { return __ffsll((long long)(U & (~0ull << (j + 1)))) - 1; }, [&](int j, const unsigned char* sb) {
            const bool mine = (mysel >> j) & 1ull;
            if (__ballot(mine) != 0ull) {
                bf16x8 q2[4];
#pragma unroll
                for (int s = 0; s < 4; ++s) q2[s] = *(const bf16x8*)(ql + s * 32);
                f32x16 s0, s1; attn_scores(sb, q2, r, h, s0, s1);
                if (j == (qb >> 6)) {
                    const int lim = mine ? (qpos - 64 * j) : -1;
#pragma unroll
                    for (int i = 0; i < 16; ++i) {
                        const int kl = crow(i, h);
                        if (kl > lim) s0[i] = NEG_INF;
                        if (kl + 32 > lim) s1[i] = NEG_INF;
                    }
                    attn_softmax_pv<64>(s0, s1, m, lv, o, sb + KT_BYTES, r, h);
                } else {
                    attn_softmax_pv<64>(s0, s1, m, lv, o, sb + KT_BYTES, r, h, mine);
                }
            }
        }, probe);
        const float l = xhalf_sum(hsum16(lv));
        const float sc = l > 0.f ? gp[1] / l : 0.f;
#pragma unroll
        for (int dt = 0; dt < 2; ++dt)
#pragma unroll
            for (int i = 0; i < 16; ++i) oacc[dt][i] += sc * o[dt][i];
    }
    {
        const bf16_t* Kw = (const bf16_t*)(p.ws + OFF_KW) + (size_t)bg * 4096 * 64;
        const bf16_t* VwT = (const bf16_t*)(p.ws + OFF_VWT) + (size_t)bg * 64 * 4096;
        const int tlo = (q0 > 511 ? q0 - 511 : 0) >> 6, thi = (q0 + 63) >> 6;
        f32x16 o[2];
#pragma unroll
        for (int dt = 0; dt < 2; ++dt)
#pragma unroll
            for (int i = 0; i < 16; ++i) o[dt][i] = 0.f;
        float m = -1e30f; f32x16 lv;
#pragma unroll
        for (int i = 0; i < 16; ++i) lv[i] = 0.f;
        kv_loop<64, true>(lds, Kw, VwT, 4096, thi - tlo + 1, tlo, inc, [&](int j, const unsigned char* sb) {
            const int k0 = j * 64;
            if (k0 > qb + 31 || k0 + 63 <= qb - 512) return;
            bf16x8 q2[4];
#pragma unroll
            for (int s = 0; s < 4; ++s) q2[s] = *(const bf16x8*)(ql + s * 32);
            f32x16 s0, s1; attn_scores(sb, q2, r, h, s0, s1);
            if (!(k0 + 63 <= qb && k0 > qb + 31 - 512)) {
#pragma unroll
                for (int i = 0; i < 16; ++i) {
                    const int ka = k0 + crow(i, h), kb2 = ka + 32;
                    if (!(ka <= qpos && ka > qpos - 512)) s0[i] = NEG_INF;
                    if (!(kb2 <= qpos && kb2 > qpos - 512)) s1[i] = NEG_INF;
                }
            }
            attn_softmax_pv<64>(s0, s1, m, lv, o, sb + KT_BYTES, r, h);
        }, probe);
        const float l = xhalf_sum(hsum16(lv));
        const float sc = l > 0.f ? gp[2] / l : 0.f;
#pragma unroll
        for (int dt = 0; dt < 2; ++dt)
#pragma unroll
            for (int i = 0; i < 16; ++i) oacc[dt][i] += sc * o[dt][i];
    }
    if (probe) {
        float chk = 0.f;
#pragma unroll
        for (int dt = 0; dt < 2; ++dt)
#pragma unroll
            for (int i = 0; i < 16; ++i) chk += oacc[dt][i];
        if (chk == 1.2345e-30f) ((float*)(p.ws + OFF_CTL))[33] = chk;
        return;
    }
    bf16_t* O = (bf16_t*)(p.ws + OFF_O) + ((size_t)b * 4096 + qpos) * 1024 + 512 + head * 64;
#pragma unroll
    for (int dt = 0; dt < 2; ++dt)
#pragma unroll
        for (int g4 = 0; g4 < 4; ++g4) {
            u32x2 ov; ov.x = pk_bf16(oacc[dt][4 * g4], oacc[dt][4 * g4 + 1]); ov.y = pk_bf16(oacc[dt][4 * g4 + 2], oacc[dt][4 * g4 + 3]);
            *(u32x2*)(O + dt * 32 + 8 * g4 + 4 * h) = ov;
        }
}
DI void phase4(const Params& p, unsigned char* lds, int rep = 0, int probe = 0, int which = 3) {
    unsigned* counter = (unsigned*)(p.ws + OFF_CTL) + 2 * rep;
    volatile int* su = (volatile int*)(lds + LDS_UNIT);
    if (which & 1) for (;;) {
        if (threadIdx.x == 0) *su = (int)atomicAdd(counter, 1u);
        __syncthreads();
        const int u = *su;
        __syncthreads();
        if (u >= 512) break;
        diff_unit(p, u, lds, probe);
    }
    if (which & 2) for (;;) {
        if (threadIdx.x == 0) *su = (int)atomicAdd(counter + 1, 1u);
        __syncthreads();
        const int u = *su;
        __syncthreads();
        if (u >= 1024) break;
        nsa_unit(p, u, lds, probe);
    }
}
DI void phase5(const Params& p, unsigned char* lds) {
    pg8::Gemm g; g.A = (const bf16_t*)(p.ws + OFF_O); g.Bt = (const bf16_t*)(p.ws + OFF_WOUTT); g.M = T; g.N = 1024; g.K = 1024;
    pg8::StaticOrder S; S.init(T, 1024, (int)gridDim.x, (int)blockIdx.x);
    pg8::EpiPlain E; E.O = (bf16_t*)(p.ws + OFF_MIX); E.ldc = 1024;
    pg8::gemm_phase<pg8::EpiPlain, pg8::StaticOrder, true, true>((PG8_LAS unsigned char*)lds, g, S, E);
    __syncthreads();
}
DI void phase6(const Params& p) {
    const int lane = VTID & 63, w = VTID >> 6;
    const float* x = p.in[0]; const float* gpost = p.in[15]; const float* gffn = p.in[16];
    const bf16_t* MIX = (const bf16_t*)(p.ws + OFF_MIX);
    bf16_t* H = (bf16_t*)(p.ws + OFF_H);
    float* RSTD = (float*)(p.ws + OFF_GATES);
    for (int row = VBLK * 4 + w; row < T; row += VGRID * 4) {
        f32x4 mv[4], xv[4]; float ss = 0.f;
#pragma unroll
        for (int i = 0; i < 4; ++i) {
            const u32x2 u = *(const u32x2*)(MIX + (size_t)row * 1024 + i * 256 + lane * 4);
            mv[i][0] = bflo(u.x); mv[i][1] = bfhi(u.x); mv[i][2] = bflo(u.y); mv[i][3] = bfhi(u.y);
            xv[i] = *(const f32x4*)(x + (size_t)row * 1024 + i * 256 + lane * 4);
            ss += mv[i][0] * mv[i][0] + mv[i][1] * mv[i][1] + mv[i][2] * mv[i][2] + mv[i][3] * mv[i][3];
        }
        ss = wave_sum(ss);
        const float rstd = rsqrtf(ss * (1.f / 1024.f) + NORM_EPS);
        if (lane == 0) RSTD[row] = rstd;
        float ss2 = 0.f;
#pragma unroll
        for (int i = 0; i < 4; ++i) {
            const f32x4 gg = *(const f32x4*)(gpost + i * 256 + lane * 4);
#pragma unroll
            for (int e = 0; e < 4; ++e) { xv[i][e] += mv[i][e] * rstd * gg[e]; ss2 += xv[i][e] * xv[i][e]; }
        }
        ss2 = wave_sum(ss2);
        const float rstd2 = rsqrtf(ss2 * (1.f / 1024.f) + NORM_EPS);
#pragma unroll
        for (int i = 0; i < 4; ++i) {
            const f32x4 gg = *(const f32x4*)(gffn + i * 256 + lane * 4);
            u32x2 o; o.x = pk_bf16(xv[i][0] * rstd2 * gg[0], xv[i][1] * rstd2 * gg[1]); o.y = pk_bf16(xv[i][2] * rstd2 * gg[2], xv[i][3] * rstd2 * gg[3]);
            *(u32x2*)(H + (size_t)row * 1024 + i * 256 + lane * 4) = o;
        }
    }
}
DI void phase7(const Params& p, unsigned char* lds, int probe = 0) {
    pg8::Gemm g; g.A = (const bf16_t*)(p.ws + OFF_H); g.Bt = (const bf16_t*)(p.ws + OFF_WGUT); g.M = T; g.N = 2 * DFF; g.K = 1024;
    pg8::StaticOrder S; S.init(T, 2 * DFF, (int)gridDim.x, (int)blockIdx.x);
    pg8::EpiSwiGLU E; E.ACT = (bf16_t*)(p.ws + OFF_ACT); E.ldc = DFF;
    pg8::gemm_phase<pg8::EpiSwiGLU, pg8::StaticOrder, true, true>((PG8_LAS unsigned char*)lds, g, S, E);
    __syncthreads();
}
DI void phase8(const Params& p, unsigned char* lds) {
    pg8::Gemm g; g.A = (const bf16_t*)(p.ws + OFF_ACT); g.Bt = (const bf16_t*)(p.ws + OFF_WDT); g.M = T; g.N = 1024; g.K = DFF;
    pg8::StaticOrder S; S.init(T, 1024, (int)gridDim.x, (int)blockIdx.x);
    pg8::EpiPlain E; E.O = (bf16_t*)(p.ws + OFF_O); E.ldc = 1024;
    pg8::gemm_phase<pg8::EpiPlain, pg8::StaticOrder, true, true>((PG8_LAS unsigned char*)lds, g, S, E);
    __syncthreads();
}
DI void phase9(const Params& p) {
    const int lane = VTID & 63, w = VTID >> 6;
    const float* x = p.in[0]; const float* g1 = p.in[15]; const float* g2 = p.in[20];
    const bf16_t* MIX = (const bf16_t*)(p.ws + OFF_MIX);
    const bf16_t* F = (const bf16_t*)(p.ws + OFF_O);
    const float* RSTD = (const float*)(p.ws + OFF_GATES);
    for (int row = VBLK * 4 + w; row < T; row += VGRID * 4) {
        f32x4 fv[4], mv[4]; float ss = 0.f;
#pragma unroll
        for (int i = 0; i < 4; ++i) {
            const u32x2 u = *(const u32x2*)(F + (size_t)row * 1024 + i * 256 + lane * 4);
            fv[i][0] = bflo(u.x); fv[i][1] = bfhi(u.x); fv[i][2] = bflo(u.y); fv[i][3] = bfhi(u.y);
            const u32x2 um = *(const u32x2*)(MIX + (size_t)row * 1024 + i * 256 + lane * 4);
            mv[i][0] = bflo(um.x); mv[i][1] = bfhi(um.x); mv[i][2] = bflo(um.y); mv[i][3] = bfhi(um.y);
            ss += fv[i][0] * fv[i][0] + fv[i][1] * fv[i][1] + fv[i][2] * fv[i][2] + fv[i][3] * fv[i][3];
        }
        ss = wave_sum(ss);
        const float rstd = rsqrtf(ss * (1.f / 1024.f) + NORM_EPS);
        const float rstd1 = RSTD[row];
#pragma unroll
        for (int i = 0; i < 4; ++i) {
            const f32x4 ga = *(const f32x4*)(g1 + i * 256 + lane * 4);
            const f32x4 gb = *(const f32x4*)(g2 + i * 256 + lane * 4);
            f32x4 xv = *(const f32x4*)(x + (size_t)row * 1024 + i * 256 + lane * 4);
#pragma unroll
            for (int e = 0; e < 4; ++e) { xv[e] += mv[i][e] * rstd1 * ga[e]; xv[e] += fv[i][e] * rstd * gb[e]; }
            *(f32x4*)(p.out + (size_t)row * 1024 + i * 256 + lane * 4) = xv;
        }
    }
}

__global__ void __launch_bounds__(512, 2) mega(Params p) {
    extern __shared__ __attribute__((aligned(16))) unsigned char lds[];
    cg::grid_group grid = cg::this_grid();
    const bool fused = (p.ph_hi - p.ph_lo) > 1;
    XcdBarrier xb; xb.bar = (unsigned*)(p.ws + OFF_XB); xb.x = 0; xb.st = (volatile LAS unsigned*)(lds + LDS_XB);
    if (fused) {
        if (threadIdx.x == 0) { xb.st[0] = 0u; xb.st[1] = 0u; }
        __syncthreads();
        xb = xcd_barrier_post((unsigned*)(p.ws + OFF_XB), (volatile LAS unsigned*)(lds + LDS_XB));
    }
    if (p.ph_hi > 1000) grid.sync();
#ifndef ONLY_PH
#define ONLY_PH -1
#endif
#define PH_ON(n) (ONLY_PH < 0 || ONLY_PH == (n))
#define RUN_PHASE(n, call) if (p.ph_lo <= (n) && (n) < p.ph_hi) { if (PH_ON(n)) { call; } if ((n) + 1 < p.ph_hi) { xcd_barrier(xb); if (PROBE_MODE == 1) xcd_barrier(xb); } }
    RUN_PHASE(0, phase0(p, lds))
    RUN_PHASE(1, phase1(p, lds))
    RUN_PHASE(2, phase2(p, lds))
    RUN_PHASE(3, phase3(p, lds))
    RUN_PHASE(4, phase4(p, lds))
#if PROBE_MODE == 2
    RUN_PHASE(4, phase4(p, lds, 1))
#endif
#if PROBE_MODE == 8
    RUN_PHASE(4, phase4(p, lds, 1, 0, 1))
#endif
#if PROBE_MODE == 9
    RUN_PHASE(4, phase4(p, lds, 1, 0, 2))
#endif
#if PROBE_MODE == 6
    RUN_PHASE(4, phase4(p, lds, 1, 1))
#endif
#if PROBE_MODE == 7
    RUN_PHASE(4, phase4(p, lds, 1, 2))
#endif
    RUN_PHASE(5, phase5(p, lds))
    RUN_PHASE(6, phase6(p))
    RUN_PHASE(7, phase7(p, lds))
#if PROBE_MODE == 3
    RUN_PHASE(7, phase7(p, lds))
#endif
#if PROBE_MODE == 4
    RUN_PHASE(7, phase7(p, lds, 1))
#endif
#if PROBE_MODE == 5
    RUN_PHASE(7, phase7(p, lds, 2))
#endif
    RUN_PHASE(8, phase8(p, lds))
    RUN_PHASE(9, phase9(p))
}

extern "C" void kernel_launch(void* const* d_in, const int* in_sizes, int n_in, void* d_out, int out_size, void* d_ws, size_t ws_size, hipStream_t stream) {
    static int grid_blocks = 0;
    if (grid_blocks == 0) {
        if (n_in != 21 || ws_size < WS_END) { fprintf(stderr, "kernel_launch: unexpected n_in %d / ws %zu (need %zu)\n", n_in, ws_size, (size_t)WS_END); grid_blocks = -1; return; }
        int dev = 0, cus = 0, per_cu = 0;
        hipGetDevice(&dev);
        hipDeviceGetAttribute(&cus, hipDeviceAttributeMultiprocessorCount, dev);
        if (hipFuncSetAttribute((const void*)mega, hipFuncAttributeMaxDynamicSharedMemorySize, LDS_BYTES) != hipSuccess) { fprintf(stderr, "kernel_launch: hipFuncSetAttribute failed\n"); grid_blocks = -1; return; }
        hipOccupancyMaxActiveBlocksPerMultiprocessor(&per_cu, (const void*)mega, 512, LDS_BYTES);
        if (per_cu < 1) per_cu = 1;
        if (per_cu > 1) per_cu = 1;
        grid_blocks = cus * per_cu;
        if (grid_blocks > 256) grid_blocks = 256;
    }
    if (grid_blocks < 0) return;
    Params p{};
    for (int i = 0; i < 21; ++i) p.in[i] = (const float*)d_in[i];
    p.out = (float*)d_out; p.ws = (unsigned char*)d_ws;
#if MULTI_LAUNCH
    for (int ph = 0; ph < NPH; ++ph) {
        p.ph_lo = ph; p.ph_hi = ph + 1;
        hipLaunchKernelGGL(mega, dim3(grid_blocks), dim3(512), LDS_BYTES, stream, p);
    }
#else
    p.ph_lo = 0; p.ph_hi = NPH;
    if (hipMemsetAsync((unsigned char*)d_ws + OFF_XB, 0, XCD_BAR_WORDS * 4, stream) != hipSuccess) { fprintf(stderr, "kernel_launch: memset of barrier words failed\n"); return; }
    void* args[] = {&p};
    hipError_t e = hipLaunchCooperativeKernel((const void*)mega, dim3(grid_blocks), dim3(512), args, LDS_BYTES, stream);
    if (e != hipSuccess) fprintf(stderr, "cooperative launch failed: %s (grid %d)\n", hipGetErrorString(e), grid_blocks);
#endif
}
```

```cpp
#include <hip/hip_runtime.h>
#include <hip/hip_cooperative_groups.h>
#include <cstdio>
#include <cstdint>
namespace cg = cooperative_groups;

#ifndef MULTI_LAUNCH
#define MULTI_LAUNCH 0
#endif
#ifndef PROBE_MODE
#define PROBE_MODE 0
#endif

typedef unsigned short bf16_t;
typedef short bf16x8 __attribute__((ext_vector_type(8)));
typedef short s16x4 __attribute__((ext_vector_type(4)));
typedef float f32x16 __attribute__((ext_vector_type(16)));
typedef float f32x4 __attribute__((ext_vector_type(4)));
typedef float f32x2 __attribute__((ext_vector_type(2)));
typedef unsigned u32x4 __attribute__((ext_vector_type(4)));
typedef unsigned u32x2 __attribute__((ext_vector_type(2)));
typedef __bf16 bf16v2 __attribute__((ext_vector_type(2)));
typedef unsigned long long u64;

#define DI __device__ __forceinline__
#define MFMA(a, b, c) __builtin_amdgcn_mfma_f32_32x32x16_bf16((a), (b), (c), 0, 0, 0)

constexpr int T = 32768, S = 4096, DM = 1024;
constexpr int INC = 2840, INP = 3072, DFF = 2816;
constexpr int NPH = 10;
constexpr int HALF_LDS = 73728;
constexpr int LDS_BYTES = 2 * HALF_LDS + 256;
#define VTID ((int)(threadIdx.x & 255))
#define VHALF ((int)(threadIdx.x >> 8))
#define VBLK ((int)(blockIdx.x * 2 + (threadIdx.x >> 8)))
#define VGRID ((int)(gridDim.x * 2))
constexpr float NORM_EPS = 1e-6f;

constexpr size_t al256(size_t x) { return (x + 255) & ~(size_t)255; }
constexpr size_t OFF_CTL = 0;
constexpr size_t OFF_XB = 4096;
constexpr size_t OFF_WINT = 4096 + 16384;
constexpr size_t OFF_WOUTT = OFF_WINT + (size_t)INP * 1024 * 2;
constexpr size_t OFF_WGUT = OFF_WOUTT + (size_t)1024 * 1024 * 2;
constexpr size_t OFF_WDT = OFF_WGUT + (size_t)2 * DFF * 1024 * 2;
constexpr size_t OFF_W1T = OFF_WDT + (size_t)1024 * DFF * 2;
constexpr size_t OFF_W2T = OFF_W1T + (size_t)2 * 256 * 2048 * 2;
constexpr size_t OFF_B1 = OFF_W2T + (size_t)2 * 128 * 256 * 2;
constexpr size_t OFF_ROPE = OFF_B1 + 2 * 256 * 4;
constexpr size_t OFF_H = al256(OFF_ROPE + (size_t)4096 * 32 * 8);
constexpr size_t OFF_O = OFF_H + (size_t)T * 1024 * 2;
constexpr size_t OFF_MIX = OFF_O + (size_t)T * 1024 * 2;
constexpr size_t OFF_QKV = OFF_MIX + (size_t)T * 1024 * 2;
constexpr size_t SZ_H8 = (size_t)8 * 8 * 4096 * 64 * 2;
constexpr size_t SZ_G2 = (size_t)8 * 2 * 4096 * 64 * 2;
constexpr size_t OFF_QD = OFF_QKV;
constexpr size_t OFF_KD = OFF_QD + SZ_H8;
constexpr size_t OFF_VDT = OFF_KD + SZ_H8;
constexpr size_t OFF_QN = OFF_VDT + SZ_H8;
constexpr size_t OFF_KCT = OFF_QN + SZ_H8;
constexpr size_t OFF_VCT = OFF_KCT + SZ_G2;
constexpr size_t OFF_KS = OFF_VCT + SZ_G2;
constexpr size_t OFF_VST = OFF_KS + SZ_G2;
constexpr size_t OFF_KW = OFF_VST + SZ_G2;
constexpr size_t OFF_VWT = OFF_KW + SZ_G2;
constexpr size_t OFF_GATES = OFF_VWT + SZ_G2;
constexpr size_t OFF_HID = OFF_GATES + (size_t)T * 24 * 4;
constexpr size_t OFF_KCMP = OFF_HID + (size_t)2 * 16 * 256 * 256 * 2;
constexpr size_t OFF_VCMPT = OFF_KCMP + (size_t)16 * 256 * 64 * 2;
constexpr size_t OFF_QKV_END = OFF_VCMPT + (size_t)16 * 256 * 64 * 2;
constexpr size_t OFF_ACT = OFF_QKV;
constexpr size_t OFF_ACT_END = OFF_ACT + (size_t)T * DFF * 2;
constexpr size_t WS_END = OFF_ACT_END > OFF_QKV_END ? OFF_ACT_END : OFF_QKV_END;

struct Params {
    const float* in[21];
    float* out;
    unsigned char* ws;
    int ph_lo, ph_hi;
};

DI unsigned pk_bf16(float a, float b) { f32x2 v = {a, b}; return __builtin_bit_cast(unsigned, __builtin_convertvector(v, bf16v2)); }
DI bf16_t f2bf(float a) { return (bf16_t)(pk_bf16(a, 0.f) & 0xffffu); }
DI float bflo(unsigned u) { return __uint_as_float(u << 16); }
DI float bfhi(unsigned u) { return __uint_as_float(u & 0xffff0000u); }
DI u32x4 pk8(const float (&v)[8]);
DI int crow(int i, int h) { return (i & 3) + 8 * (i >> 2) + 4 * h; }
DI float wave_sum(float v) {
    v += __shfl_xor(v, 32); v += __shfl_xor(v, 16); v += __shfl_xor(v, 8);
    v += __shfl_xor(v, 4); v += __shfl_xor(v, 2); v += __shfl_xor(v, 1);
    return v;
}
DI float fast_exp2(float x) { return __builtin_amdgcn_exp2f(x); }
DI float xhalf_max(float x) { auto rr = __builtin_amdgcn_permlane32_swap(__float_as_uint(x), __float_as_uint(x), false, false); return fmaxf(__uint_as_float(rr[0]), __uint_as_float(rr[1])); }
DI float xhalf_sum(float x) { auto rr = __builtin_amdgcn_permlane32_swap(__float_as_uint(x), __float_as_uint(x), false, false); return __uint_as_float(rr[0]) + __uint_as_float(rr[1]); }
DI float sigmoidf(float x) { return 1.f / (1.f + __expf(-x)); }


#define XB_TMO      128
#define XB_XCNT(j)  (256  + 64 * (j))
#define XB_XSUB(j)  (1280 + 64 * (j))
#define XB_XGEN(j)  (2304 + 64 * (j))
#define XB_TOP      3328
#define XB_TOPGEN   3392
#define XCD_BAR_WORDS 3456
#define XB_SPIN_CAP (1u << 18)
#define LAS __attribute__((address_space(3)))
DI unsigned xb_ld(unsigned* p) { return __hip_atomic_load(p, __ATOMIC_RELAXED, __HIP_MEMORY_SCOPE_AGENT); }
DI unsigned xb_add(unsigned* p, unsigned v) { return __hip_atomic_fetch_add(p, v, __ATOMIC_RELAXED, __HIP_MEMORY_SCOPE_AGENT); }
DI unsigned xb_xcc_id() { return (unsigned)__builtin_amdgcn_s_getreg((3 << 11) | 20) & 0xFu; }
#define XB_SPIN(cond, bar) do { unsigned _sp = 0; while (cond) { __builtin_amdgcn_s_sleep(1); \
    if ((++_sp & 255u) == 0u) { if (xb_ld(&(bar)[XB_TMO])) break; if (_sp > XB_SPIN_CAP) { atomicAdd(&(bar)[XB_TMO], 1u); break; } } } } while (0)
struct XcdBarrier { unsigned* bar; unsigned x; volatile LAS unsigned* st; };
DI XcdBarrier xcd_barrier_post(unsigned* bar, volatile LAS unsigned* st) {
    XcdBarrier b; b.bar = bar; b.x = xb_xcc_id(); b.st = st;
    if (threadIdx.x == 0) (void)xb_add(&bar[XB_XCNT(b.x)], 1u);
    return b;
}
DI void xcd_barrier_complete(unsigned* bar, unsigned x, unsigned& nloc, unsigned& nx) {
    const unsigned G = gridDim.x * gridDim.y * gridDim.z;
    unsigned sum, cnt, mine, sp = 0u;
    for (;;) {
        sum = 0u; cnt = 0u; mine = 0u;
#pragma unroll
        for (unsigned j = 0; j < 16; ++j) { const unsigned c = xb_ld(&bar[XB_XCNT(j)]); sum += c; cnt += (c > 0u) ? 1u : 0u; mine = (j == x) ? c : mine; }
        if (sum == G) break;
        __builtin_amdgcn_s_sleep(1);
        if ((++sp & 255u) == 0u) { if (xb_ld(&bar[XB_TMO])) break; if (sp > XB_SPIN_CAP) { atomicAdd(&bar[XB_TMO], 1u); break; } }
    }
    nloc = mine > 0u ? mine : 1u; nx = cnt > 0u ? cnt : 1u;
}
DI void xcd_barrier(const XcdBarrier& b) {
    asm volatile("s_waitcnt vmcnt(0)" ::: "memory");
    __syncthreads();
    if (threadIdx.x == 0) {
        unsigned* bar = b.bar;
        __builtin_amdgcn_s_waitcnt(0);
        unsigned nloc = b.st[0], nx = b.st[1];
        if (nloc == 0u) { xcd_barrier_complete(bar, b.x, nloc, nx); b.st[0] = nloc; b.st[1] = nx; }
        const unsigned old = xb_add(&bar[XB_XSUB(b.x)], 1u);
        const unsigned gen = old / nloc;
        if (old + 1u == (gen + 1u) * nloc) {
            __builtin_amdgcn_fence(__ATOMIC_RELEASE, "agent");
            asm volatile("s_waitcnt vmcnt(0)" ::: "memory");
            const unsigned og = xb_add(&bar[XB_TOP], 1u);
            const unsigned tg = og / nx;
            if (og + 1u == (tg + 1u) * nx) xb_add(&bar[XB_TOPGEN], 1u);
            else XB_SPIN(xb_ld(&bar[XB_TOPGEN]) == tg, bar);
            __builtin_amdgcn_fence(__ATOMIC_ACQUIRE, "agent");
            xb_add(&bar[XB_XGEN(b.x)], 1u);
            asm volatile("s_waitcnt vmcnt(0)" ::: "memory");
        } else {
            XB_SPIN(xb_ld(&bar[XB_XGEN(b.x)]) == gen, bar);
            __builtin_amdgcn_fence(__ATOMIC_ACQUIRE, "agent");
            asm volatile("s_waitcnt vmcnt(0)" ::: "memory");
        }
    }
    __syncthreads();
}
constexpr int LDS_XB = 2 * 73728;

DI int wdst_row(int n, int mode) {
    int dr = n;
    if (mode == 1 || mode == 2) dr = (n >> 2) * 8 + (n & 3) + (mode == 2 ? 4 : 0);
    else if (mode == 3) {
        const bool rope = (n < 1024) || (n >= 1536 && n < 2176) || (n >= 2304 && n < 2432) || (n >= 2560 && n < 2688);
        if (rope) { const int d = n & 63; dr = (n & ~63) + 8 * ((d & 31) >> 2) + (d & 3) + 4 * (d >> 5); }
    }
    return dr;
}
DI void transpose_tile(const float* __restrict__ src, int K, int N, bf16_t* __restrict__ dst, int ldd, int mode, int tile, float* tl, bool valid) {
    const int nbN = (N + 63) >> 6;
    const int kb = tile / nbN, nb = tile - kb * nbN;
    const int t = VTID;
    if (valid) {
#pragma unroll
        for (int i = 0; i < 4; ++i) {
            const int row = (t >> 4) + 16 * i, c4 = (t & 15) * 4, n = nb * 64 + c4;
            f32x4 v = {0.f, 0.f, 0.f, 0.f};
            if (n < N) v = *(const f32x4*)(src + (size_t)(kb * 64 + row) * N + n);
            float* q = tl + row * 65 + c4;
            q[0] = v[0]; q[1] = v[1]; q[2] = v[2]; q[3] = v[3];
        }
    }
    __syncthreads();
    if (valid) {
        const int nl = t >> 2, kc = (t & 3) * 16, n = nb * 64 + nl;
        if (n < N) {
            float a[8], b[8];
#pragma unroll
            for (int k = 0; k < 8; ++k) { a[k] = tl[(kc + k) * 65 + nl]; b[k] = tl[(kc + 8 + k) * 65 + nl]; }
            bf16_t* d = dst + (size_t)wdst_row(n, mode) * ldd + kb * 64 + kc;
            *(u32x4*)d = pk8(a); *(u32x4*)(d + 8) = pk8(b);
        }
    }
    __syncthreads();
}

DI void phase0(const Params& p, unsigned char* lds) {
    const int tid = VTID, lane = tid & 63, w = tid >> 6;
    const int G = VGRID;
    unsigned char* ws = p.ws;
    float* tl = (float*)(lds + VHALF * HALF_LDS);
    if (VBLK == 0) {
        if (tid < 64) {
            float a = p.in[3][lane] * p.in[4][lane];
            float b = p.in[5][lane] * p.in[6][lane];
            a = wave_sum(a); b = wave_sum(b);
            if (lane == 0) {
                ((float*)(ws + OFF_CTL))[16] = expf(a) - expf(b) + 0.2f;
                ((unsigned*)(ws + OFF_CTL))[0] = 0u; ((unsigned*)(ws + OFF_CTL))[1] = 0u; ((unsigned*)(ws + OFF_CTL))[2] = 0u; ((unsigned*)(ws + OFF_CTL))[3] = 0u;
            }
        }
    }
    {
        const int c0 = 720, c1 = c0 + 256, c2 = c1 + 704, c3 = c2 + 704, c4 = c3 + 704, c5 = c4 + 128, c6 = c5 + 128, c7 = c6 + 4, c8 = c7 + 4;
        for (int tb = 0; tb < c8; tb += G) {
            const bool valid = tb + VBLK < c8; const int t = valid ? tb + VBLK : c8 - 1;
            if (t < c0) transpose_tile(p.in[2], 1024, INC, (bf16_t*)(ws + OFF_WINT), 1024, 3, t, tl, valid);
            else if (t < c1) transpose_tile(p.in[14], 1024, 1024, (bf16_t*)(ws + OFF_WOUTT), 1024, 0, t - c0, tl, valid);
            else if (t < c2) transpose_tile(p.in[17], 1024, DFF, (bf16_t*)(ws + OFF_WGUT), 1024, 1, t - c1, tl, valid);
            else if (t < c3) transpose_tile(p.in[18], 1024, DFF, (bf16_t*)(ws + OFF_WGUT), 1024, 2, t - c2, tl, valid);
            else if (t < c4) transpose_tile(p.in[19], DFF, 1024, (bf16_t*)(ws + OFF_WDT), DFF, 0, t - c3, tl, valid);
            else if (t < c5) transpose_tile(p.in[9], 2048, 256, (bf16_t*)(ws + OFF_W1T), 2048, 0, t - c4, tl, valid);
            else if (t < c6) transpose_tile(p.in[12], 2048, 256, (bf16_t*)(ws + OFF_W1T) + 256 * 2048, 2048, 0, t - c5, tl, valid);
            else if (t < c7) transpose_tile(p.in[10], 256, 64, (bf16_t*)(ws + OFF_W2T), 256, 0, t - c6, tl, valid);
            else transpose_tile(p.in[13], 256, 64, (bf16_t*)(ws + OFF_W2T) + 128 * 256, 256, 0, t - c7, tl, valid);
        }
    }
    for (int t = VBLK; t < 8; t += G) {
        const int kv = t >> 2, cgp = t & 3;
        const float* pos = p.in[kv ? 11 : 8];
        const float* w1 = p.in[kv ? 12 : 9];
        const int c = cgp * 64 + (tid & 63), part = tid >> 6;
        float acc = 0.f;
        for (int k = part * 512; k < part * 512 + 512; ++k) acc += pos[k] * w1[(size_t)k * 256 + c];
        __syncthreads();
        tl[part * 64 + (tid & 63)] = acc;
        __syncthreads();
        if (tid < 64) ((float*)(ws + OFF_B1))[kv * 256 + c] = (tl[tid] + tl[64 + tid]) + (tl[128 + tid] + tl[192 + tid]);
        __syncthreads();
    }
    {
        f32x2* tab = (f32x2*)(ws + OFF_ROPE);
        for (int i = VBLK * 256 + tid; i < 4096 * 32; i += G * 256) {
            const int pos = i >> 5, j = i & 31;
            const float inv = 1.0f / powf(10000.f, (float)(2 * j) / 64.f);
            const float ang = (float)pos * inv;
            f32x2 cs; cs.x = cosf(ang); cs.y = sinf(ang);
            tab[i] = cs;
        }
    }
    {
        const float* x = p.in[0]; const float* g = p.in[1];
        bf16_t* H = (bf16_t*)(ws + OFF_H);
        for (int row = VBLK * 4 + w; row < T; row += G * 4) {
            const float* xr = x + (size_t)row * 1024;
            f32x4 v[4]; float ss = 0.f;
#pragma unroll
            for (int i = 0; i < 4; ++i) { v[i] = *(const f32x4*)(xr + i * 256 + lane * 4); ss += v[i][0] * v[i][0] + v[i][1] * v[i][1] + v[i][2] * v[i][2] + v[i][3] * v[i][3]; }
            ss = wave_sum(ss);
            const float rstd = rsqrtf(ss * (1.f / 1024.f) + NORM_EPS);
#pragma unroll
            for (int i = 0; i < 4; ++i) {
                const f32x4 gg = *(const f32x4*)(g + i * 256 + lane * 4);
                u32x2 o; o.x = pk_bf16(v[i][0] * rstd * gg[0], v[i][1] * rstd * gg[1]); o.y = pk_bf16(v[i][2] * rstd * gg[2], v[i][3] * rstd * gg[3]);
                *(u32x2*)(H + (size_t)row * 1024 + i * 256 + lane * 4) = o;
            }
        }
    }
}

constexpr int GP = 144;
constexpr int GT = 128 * GP;
constexpr int DT = 16384;
constexpr int DSTAGE = 2 * DT;
#define LAS3 __attribute__((address_space(3)))
template <bool SWAP>
DI void gemm_compute(const unsigned char* base, const int (&ao)[4], const int (&bo)[4], f32x16 (&acc)[2][2]) {
#pragma unroll
    for (int s = 0; s < 4; ++s) {
        const bf16x8 a0 = *(const bf16x8*)(base + ao[s]), a1 = *(const bf16x8*)(base + ao[s] + 32 * 128);
        const bf16x8 b0 = *(const bf16x8*)(base + DT + bo[s]), b1 = *(const bf16x8*)(base + DT + bo[s] + 32 * 128);
        if (SWAP) {
            acc[0][0] = MFMA(b0, a0, acc[0][0]); acc[0][1] = MFMA(b1, a0, acc[0][1]);
            acc[1][0] = MFMA(b0, a1, acc[1][0]); acc[1][1] = MFMA(b1, a1, acc[1][1]);
        } else {
            acc[0][0] = MFMA(a0, b0, acc[0][0]); acc[0][1] = MFMA(a0, b1, acc[0][1]);
            acc[1][0] = MFMA(a1, b0, acc[1][0]); acc[1][1] = MFMA(a1, b1, acc[1][1]);
        }
    }
}
DI void gemm_dma(const bf16_t* ga, const bf16_t* gb, int lda, int ldb, int k0, unsigned char* stage_w) {
#pragma unroll
    for (int i = 0; i < 4; ++i) {
        __builtin_amdgcn_global_load_lds((const unsigned*)(ga + (size_t)(32 * i) * lda + k0), (LAS3 unsigned*)(stage_w + i * 4096), 16, 0, 0);
        __builtin_amdgcn_global_load_lds((const unsigned*)(gb + (size_t)(32 * i) * ldb + k0), (LAS3 unsigned*)(stage_w + DT + i * 4096), 16, 0, 0);
    }
}
template <bool SWAP>
DI void gemm_main(const bf16_t* __restrict__ Ag, int lda, const bf16_t* __restrict__ Bg, int ldb, int K, f32x16 (&acc)[2][2], unsigned char* lds, int probe = 0) {
    const int tid = VTID, lane = tid & 63, w = __builtin_amdgcn_readfirstlane(tid >> 6), wr = w >> 1, wc = w & 1, r = lane & 31, h = lane >> 5;
    const int row0 = 8 * w + (lane >> 3), kch = (lane & 7) ^ ((row0 >> 1) & 7);
    const bf16_t* ga = Ag + (size_t)row0 * lda + kch * 8;
    const bf16_t* gb = Bg + (size_t)row0 * ldb + kch * 8;
    unsigned char* st0 = lds + w * 1024;
    unsigned char* st1 = lds + DSTAGE + w * 1024;
    int ao[4], bo[4];
    {
        const int ra = wr * 64 + r, rb = wc * 64 + r;
        const int xa = h ^ ((ra >> 1) & 7), xb = h ^ ((rb >> 1) & 7);
#pragma unroll
        for (int s = 0; s < 4; ++s) { ao[s] = ra * 128 + ((xa ^ (2 * s)) << 4); bo[s] = rb * 128 + ((xb ^ (2 * s)) << 4); }
    }
    const int nk = K >> 6;
    if (probe != 1) gemm_dma(ga, gb, lda, ldb, 0, st0);
    __syncthreads();
    for (int kt = 0; kt < nk; kt += 2) {
        if (probe != 1) gemm_dma(ga, gb, lda, ldb, (kt + 1) * 64, st1);
        if (probe != 2) gemm_compute<SWAP>(lds, ao, bo, acc);
        __syncthreads();
        if (kt + 2 < nk && probe != 1) gemm_dma(ga, gb, lda, ldb, (kt + 2) * 64, st0);
        if (probe != 2) gemm_compute<SWAP>(lds + DSTAGE, ao, bo, acc);
        __syncthreads();
    }
}
DI void zero_acc(f32x16 (&acc)[2][2]) {
#pragma unroll
    for (int a = 0; a < 2; ++a)
#pragma unroll
        for (int b = 0; b < 2; ++b)
#pragma unroll
            for (int i = 0; i < 16; ++i) acc[a][b][i] = 0.f;
}
DI void tile_map(int t, int NT, int& mt, int& nt) {
    const int xcd = t & 7, j = t >> 3;
    const int grp = j / (8 * NT), rem = j - grp * 8 * NT;
    nt = rem >> 3; mt = xcd * 32 + grp * 8 + (rem & 7);
}
constexpr int CP = 132;
template <bool SWAP>
DI void acc_to_lds(const f32x16 (&acc)[2][2], unsigned char* lds) {
    const int lane = VTID & 63, w = VTID >> 6, wr = w >> 1, wc = w & 1, r = lane & 31, h = lane >> 5;
    float* base = (float*)lds + (SWAP ? ((wc * 64 + 4 * h) * CP + wr * 64 + r) : ((wr * 64 + 4 * h) * CP + wc * 64 + r));
#pragma unroll
    for (int mt = 0; mt < 2; ++mt)
#pragma unroll
        for (int nt = 0; nt < 2; ++nt)
#pragma unroll
            for (int i = 0; i < 16; ++i) {
                const int rr = (i & 3) + 8 * (i >> 2);
                if (SWAP) base[(nt * 32 + rr) * CP + mt * 32] = acc[mt][nt][i];
                else base[(mt * 32 + rr) * CP + nt * 32] = acc[mt][nt][i];
            }
}
DI void ld8(const float* q, float (&v)[8]) {
    const f32x4 a = *(const f32x4*)q, b = *(const f32x4*)(q + 4);
    v[0] = a[0]; v[1] = a[1]; v[2] = a[2]; v[3] = a[3]; v[4] = b[0]; v[5] = b[1]; v[6] = b[2]; v[7] = b[3];
}
DI u32x4 pk8(const float (&v)[8]) {
    u32x4 o; o.x = pk_bf16(v[0], v[1]); o.y = pk_bf16(v[2], v[3]); o.z = pk_bf16(v[4], v[5]); o.w = pk_bf16(v[6], v[7]);
    return o;
}
DI void out_plain(const unsigned char* lds, bf16_t* dst, size_t ldd, int nch_log2) {
    const float* Ct = (const float*)lds;
    const int total = 128 << nch_log2;
#pragma unroll 1
    for (int c = VTID; c < total; c += 256) {
        const int a = c >> nch_log2, ch = c & ((1 << nch_log2) - 1);
        float v[8]; ld8(Ct + a * CP + ch * 8, v);
        *(u32x4*)(dst + (size_t)a * ldd + ch * 8) = pk8(v);
    }
}

namespace pg8 {
#define PG8_LAS __attribute__((address_space(3)))
typedef unsigned short bf16_t;
typedef short bf16x8 __attribute__((ext_vector_type(8)));
typedef float f32x4 __attribute__((ext_vector_type(4)));
typedef unsigned u32x4 __attribute__((ext_vector_type(4)));
constexpr int BM = 256, BK = 64, HALF = 128, HTB = HALF * BK * 2  , STAGE_BYTES = 8 * HTB, NXCD = 8, WGM = 8;

__host__ __device__ __forceinline__ int lds_byte(int r, int c) { const int st = (r >> 4) * 2 + (c >> 5), rr = r & 15, cc = c & 31, ob = rr * 64 + cc * 2; return st * 1024 + (ob ^ (((ob >> 9) & 1) << 5)); }
__host__ __device__ __forceinline__ void stage_rc(int b, int& R, int& C) { const int st = b / 1024, sb = b % 1024, swz = sb ^ (((sb >> 9) & 1) << 5); R = (st >> 1) * 16 + swz / 64; C = (st & 1) * 32 + (swz % 64) / 2; }
__host__ __device__ __forceinline__ int perm32(int rho) { const int n = rho >> 4, i = rho & 15; return 8 * (i >> 2) + 4 * n + (i & 3); }

struct Unit { int pm, pn; };
struct Gemm { const bf16_t* A; const bf16_t* Bt; int M, N, K; };

struct StaticOrder {
    int nM, nN, nwg, G, c;
    __host__ __device__ void init(int M, int N, int G_, int c_) { nM = M / BM; nN = N / BM; nwg = nM * nN; G = G_; c = c_; }
    __host__ __device__ bool next(int i, Unit& u) const {
        const long L = (long)i * G + c; if (L >= nwg) return false;
        int wgid = (int)L; { const int q = nwg / NXCD, r = nwg % NXCD, xcd = wgid % NXCD, off = wgid / NXCD; wgid = (xcd < r ? xcd * (q + 1) : r * (q + 1) + (xcd - r) * q) + off; }
        const int nig = WGM * nN, gid = wgid / nig, fm = gid * WGM, gsz = (nM - fm) < WGM ? (nM - fm) : WGM;
        u.pm = fm + ((wgid % nig) % gsz); u.pn = (wgid % nig) / gsz; return true;
    }
    __device__ __forceinline__ void a_ready(const Unit&) const {}
    __device__ __forceinline__ void done(const Unit&) const {}
};

__device__ __forceinline__ unsigned cvt_pk_bf16(float lo, float hi) { unsigned r; asm volatile("v_cvt_pk_bf16_f32 %0, %1, %2" : "=v"(r) : "v"(lo), "v"(hi)); return r; }
typedef float f32x2 __attribute__((ext_vector_type(2)));
template <class Epi, class Sched, bool ALIGN_EPI = false, bool SP2 = false>
__device__ __forceinline__ void gemm_phase(PG8_LAS unsigned char* lds, const Gemm g, const Sched& S, const Epi& E) {
    const int tid = threadIdx.x, wid = __builtin_amdgcn_readfirstlane(tid >> 6), lane = tid & 63, wr = wid >> 2, wc = wid & 3, fr = lane & 15, fq = lane >> 4;
    const int K = g.K, nt = K / BK;
    unsigned voffA[2], voffB[2];
#pragma unroll
    for (int i = 0; i < 2; ++i) { int R, C; stage_rc(tid * 16 + i * 8192, R, C); const int Rb = Epi::PERM ? ((R & ~31) + perm32(R & 31)) : R;
        voffA[i] = (unsigned)(R * K + C) * 2u; voffB[i] = (unsigned)(Rb * K + C) * 2u; }
    const size_t kstep = (size_t)(BK * 2);
    const size_t hstep = (size_t)HALF * K * 2;
    const size_t tstep = 2 * hstep;
    const unsigned ldsw = (unsigned)wid * 1024u;
    const int aoff = lds_byte(wr * 64 + fr, fq * 8), boff = lds_byte(wc * 32 + fr, fq * 8);
#define PG8_SA(b, h) (((b) * 2 + (h)) * HTB)
#define PG8_SB(b, h) ((4 + (b) * 2 + (h)) * HTB)
#define PG8_STAGE(bufoff, gbase, voff) do { _Pragma("unroll") for (int _i = 0; _i < 2; ++_i) \
        __builtin_amdgcn_global_load_lds((const unsigned*)((const char*)(gbase) + (voff)[_i]), (PG8_LAS unsigned*)(lds + (bufoff) + ldsw + _i * 8192), 16, 0, 0); } while (0)
#define PG8_LDA(dst, b, h) do { _Pragma("unroll") for (int m = 0; m < 4; ++m) _Pragma("unroll") for (int k = 0; k < 2; ++k) dst[m][k] = *(const PG8_LAS bf16x8*)(lds + PG8_SA(b, h) + aoff + m * 2048 + k * 1024); } while (0)
#define PG8_LDB(dst, b, h) do { _Pragma("unroll") for (int n = 0; n < 2; ++n) _Pragma("unroll") for (int k = 0; k < 2; ++k) dst[n][k] = *(const PG8_LAS bf16x8*)(lds + PG8_SB(b, h) + boff + n * 2048 + k * 1024); } while (0)
#define PG8_MMA(ai, bj, At, Bt) do { __builtin_amdgcn_s_setprio(1); _Pragma("unroll") for (int m = 0; m < 4; ++m) _Pragma("unroll") for (int n = 0; n < 2; ++n) _Pragma("unroll") for (int k = 0; k < 2; ++k) \
        acc[ai][bj][m][n] = __builtin_amdgcn_mfma_f32_16x16x32_bf16(Bt[n][k], At[m][k], acc[ai][bj][m][n], 0, 0, 0); __builtin_amdgcn_s_setprio(0); } while (0)
#define PG8_WAIT_V(n) asm volatile("s_waitcnt vmcnt(" #n ")" ::: "memory")
#define PG8_WAIT_L(n) asm volatile("s_waitcnt lgkmcnt(" #n ")" ::: "memory")
#define PG8_BAR __builtin_amdgcn_s_barrier()
#define PG8_SCHED __builtin_amdgcn_sched_barrier(0)
    Unit cur, nxt; int ui = 0;
    if (!S.next(0, cur)) return;
    f32x4 acc[2][2][4][2];
#pragma unroll
    for (int a = 0; a < 2; ++a)
#pragma unroll
        for (int b = 0; b < 2; ++b)
#pragma unroll
            for (int m = 0; m < 4; ++m)
#pragma unroll
                for (int n = 0; n < 2; ++n) acc[a][b][m][n] = (f32x4){0.f, 0.f, 0.f, 0.f};
    bf16x8 At[4][2], B0[2][2], B1[2][2];
    const char* cA = (const char*)g.A + (size_t)cur.pm * tstep; const char* cB = (const char*)g.Bt + (size_t)cur.pn * tstep;
    S.a_ready(cur);
    if constexpr (SP2) {
        PG8_STAGE(PG8_SB(0, 0), cB, voffB); PG8_STAGE(PG8_SB(0, 1), cB + hstep, voffB); PG8_STAGE(PG8_SA(0, 0), cA, voffA); PG8_STAGE(PG8_SA(0, 1), cA + hstep, voffA);
        if (wr == 1) PG8_BAR;
        PG8_WAIT_V(2); PG8_BAR;
        PG8_STAGE(PG8_SB(1, 0), cB + kstep, voffB); PG8_STAGE(PG8_SA(1, 0), cA + kstep, voffA); PG8_STAGE(PG8_SB(1, 1), cB + hstep + kstep, voffB);
        PG8_WAIT_V(6); PG8_BAR;
    } else {
        PG8_STAGE(PG8_SB(0, 0), cB, voffB); PG8_STAGE(PG8_SA(0, 0), cA, voffA); PG8_STAGE(PG8_SB(0, 1), cB + hstep, voffB); PG8_STAGE(PG8_SA(0, 1), cA + hstep, voffA);
        if (wr == 1) PG8_BAR;
        PG8_WAIT_V(4); PG8_BAR;
        PG8_STAGE(PG8_SB(1, 0), cB + kstep, voffB); PG8_STAGE(PG8_SA(1, 0), cA + kstep, voffA); PG8_STAGE(PG8_SB(1, 1), cB + hstep + kstep, voffB);
        PG8_WAIT_V(6); PG8_BAR;
    }
    for (;;) {
        const bool has_next = S.next(ui + 1, nxt);
        const char* nA = has_next ? (const char*)g.A + (size_t)nxt.pm * tstep : cA; const char* nB = has_next ? (const char*)g.Bt + (size_t)nxt.pn * tstep : cB;
        for (int t = 0; t < nt; t += 2) {
            const bool last = (t == nt - 2);
            const char* a1 = cA + (size_t)(t + 1) * kstep;
            const char* a2 = last ? nA : cA + (size_t)(t + 2) * kstep; const char* b2 = last ? nB : cB + (size_t)(t + 2) * kstep;
            const char* a3 = a2 + kstep; const char* b3 = b2 + kstep;
            if (last && has_next) S.a_ready(nxt);
            if constexpr (SP2) {
            PG8_LDB(B0, 0, 0); PG8_LDB(B1, 0, 1); PG8_SCHED; PG8_LDA(At, 0, 0); PG8_STAGE(PG8_SA(1, 1), a1 + hstep, voffA);
            PG8_WAIT_V(8); PG8_WAIT_L(0); PG8_BAR; PG8_MMA(0, 0, At, B0); PG8_MMA(0, 1, At, B1); PG8_BAR; PG8_SCHED;
            PG8_LDA(At, 0, 1); PG8_STAGE(PG8_SB(0, 0), b2, voffB); PG8_STAGE(PG8_SB(0, 1), b2 + hstep, voffB); PG8_STAGE(PG8_SA(0, 0), a2, voffA);
            PG8_WAIT_V(8); PG8_WAIT_L(0); PG8_BAR; PG8_MMA(1, 0, At, B0); PG8_MMA(1, 1, At, B1); PG8_BAR; PG8_SCHED;
            PG8_LDB(B0, 1, 0); PG8_LDB(B1, 1, 1); PG8_SCHED; PG8_LDA(At, 1, 0); PG8_STAGE(PG8_SA(0, 1), a2 + hstep, voffA);
            PG8_WAIT_V(8); PG8_WAIT_L(0); PG8_BAR; PG8_MMA(0, 0, At, B0); PG8_MMA(0, 1, At, B1); PG8_BAR; PG8_SCHED;
            PG8_LDA(At, 1, 1); PG8_STAGE(PG8_SB(1, 0), b3, voffB); PG8_STAGE(PG8_SB(1, 1), b3 + hstep, voffB); PG8_STAGE(PG8_SA(1, 0), a3, voffA);
            PG8_WAIT_V(8); PG8_WAIT_L(0); PG8_BAR; PG8_MMA(1, 0, At, B0); PG8_MMA(1, 1, At, B1); PG8_BAR; PG8_SCHED;
            } else {
            PG8_LDB(B0, 0, 0); PG8_SCHED; PG8_LDA(At, 0, 0); PG8_STAGE(PG8_SA(1, 1), a1 + hstep, voffA);
            PG8_WAIT_L(8); PG8_BAR; PG8_WAIT_L(0); PG8_MMA(0, 0, At, B0); PG8_BAR; PG8_SCHED;
            PG8_LDB(B1, 0, 1); PG8_STAGE(PG8_SB(0, 0), b2, voffB);
            PG8_BAR; PG8_WAIT_L(0); PG8_MMA(0, 1, At, B1); PG8_BAR;
            PG8_LDA(At, 0, 1); PG8_STAGE(PG8_SA(0, 0), a2, voffA);
            PG8_BAR; PG8_WAIT_L(0); PG8_MMA(1, 0, At, B0); PG8_BAR; PG8_SCHED;
            PG8_STAGE(PG8_SB(0, 1), b2 + hstep, voffB);
            PG8_WAIT_V(6); PG8_BAR; PG8_MMA(1, 1, At, B1); PG8_BAR;
            PG8_LDB(B0, 1, 0); PG8_SCHED; PG8_LDA(At, 1, 0); PG8_STAGE(PG8_SA(0, 1), a2 + hstep, voffA);
            PG8_WAIT_L(8); PG8_BAR; PG8_WAIT_L(0); PG8_MMA(0, 0, At, B0); PG8_BAR; PG8_SCHED;
            PG8_LDB(B1, 1, 1); PG8_STAGE(PG8_SB(1, 0), b3, voffB);
            PG8_BAR; PG8_WAIT_L(0); PG8_MMA(0, 1, At, B1); PG8_BAR;
            PG8_LDA(At, 1, 1); PG8_STAGE(PG8_SA(1, 0), a3, voffA);
            PG8_BAR; PG8_WAIT_L(0); PG8_MMA(1, 0, At, B0); PG8_BAR; PG8_SCHED;
            PG8_STAGE(PG8_SB(1, 1), b3 + hstep, voffB);
            PG8_WAIT_V(6); PG8_BAR; PG8_MMA(1, 1, At, B1); PG8_BAR;
            }
        }
        if constexpr (ALIGN_EPI) { if (wr == 0) PG8_BAR; }
        if constexpr (!Epi::AFTER_DRAIN) { E(acc, cur, wr, wc, fr, fq); S.done(cur); }
        if (!has_next) break;
#pragma unroll
        for (int a = 0; a < 2; ++a)
#pragma unroll
            for (int b = 0; b < 2; ++b)
#pragma unroll
                for (int m = 0; m < 4; ++m)
#pragma unroll
                    for (int n = 0; n < 2; ++n) acc[a][b][m][n] = (f32x4){0.f, 0.f, 0.f, 0.f};
        cur = nxt; cA = nA; cB = nB; ++ui;
        if constexpr (ALIGN_EPI) { if (wr == 1) PG8_BAR; }
    }
    PG8_WAIT_V(0);
    if constexpr (!ALIGN_EPI) { if (wr == 0) PG8_BAR; }
    PG8_BAR;
    if constexpr (Epi::AFTER_DRAIN) { E.fused(acc, cur, wr, wc, fr, fq, lds, wid, lane); S.done(cur); }
#undef PG8_SA
#undef PG8_SB
#undef PG8_STAGE
#undef PG8_LDA
#undef PG8_LDB
#undef PG8_MMA
#undef PG8_WAIT_V
#undef PG8_WAIT_L
#undef PG8_BAR
#undef PG8_SCHED
}


struct EpiPlain {
    static constexpr bool PERM = true, AFTER_DRAIN = false;
    bf16_t* O; int ldc;
    __device__ __forceinline__ void operator()(const f32x4 (&acc)[2][2][4][2], const Unit& u, int wr, int wc, int fr, int fq) const {
        bf16_t* base = O + (size_t)(u.pm * BM + wr * 64 + fr) * ldc + u.pn * BM + wc * 32 + 8 * fq;
#pragma unroll
        for (int ai = 0; ai < 2; ++ai)
#pragma unroll
            for (int m = 0; m < 4; ++m) {
                bf16_t* rowp = base + (size_t)(ai * HALF + m * 16) * ldc;
#pragma unroll
                for (int bj = 0; bj < 2; ++bj) {
                    const f32x4 v0 = acc[ai][bj][m][0], v1 = acc[ai][bj][m][1];
                    u32x4 w; w.x = cvt_pk_bf16(v0[0], v0[1]); w.y = cvt_pk_bf16(v0[2], v0[3]); w.z = cvt_pk_bf16(v1[0], v1[1]); w.w = cvt_pk_bf16(v1[2], v1[3]);
                    *(u32x4*)(rowp + bj * HALF) = w;
                }
            }
    }
};
struct EpiSwiGLU {
    static constexpr bool PERM = true, AFTER_DRAIN = false;
    bf16_t* ACT; int ldc;
    __device__ __forceinline__ void operator()(const f32x4 (&acc)[2][2][4][2], const Unit& u, int wr, int wc, int fr, int fq) const {
        bf16_t* base = ACT + (size_t)(u.pm * BM + wr * 64 + fr) * ldc + ((u.pn * BM + wc * 32 + 8 * fq) >> 1);
#pragma unroll
        for (int ai = 0; ai < 2; ++ai)
#pragma unroll
            for (int m = 0; m < 4; ++m) {
                bf16_t* rowp = base + (size_t)(ai * HALF + m * 16) * ldc;
#pragma unroll
                for (int bj = 0; bj < 2; ++bj) {
                    const f32x4 g = acc[ai][bj][m][0], up = acc[ai][bj][m][1];
                    float a[4];
#pragma unroll
                    for (int e = 0; e < 4; ++e) a[e] = g[e] * __builtin_amdgcn_rcpf(1.f + __expf(-g[e])) * up[e];
                    typedef unsigned u32x2v __attribute__((ext_vector_type(2)));
                    u32x2v w; w.x = cvt_pk_bf16(a[0], a[1]); w.y = cvt_pk_bf16(a[2], a[3]);
                    *(u32x2v*)(rowp + bj * (HALF / 2)) = w;
                }
            }
    }
};
struct EpiInproj {
    static constexpr bool PERM = true, AFTER_DRAIN = false;
    unsigned char* ws; size_t off_qd, off_kd, off_vdt, off_qn, off_kct, off_vct, off_ks, off_vst, off_kw, off_vwt, off_gates, off_rope;
    __device__ __forceinline__ void operator()(const f32x4 (&acc)[2][2][4][2], const Unit& u, int wr, int wc, int fr, int fq) const {
        typedef unsigned u32x2v __attribute__((ext_vector_type(2)));
        typedef float f32x2v __attribute__((ext_vector_type(2)));
        const int row0 = u.pm * BM + wr * 64 + fr;
        const int b = row0 >> 12, pos0 = row0 & 4095;
#pragma unroll
        for (int bj = 0; bj < 2; ++bj) {
            const int cb = u.pn * BM + bj * HALF;
            const int cl = wc * 32 + 8 * fq;
            int kind = 4; size_t off = 0; int hidx = 0;
            if (cb < 512) { kind = 0; off = off_qd; hidx = b * 8 + ((cb + cl) >> 6); }
            else if (cb < 1024) { kind = 0; off = off_kd; hidx = b * 8 + ((cb - 512 + cl) >> 6); }
            else if (cb < 1536) { kind = 2; off = off_vdt; hidx = b * 4 + ((cb - 1024) >> 7); }
            else if (cb < 2048) { kind = 0; off = off_qn; hidx = b * 8 + ((cb - 1536 + cl) >> 6); }
            else if (cb == 2048) { kind = 0; off = off_kct; hidx = b * 2 + (cl >> 6); }
            else if (cb == 2176) { kind = 1; off = off_vct; hidx = b * 2 + (cl >> 6); }
            else if (cb == 2304) { kind = 0; off = off_ks; hidx = b * 2 + (cl >> 6); }
            else if (cb == 2432) { kind = 3; off = off_vst; hidx = b * 2 + (cl >> 6); }
            else if (cb == 2560) { kind = 0; off = off_kw; hidx = b * 2 + (cl >> 6); }
            else if (cb == 2688) { kind = 3; off = off_vwt; hidx = b * 2 + (cl >> 6); }
            else if (cb == 2816) kind = 5;
            if (kind == 0) {
                const int g4 = 4 * (((cl & 63) >> 3));
                bf16_t* dst = (bf16_t*)(ws + off) + ((size_t)hidx * 4096 + pos0) * 64 + g4;
                const f32x2v* tab = (const f32x2v*)(ws + off_rope) + (size_t)pos0 * 32 + g4;
#pragma unroll
                for (int ai = 0; ai < 2; ++ai)
#pragma unroll
                    for (int m = 0; m < 4; ++m) {
                        const int dp = ai * HALF + m * 16;
                        const f32x4 x1 = acc[ai][bj][m][0], x2 = acc[ai][bj][m][1];
                        const f32x4 t01 = *(const f32x4*)(tab + (size_t)dp * 32), t23 = *(const f32x4*)(tab + (size_t)dp * 32 + 2);
                        const float c0 = t01[0], s0 = t01[1], c1 = t01[2], s1 = t01[3], c2 = t23[0], s2 = t23[1], c3 = t23[2], s3 = t23[3];
                        u32x2v lo, hi;
                        lo.x = cvt_pk_bf16(x1[0] * c0 - x2[0] * s0, x1[1] * c1 - x2[1] * s1); lo.y = cvt_pk_bf16(x1[2] * c2 - x2[2] * s2, x1[3] * c3 - x2[3] * s3);
                        hi.x = cvt_pk_bf16(x1[0] * s0 + x2[0] * c0, x1[1] * s1 + x2[1] * c1); hi.y = cvt_pk_bf16(x1[2] * s2 + x2[2] * c2, x1[3] * s3 + x2[3] * c3);
                        *(u32x2v*)(dst + (size_t)dp * 64) = lo; *(u32x2v*)(dst + (size_t)dp * 64 + 32) = hi;
                    }
            } else if (kind == 1) {
                bf16_t* dst = (bf16_t*)(ws + off) + ((size_t)hidx * 4096 + pos0) * 64 + (cl & 63);
#pragma unroll
                for (int ai = 0; ai < 2; ++ai)
#pragma unroll
                    for (int m = 0; m < 4; ++m) {
                        const f32x4 v0 = acc[ai][bj][m][0], v1 = acc[ai][bj][m][1];
                        u32x4 w; w.x = cvt_pk_bf16(v0[0], v0[1]); w.y = cvt_pk_bf16(v0[2], v0[3]); w.z = cvt_pk_bf16(v1[0], v1[1]); w.w = cvt_pk_bf16(v1[2], v1[3]);
                        *(u32x4*)(dst + (size_t)(ai * HALF + m * 16) * 64) = w;
                    }
            } else if (kind == 2 || kind == 3) {
                const int dv = (kind == 2) ? 128 : 64;
                const int e0 = (kind == 2) ? cl : (cl & 63);
#pragma unroll
                for (int ai = 0; ai < 2; ++ai) {
                    const int pa = pos0 + ai * HALF;
                    bf16_t* dst = (bf16_t*)(ws + off) + (((size_t)hidx * 64 + (pa >> 6)) * dv + e0) * 64 + (pa & 63);
#pragma unroll
                    for (int m = 0; m < 4; ++m)
#pragma unroll
                        for (int n = 0; n < 2; ++n)
#pragma unroll
                            for (int j = 0; j < 4; ++j) {
                                const unsigned pk = cvt_pk_bf16(acc[ai][bj][m][n][j], 0.f);
                                dst[(4 * n + j) * 64 + 16 * m] = (bf16_t)(pk & 0xffffu);
                            }
                }
            } else if (kind == 5) {
                if (wc == 0 && fq < 3) {
                    float* gates = (float*)(ws + off_gates) + (size_t)row0 * 24 + 8 * fq;
#pragma unroll
                    for (int ai = 0; ai < 2; ++ai)
#pragma unroll
                        for (int m = 0; m < 4; ++m) {
                            f32x4 a = acc[ai][bj][m][0], c = acc[ai][bj][m][1];
#pragma unroll
                            for (int e = 0; e < 4; ++e) { a[e] = 1.f / (1.f + __expf(-a[e])); c[e] = 1.f / (1.f + __expf(-c[e])); }
                            float* gp = gates + (size_t)(ai * HALF + m * 16) * 24;
                            *(f32x4*)gp = a; *(f32x4*)(gp + 4) = c;
                        }
                }
            }
        }
    }
};
}

DI void epi_inproj(const Params& p, const unsigned char* lds, int m0, int n0) {
    unsigned char* ws = p.ws;
    const float* Ct = (const float*)lds;
    const int b = m0 >> 12, pos0 = m0 & 4095;
    int tid = VTID; asm volatile("" : "+v"(tid));
    if (n0 == 2816) {
        float* gates = (float*)(ws + OFF_GATES);
#pragma unroll 1
        for (int c = tid; c < 128 * 3; c += 256) {
            const int a = c / 3, ch = c - a * 3;
            float v[8]; ld8(Ct + a * CP + ch * 8, v);
            f32x4 o0, o1;
            o0[0] = sigmoidf(v[0]); o0[1] = sigmoidf(v[1]); o0[2] = sigmoidf(v[2]); o0[3] = sigmoidf(v[3]);
            o1[0] = sigmoidf(v[4]); o1[1] = sigmoidf(v[5]); o1[2] = sigmoidf(v[6]); o1[3] = sigmoidf(v[7]);
            float* g = gates + (size_t)(m0 + a) * 24 + ch * 8;
            *(f32x4*)g = o0; *(f32x4*)(g + 4) = o1;
        }
        return;
    }
    const bool tr = (n0 >= 1024 && n0 < 1536) || n0 == 2432 || n0 == 2688;
    if (tr) {
        bf16_t* dst; int hshift, hbase, nbase;
        if (n0 < 1536) { dst = (bf16_t*)(ws + OFF_VDT); hshift = 7; hbase = b * 4; nbase = 1024; }
        else if (n0 == 2432) { dst = (bf16_t*)(ws + OFF_VST); hshift = 6; hbase = b * 2; nbase = 2432; }
        else { dst = (bf16_t*)(ws + OFF_VWT); hshift = 6; hbase = b * 2; nbase = 2688; }
#pragma unroll 1
        for (int c = tid; c < 2048; c += 256) {
            const int a = c >> 4, ch = c & 15;
            const int cr = n0 + a - nbase;
            const int hidx = hbase + (cr >> hshift), e = cr & ((1 << hshift) - 1);
            float v[8]; ld8(Ct + a * CP + ch * 8, v);
            const int pos = pos0 + ch * 8;
            *(u32x4*)(dst + ((((size_t)hidx * 64 + (pos >> 6)) << hshift) + e) * 64 + (pos & 63)) = pk8(v);
        }
        return;
    }
    if (n0 == 2176) {
        bf16_t* dst = (bf16_t*)(ws + OFF_VCT);
#pragma unroll 1
        for (int c = tid; c < 2048; c += 256) {
            const int a = c >> 4, ch = c & 15;
            const int hidx = b * 2 + (ch >> 3);
            float v[8]; ld8(Ct + a * CP + ch * 8, v);
            *(u32x4*)(dst + ((size_t)hidx * 4096 + pos0 + a) * 64 + (ch & 7) * 8) = pk8(v);
        }
        return;
    }
    {
        bf16_t* dst; int hbase;
        if (n0 < 512) { dst = (bf16_t*)(ws + OFF_QD); hbase = b * 8 + (n0 >> 6); }
        else if (n0 < 1024) { dst = (bf16_t*)(ws + OFF_KD); hbase = b * 8 + ((n0 - 512) >> 6); }
        else if (n0 < 2048) { dst = (bf16_t*)(ws + OFF_QN); hbase = b * 8 + ((n0 - 1536) >> 6); }
        else if (n0 == 2048) { dst = (bf16_t*)(ws + OFF_KCT); hbase = b * 2; }
        else if (n0 == 2304) { dst = (bf16_t*)(ws + OFF_KS); hbase = b * 2; }
        else { dst = (bf16_t*)(ws + OFF_KW); hbase = b * 2; }
        const float* tab = (const float*)(ws + OFF_ROPE);
#pragma unroll 1
        for (int c = tid; c < 1024; c += 256) {
            const int a = c >> 3, hd = (c >> 2) & 1, cc = c & 3;
            float x1[8], x2[8], cs[16];
            ld8(Ct + a * CP + hd * 64 + cc * 8, x1); ld8(Ct + a * CP + hd * 64 + 32 + cc * 8, x2);
            const int pos = pos0 + a;
            const float* tp = tab + ((size_t)pos * 32 + cc * 8) * 2;
            {
                const f32x4 t0 = *(const f32x4*)tp, t1 = *(const f32x4*)(tp + 4), t2 = *(const f32x4*)(tp + 8), t3 = *(const f32x4*)(tp + 12);
                cs[0] = t0[0]; cs[1] = t0[1]; cs[2] = t0[2]; cs[3] = t0[3]; cs[4] = t1[0]; cs[5] = t1[1]; cs[6] = t1[2]; cs[7] = t1[3];
                cs[8] = t2[0]; cs[9] = t2[1]; cs[10] = t2[2]; cs[11] = t2[3]; cs[12] = t3[0]; cs[13] = t3[1]; cs[14] = t3[2]; cs[15] = t3[3];
            }
            float y1[8], y2[8];
#pragma unroll
            for (int e = 0; e < 8; ++e) { const float cv = cs[2 * e], sv = cs[2 * e + 1]; y1[e] = x1[e] * cv - x2[e] * sv; y2[e] = x1[e] * sv + x2[e] * cv; }
            bf16_t* d = dst + ((size_t)(hbase + hd) * 4096 + pos) * 64 + cc * 8;
            *(u32x4*)d = pk8(y1); *(u32x4*)(d + 32) = pk8(y2);
        }
    }
}
DI void phase1(const Params& p, unsigned char* lds) {
    pg8::Gemm g; g.A = (const bf16_t*)(p.ws + OFF_H); g.Bt = (const bf16_t*)(p.ws + OFF_WINT); g.M = T; g.N = INP; g.K = 1024;
    pg8::StaticOrder S; S.init(T, INP, (int)gridDim.x, (int)blockIdx.x);
    pg8::EpiInproj E; E.ws = p.ws; E.off_qd = OFF_QD; E.off_kd = OFF_KD; E.off_vdt = OFF_VDT; E.off_qn = OFF_QN; E.off_kct = OFF_KCT; E.off_vct = OFF_VCT;
    E.off_ks = OFF_KS; E.off_vst = OFF_VST; E.off_kw = OFF_KW; E.off_vwt = OFF_VWT; E.off_gates = OFF_GATES; E.off_rope = OFF_ROPE;
    pg8::gemm_phase<pg8::EpiInproj, pg8::StaticOrder, true, true>((PG8_LAS unsigned char*)lds, g, S, E);
    __syncthreads();
}

DI void phase2(const Params& p, unsigned char* lds) {
    unsigned char* hl = lds + VHALF * HALF_LDS;
    for (int t = blockIdx.x; t < 128; t += gridDim.x) {
        const int kv = t >> 6, bg = (t >> 2) & 15, mt = (t >> 1) & 1, nt = t & 1, kh = VHALF * 1024;
        const bf16_t* A = (const bf16_t*)(p.ws + (kv ? OFF_VCT : OFF_KCT)) + (size_t)bg * 4096 * 64 + (size_t)mt * 128 * 1024 + kh;
        const bf16_t* B = (const bf16_t*)(p.ws + OFF_W1T) + (size_t)kv * 256 * 2048 + (size_t)nt * 128 * 2048 + kh;
        f32x16 acc[2][2]; zero_acc(acc);
        gemm_main<false>(A, 1024, B, 2048, 1024, acc, hl);
        acc_to_lds<false>(acc, hl);
        __syncthreads();
        const float* b1 = (const float*)(p.ws + OFF_B1) + kv * 256 + nt * 128;
        bf16_t* HID = (bf16_t*)(p.ws + OFF_HID) + (size_t)(kv * 16 + bg) * 65536 + (size_t)mt * 128 * 256 + nt * 128;
        const float* C0 = (const float*)lds; const float* C1 = (const float*)(lds + HALF_LDS);
#pragma unroll 1
        for (int c = threadIdx.x; c < 2048; c += 512) {
            const int a = c >> 4, ch = c & 15;
            float v[8], v2[8], bb[8]; ld8(C0 + a * CP + ch * 8, v); ld8(C1 + a * CP + ch * 8, v2); ld8(b1 + ch * 8, bb);
#pragma unroll
            for (int e = 0; e < 8; ++e) { const float z = (v[e] + v2[e]) + bb[e]; v[e] = z * sigmoidf(z); }
            *(u32x4*)(HID + (size_t)a * 256 + ch * 8) = pk8(v);
        }
        __syncthreads();
    }
}
DI void phase3(const Params& p, unsigned char* lds) {
    unsigned char* hl = lds + VHALF * HALF_LDS;
    for (int t = blockIdx.x; t < 64; t += gridDim.x) {
        const int kv = t >> 5, bg = (t >> 1) & 15, mt = t & 1, kh = VHALF * 128;
        const bf16_t* A = (const bf16_t*)(p.ws + OFF_HID) + (size_t)(kv * 16 + bg) * 65536 + (size_t)mt * 128 * 256 + kh;
        const bf16_t* B = (const bf16_t*)(p.ws + OFF_W2T) + (size_t)kv * 128 * 256 + kh;
        f32x16 acc[2][2]; zero_acc(acc);
        if (kv == 0) { gemm_main<false>(A, 256, B, 256, 128, acc, hl); acc_to_lds<false>(acc, hl); }
        else { gemm_main<true>(A, 256, B, 256, 128, acc, hl); acc_to_lds<true>(acc, hl); }
        __syncthreads();
        const float* C0 = (const float*)lds; const float* C1 = (const float*)(lds + HALF_LDS);
        if (kv == 0) {
            bf16_t* KC = (bf16_t*)(p.ws + OFF_KCMP) + (size_t)bg * 256 * 64 + (size_t)mt * 128 * 64;
#pragma unroll 1
            for (int c = threadIdx.x; c < 128 * 8; c += 512) {
                const int a = c >> 3, ch = c & 7;
                float v[8], v2[8]; ld8(C0 + a * CP + ch * 8, v); ld8(C1 + a * CP + ch * 8, v2);
#pragma unroll
                for (int e = 0; e < 8; ++e) v[e] += v2[e];
                *(u32x4*)(KC + (size_t)a * 64 + ch * 8) = pk8(v);
            }
        } else {
            bf16_t* VC = (bf16_t*)(p.ws + OFF_VCMPT) + (size_t)bg * 64 * 256;
#pragma unroll 1
            for (int c = threadIdx.x; c < 64 * 16; c += 512) {
                const int a = c >> 4, ch = c & 15;
                const int n = mt * 128 + ch * 8;
                float v[8], v2[8]; ld8(C0 + a * CP + ch * 8, v); ld8(C1 + a * CP + ch * 8, v2);
#pragma unroll
                for (int e = 0; e < 8; ++e) v[e] += v2[e];
                *(u32x4*)(VC + ((size_t)(n >> 6) * 64 + a) * 64 + (n & 63)) = pk8(v);
            }
        }
        __syncthreads();
    }
}

constexpr int KP = 144;
constexpr int VP = 144;
constexpr int KT_BYTES = 64 * KP;
constexpr float SM_C = 0.125f * 1.4426950408889634f;
#define NEG_INF (-__builtin_inff())

template <int DV> struct KVStage { u32x4 k[1]; u32x4 v[DV / 64]; };

template <int DV, bool HAS_V>
DI void kv_gload(KVStage<DV>& st, const bf16_t* __restrict__ Kb, const bf16_t* __restrict__ VTb, int ldv, int key0) {
    const int tid = threadIdx.x;
    st.k[0] = *(const u32x4*)(Kb + (size_t)(key0 + (tid >> 3)) * 64 + (tid & 7) * 8);
    if (HAS_V) {
#pragma unroll
        for (int i = 0; i < DV / 64; ++i) { const int c = tid + 512 * i; st.v[i] = *(const u32x4*)(VTb + (size_t)(key0 >> 6) * (DV * 64) + c * 8); }
    }
}
template <int DV, bool HAS_V>
DI void kv_sstore(const KVStage<DV>& st, unsigned char* buf) {
    const int tid = threadIdx.x;
    *(u32x4*)(buf + (tid >> 3) * KP + (tid & 7) * 16) = st.k[0];
    if (HAS_V) {
#pragma unroll
        for (int i = 0; i < DV / 64; ++i) {
            const int c = tid + 512 * i, kc = c & 7; unsigned char* q = buf + KT_BYTES + (c >> 3) * VP + (kc >> 1) * 32 + (kc & 1) * 8;
            u32x2 lo, hi; lo.x = st.v[i].x; lo.y = st.v[i].y; hi.x = st.v[i].z; hi.y = st.v[i].w;
            *(u32x2*)q = lo; *(u32x2*)(q + 16) = hi;
        }
    }
}
template <int DV, bool HAS_V, class Next, class Body>
DI void kv_loop(unsigned char* lds, const bf16_t* Kb, const bf16_t* VTb, int ldv, int nt, int j0, Next next, Body body, int probe = 0) {
    constexpr int SB = KT_BYTES + (HAS_V ? DV * VP : 0);
    KVStage<DV> st;
    int jn = j0;
    if (probe != 1) { kv_gload<DV, HAS_V>(st, Kb, VTb, ldv, jn * 64); kv_sstore<DV, HAS_V>(st, lds); }
    __syncthreads();
    for (int i = 0; i < nt; ++i) {
        const int j = jn;
        const bool more = (i + 1 < nt);
        if (more) { jn = next(j); if (probe != 1) kv_gload<DV, HAS_V>(st, Kb, VTb, ldv, jn * 64); }
        if (probe != 2) body(j, (const unsigned char*)(lds + (i & 1) * SB));
        if (more && probe != 1) kv_sstore<DV, HAS_V>(st, lds + ((i + 1) & 1) * SB);
        __syncthreads();
    }
}
DI void attn_scores(const unsigned char* kb, const bf16x8 (&qf)[4], int r, int h, f32x16& s0, f32x16& s1) {
#pragma unroll
    for (int i = 0; i < 16; ++i) { s0[i] = 0.f; s1[i] = 0.f; }
#pragma unroll
    for (int s = 0; s < 4; ++s) {
        const bf16x8 k0 = *(const bf16x8*)(kb + r * KP + s * 32 + h * 16);
        const bf16x8 k1 = *(const bf16x8*)(kb + (32 + r) * KP + s * 32 + h * 16);
        s0 = MFMA(k0, qf[s], s0); s1 = MFMA(k1, qf[s], s1);
    }
}
DI void pack_p(const f32x16& p0, const f32x16& p1, bf16x8 (&pf)[2][2]) {
#pragma unroll
    for (int sp = 0; sp < 2; ++sp) {
        u32x4 a, b;
        a.x = pk_bf16(p0[8 * sp + 0], p0[8 * sp + 1]); a.y = pk_bf16(p0[8 * sp + 2], p0[8 * sp + 3]);
        a.z = pk_bf16(p0[8 * sp + 4], p0[8 * sp + 5]); a.w = pk_bf16(p0[8 * sp + 6], p0[8 * sp + 7]);
        b.x = pk_bf16(p1[8 * sp + 0], p1[8 * sp + 1]); b.y = pk_bf16(p1[8 * sp + 2], p1[8 * sp + 3]);
        b.z = pk_bf16(p1[8 * sp + 4], p1[8 * sp + 5]); b.w = pk_bf16(p1[8 * sp + 6], p1[8 * sp + 7]);
        pf[0][sp] = __builtin_bit_cast(bf16x8, a); pf[1][sp] = __builtin_bit_cast(bf16x8, b);
    }
}
template <int DV>
DI void attn_pv(const unsigned char* vb, const bf16x8 (&pf)[2][2], int r, int h, f32x16 (&o)[DV / 32]) {
#pragma unroll
    for (int dt = 0; dt < DV / 32; ++dt)
#pragma unroll
        for (int mt = 0; mt < 2; ++mt)
#pragma unroll
            for (int sp = 0; sp < 2; ++sp) {
                const bf16x8 vf = *(const bf16x8*)(vb + (dt * 32 + r) * VP + (2 * mt + sp) * 32 + h * 16);
                o[dt] = MFMA(vf, pf[mt][sp], o[dt]);
            }
}
constexpr float SM_THR = 7.2f;
typedef float f32x8 __attribute__((ext_vector_type(8)));
DI float hsum16(const f32x16& v) {
    const f32x8 a = __builtin_shufflevector(v, v, 0, 1, 2, 3, 4, 5, 6, 7) + __builtin_shufflevector(v, v, 8, 9, 10, 11, 12, 13, 14, 15);
    const f32x4 b = __builtin_shufflevector(a, a, 0, 1, 2, 3) + __builtin_shufflevector(a, a, 4, 5, 6, 7);
    return (b[0] + b[1]) + (b[2] + b[3]);
}
template <int DV>
DI void attn_softmax_pv(f32x16& s0, f32x16& s1, float& m, f32x16& lv, f32x16 (&o)[DV / 32], const unsigned char* vb, int r, int h, bool on = true) {
    s0 = s0 * SM_C; s1 = s1 * SM_C;
    const f32x16 t = __builtin_elementwise_max(s0, s1);
    float mx = fmaxf(fmaxf(fmaxf(t[0], t[1]), fmaxf(t[2], t[3])), fmaxf(fmaxf(t[4], t[5]), fmaxf(t[6], t[7])));
    mx = fmaxf(mx, fmaxf(fmaxf(fmaxf(t[8], t[9]), fmaxf(t[10], t[11])), fmaxf(fmaxf(t[12], t[13]), fmaxf(t[14], t[15]))));
    mx = on ? mx : NEG_INF;
    mx = xhalf_max(mx);
    if (!__all(mx - m <= SM_THR)) {
        const float mn = fmaxf(m, mx);
        const float alpha = fast_exp2(m - mn);
        lv = lv * alpha; m = mn;
#pragma unroll
        for (int dt = 0; dt < DV / 32; ++dt) o[dt] = o[dt] * alpha;
    }
    const float msub = on ? m : __builtin_inff();
    s0 = s0 - msub; s1 = s1 - msub;
#pragma unroll
    for (int i = 0; i < 16; ++i) { s0[i] = fast_exp2(s0[i]); s1[i] = fast_exp2(s1[i]); }
    lv = lv + (s0 + s1);
    bf16x8 pf[2][2]; pack_p(s0, s1, pf);
    attn_pv<DV>(vb, pf, r, h, o);
}

DI void diff_unit(const Params& p, int u, unsigned char* lds, int probe = 0) {
    int tid_ = threadIdx.x; asm volatile("" : "+v"(tid_));
    const int lane = tid_ & 63, w = tid_ >> 6, r = lane & 31, h = lane >> 5;
    const int qt = 15 - (u >> 5), bh = u & 31, b = bh >> 2, hh = bh & 3;
    const int q0 = qt * 256, wq0 = q0 + 32 * w, qpos = wq0 + r;
    const int ntl = 4 * qt + 4;
    const float lam = ((const float*)(p.ws + OFF_CTL))[16];
    const bf16_t* VTb = (const bf16_t*)(p.ws + OFF_VDT) + (size_t)(b * 4 + hh) * 128 * 4096;
#pragma unroll 1
    for (int mp = 0; mp < 2; ++mp) {
        const size_t hoff = ((size_t)(b * 8 + hh * 2 + mp) * 4096) * 64;
        const bf16_t* Qb = (const bf16_t*)(p.ws + OFF_QD) + hoff;
        const bf16_t* Kb = (const bf16_t*)(p.ws + OFF_KD) + hoff;
        bf16x8 qf[4];
#pragma unroll
        for (int s = 0; s < 4; ++s) qf[s] = *(const bf16x8*)(Qb + (size_t)qpos * 64 + s * 16 + h * 8);
#pragma unroll
        for (int s = 0; s < 4; ++s) asm volatile("" : "+v"(qf[s]));
        f32x16 o[4];
#pragma unroll
        for (int dt = 0; dt < 4; ++dt)
#pragma unroll
            for (int i = 0; i < 16; ++i) o[dt][i] = 0.f;
        float m = -1e30f; f32x16 lv;
#pragma unroll
        for (int i = 0; i < 16; ++i) lv[i] = 0.f;
        kv_loop<128, true>(lds, Kb, VTb, 4096, ntl, 0, [](int j) { return j + 1; }, [&](int j, const unsigned char* sb) {
            const int k0 = j * 64;
            if (k0 <= wq0 + 31) {
                f32x16 s0, s1; attn_scores(sb, qf, r, h, s0, s1);
                if (k0 + 63 > wq0) {
#pragma unroll
                    for (int i = 0; i < 16; ++i) {
                        const int kl = k0 + crow(i, h);
                        if (kl > qpos) s0[i] = NEG_INF;
                        if (kl + 32 > qpos) s1[i] = NEG_INF;
                    }
                }
                attn_softmax_pv<128>(s0, s1, m, lv, o, sb + KT_BYTES, r, h);
            }
        }, probe);
        const float l = xhalf_sum(hsum16(lv));
        if (probe) {
            float chk = l + m;
#pragma unroll
            for (int dt = 0; dt < 4; ++dt)
#pragma unroll
                for (int i = 0; i < 16; ++i) chk += o[dt][i];
            if (chk == 1.2345e-30f) ((float*)(p.ws + OFF_CTL))[32] = chk;
            continue;
        }
        const float inv = 1.f / l;
        bf16_t* O = (bf16_t*)(p.ws + OFF_O) + ((size_t)b * 4096 + qpos) * 1024 + hh * 128;
        if (mp == 0) {
#pragma unroll
            for (int dt = 0; dt < 4; ++dt)
#pragma unroll
                for (int g4 = 0; g4 < 4; ++g4) {
                    u32x2 ov; ov.x = pk_bf16(o[dt][4 * g4] * inv, o[dt][4 * g4 + 1] * inv); ov.y = pk_bf16(o[dt][4 * g4 + 2] * inv, o[dt][4 * g4 + 3] * inv);
                    *(u32x2*)(O + dt * 32 + 8 * g4 + 4 * h) = ov;
                }
        } else {
            float ss = 0.f;
            const float li = lam * inv;
#pragma unroll
            for (int dt = 0; dt < 4; ++dt)
#pragma unroll
                for (int g4 = 0; g4 < 4; ++g4) {
                    const u32x2 pv = *(const u32x2*)(O + dt * 32 + 8 * g4 + 4 * h);
                    const float v0 = bflo(pv.x) - li * o[dt][4 * g4], v1 = bfhi(pv.x) - li * o[dt][4 * g4 + 1];
                    const float v2 = bflo(pv.y) - li * o[dt][4 * g4 + 2], v3 = bfhi(pv.y) - li * o[dt][4 * g4 + 3];
                    o[dt][4 * g4] = v0; o[dt][4 * g4 + 1] = v1; o[dt][4 * g4 + 2] = v2; o[dt][4 * g4 + 3] = v3;
                    ss += (v0 * v0 + v1 * v1) + (v2 * v2 + v3 * v3);
                }
            ss = xhalf_sum(ss);
            const float rstd = rsqrtf(ss * (1.f / 128.f) + NORM_EPS) * 0.8f;
            const float* sub = p.in[7];
#pragma unroll
            for (int dt = 0; dt < 4; ++dt)
#pragma unroll
                for (int g4 = 0; g4 < 4; ++g4) {
                    const int d = dt * 32 + 8 * g4 + 4 * h;
                    const f32x4 sg = *(const f32x4*)(sub + d);
                    u32x2 ov; ov.x = pk_bf16(o[dt][4 * g4] * rstd * sg[0], o[dt][4 * g4 + 1] * rstd * sg[1]);
                    ov.y = pk_bf16(o[dt][4 * g4 + 2] * rstd * sg[2], o[dt][4 * g4 + 3] * rstd * sg[3]);
                    *(u32x2*)(O + d) = ov;
                }
        }
    }
}

constexpr int NSA_IMPW = 36864;
constexpr int NSA_SEL = NSA_IMPW + 65536;
constexpr int NSA_UN = NSA_SEL + 512;
constexpr int NSA_FT = NSA_UN + 64;
constexpr int LDS_UNIT = 2 * 73728 + 16;
DI void nsa_unit(const Params& p, int u, unsigned char* lds, int probe = 0) {
    int tid_ = threadIdx.x; asm volatile("" : "+v"(tid_));
    const int lane = tid_ & 63, w = tid_ >> 6, r = lane & 31, h = lane >> 5;
    const int qt = 63 - (u >> 4), bg = u & 15, b = bg >> 1, g = bg & 1;
    const int hq = w >> 2, q0 = qt * 64, qb = q0 + 32 * hq, qpos = qb + r, head = g * 4 + (w & 3);
    float* IMPW = (float*)(lds + NSA_IMPW);
    u64* SEL = (u64*)(lds + NSA_SEL);
    u64* UN = (u64*)(lds + NSA_UN);
    const bf16_t* Qb = (const bf16_t*)(p.ws + OFF_QN) + ((size_t)(b * 8 + head) * 4096) * 64;
    bf16x8 qf[4];
#pragma unroll
    for (int s = 0; s < 4; ++s) qf[s] = *(const bf16x8*)(Qb + (size_t)qpos * 64 + s * 16 + h * 8);
#pragma unroll
    for (int s = 0; s < 4; ++s) asm volatile("" : "+v"(qf[s]));
    const float* gp = (const float*)(p.ws + OFF_GATES) + ((size_t)b * 4096 + qpos) * 24 + head * 3;
    auto inc = [](int j) { return j + 1; };
    f32x16 oacc[2];

    float* FT = (float*)(lds + NSA_FT);
    {
        const bf16_t* Kc = (const bf16_t*)(p.ws + OFF_KCMP) + (size_t)bg * 256 * 64;
        const bf16_t* VcT = (const bf16_t*)(p.ws + OFF_VCMPT) + (size_t)bg * 64 * 256;
        const int nmax = ((q0 + 32) >> 4) + 1, ntc = (nmax + 63) >> 6;
        const int nvalid = qpos >= 31 ? ((qpos - 31) >> 4) + 1 : 0;
        float m = -1e30f, l = 0.f, carry = 0.f;
        f32x16 oc[2];
#pragma unroll
        for (int dt = 0; dt < 2; ++dt)
#pragma unroll
            for (int i = 0; i < 16; ++i) oc[dt][i] = 0.f;
        kv_loop<64, true>(lds, Kc, VcT, 256, ntc, 0, inc, [&](int j, const unsigned char* sb) {
            f32x16 s0, s1; attn_scores(sb, qf, r, h, s0, s1);
            float mx = NEG_INF;
#pragma unroll
            for (int i = 0; i < 16; ++i) {
                const int n = j * 64 + crow(i, h);
                if (n >= nvalid) s0[i] = NEG_INF;
                if (n + 32 >= nvalid) s1[i] = NEG_INF;
                mx = fmaxf(mx, fmaxf(s0[i], s1[i]));
            }
            mx = xhalf_max(mx);
            const float mn = fmaxf(m, mx);
            const float alpha = fast_exp2((m - mn) * SM_C), nb = -mn * SM_C;
            m = mn; l *= alpha; carry *= alpha;
#pragma unroll
            for (int dt = 0; dt < 2; ++dt) oc[dt] = oc[dt] * alpha;
            if (h == 0) FT[(w * 32 + r) * 4 + j] = mn;
            float rs = 0.f;
#pragma unroll
            for (int i = 0; i < 16; ++i) {
                s0[i] = fast_exp2(__builtin_fmaf(s0[i], SM_C, nb)); s1[i] = fast_exp2(__builtin_fmaf(s1[i], SM_C, nb));
                rs += s0[i] + s1[i];
            }
            l += xhalf_sum(rs);
#pragma unroll
            for (int mt = 0; mt < 2; ++mt)
#pragma unroll
                for (int a = 0; a < 4; ++a) {
                    const float x0 = mt ? s1[4 * a] : s0[4 * a], x1 = mt ? s1[4 * a + 1] : s0[4 * a + 1];
                    const float x2 = mt ? s1[4 * a + 2] : s0[4 * a + 2], x3 = mt ? s1[4 * a + 3] : s0[4 * a + 3];
                    float mainv = ((x0 + x1) + x2) + 0.5f * x3;
                    const float cr = 0.5f * x3;
                    const auto sw_ = __builtin_amdgcn_permlane32_swap(__float_as_uint(cr), __float_as_uint(cr), false, false);
                    const float other = __uint_as_float(h ? sw_[0] : sw_[1]);
                    mainv += h ? other : carry;
                    carry = other;
                    IMPW[(w * 32 + r) * 64 + 16 * j + 8 * mt + 2 * a + h] = mainv;
                }
            bf16x8 pf[2][2]; pack_p(s0, s1, pf);
            attn_pv<64>(sb + KT_BYTES, pf, r, h, oc);
        }, probe);
        const float invl = l > 0.f ? 1.f / l : 0.f;
        if (h == 0) {
#pragma unroll
            for (int t = 0; t < 4; ++t)
                if (t < ntc) { const float mt_ = FT[(w * 32 + r) * 4 + t]; FT[(w * 32 + r) * 4 + t] = fast_exp2((mt_ - m) * SM_C) * invl; }
        }
        const float g0 = gp[0] * invl;
#pragma unroll
        for (int dt = 0; dt < 2; ++dt)
#pragma unroll
            for (int i = 0; i < 16; ++i) oacc[dt][i] = g0 * oc[dt][i];
        __syncthreads();
    }
    {
        unsigned uk8[8]; bool val8[8];
        const int j = lane;
#pragma unroll
        for (int qq = 0; qq < 8; ++qq) {
            const int rr = 8 * w + qq, qp = q0 + rr, cur = qp >> 6;
            const bool valid = j <= cur;
            float v = 0.f;
            if (valid) {
                const float* ip = IMPW + ((rr >> 5) * 4 * 32 + (rr & 31)) * 64 + j;
                const float* fp = FT + ((rr >> 5) * 4 * 32 + (rr & 31)) * 4 + (j >> 4);
                v = ((ip[0] * fp[0] + ip[2048] * fp[128]) + ip[4096] * fp[256]) + ip[6144] * fp[384];
            }
            const bool forced = (j == 0) || (j == cur) || (j == cur - 1);
            const float key = forced ? __builtin_inff() : (valid ? v : NEG_INF);
            const unsigned kb_ = __float_as_uint(key);
            uk8[qq] = (kb_ & 0x80000000u) ? ~kb_ : (kb_ | 0x80000000u);
            val8[qq] = valid;
        }
        unsigned thr8[8];
#pragma unroll
        for (int qq = 0; qq < 8; ++qq) thr8[qq] = 0u;
#pragma unroll
        for (int bit = 31; bit >= 0; --bit) {
#pragma unroll
            for (int qq = 0; qq < 8; ++qq) {
                const unsigned cand = thr8[qq] | (1u << bit);
                if (__popcll(__ballot(uk8[qq] >= cand)) >= 16) thr8[qq] = cand;
            }
        }
        u64 un = 0;
#pragma unroll
        for (int qq = 0; qq < 8; ++qq) {
            const unsigned uk = uk8[qq], thr = thr8[qq];
            const u64 gtm = __ballot(uk > thr), eqm = __ballot(uk == thr);
            const int need = 16 - (int)__popcll(gtm);
            const int below = (int)__builtin_amdgcn_mbcnt_hi((unsigned)(eqm >> 32), __builtin_amdgcn_mbcnt_lo((unsigned)eqm, 0u));
            const bool sel = ((uk > thr) || (uk == thr && below < need)) && val8[qq];
            const u64 mask = __ballot(sel);
            if (lane == 0) SEL[8 * w + qq] = mask;
            un |= mask;
        }
        if (lane == 0) UN[w] = un;
        __syncthreads();
    }
    const u64 mysel = SEL[32 * hq + r];
    const u64 U = ((UN[0] | UN[1]) | (UN[2] | UN[3])) | ((UN[4] | UN[5]) | (UN[6] | UN[7]));
    {
        const bf16_t* Ks = (const bf16_t*)(p.ws + OFF_KS) + (size_t)bg * 4096 * 64;
        const bf16_t* VsT = (const bf16_t*)(p.ws + OFF_VST) + (size_t)bg * 64 * 4096;
        const int nts = __popcll(U), j0 = __ffsll((long long)U) - 1;
        f32x16 o[2];
#pragma unroll
        for (int dt = 0; dt < 2; ++dt)
#pragma unroll
            for (int i = 0; i < 16; ++i) o[dt][i] = 0.f;
        float m = -1e30f; f32x16 lv;
#pragma unroll
        for (int i = 0; i < 16; ++i) lv[i] = 0.f;
        kv_loop<64, true>(lds, Ks, VsT, 4096, nts, j0, [U](int j) { return __ffsll((long long)(U & (~0ull << (j + 1)))) - 1; }, [&](int j, const unsigned char* sb) {
            const bool mine = (mysel >> j) & 1ull;
            if (__ballot(mine) != 0ull) {
                f32x16 s0, s1; attn_scores(sb, qf, r, h, s0, s1);
                if (j == (qb >> 6)) {
                    const int lim = mine ? (qpos - 64 * j) : -1;
#pragma unroll
                    for (int i = 0; i < 16; ++i) {
                        const int kl = crow(i, h);
                        if (kl > lim) s0[i] = NEG_INF;
                        if (kl + 32 > lim) s1[i] = NEG_INF;
                    }
                    attn_softmax_pv<64>(s0, s1, m, lv, o, sb + KT_BYTES, r, h);
                } else {
                    attn_softmax_pv<64>(s0, s1, m, lv, o, sb + KT_BYTES, r, h, mine);
                }
            }
        }, probe);
        const float l = xhalf_sum(hsum16(lv));
        const float sc = l > 0.f ? gp[1] / l : 0.f;
#pragma unroll
        for (int dt = 0; dt < 2; ++dt)
#pragma unroll
            for (int i = 0; i < 16; ++i) oacc[dt][i] += sc * o[dt][i];
    }
    {
        const bf16_t* Kw = (const bf16_t*)(p.ws + OFF_KW) + (size_t)bg * 4096 * 64;
        const bf16_t* VwT = (const bf16_t*)(p.ws + OFF_VWT) + (size_t)bg * 64 * 4096;
        const int tlo = (q0 > 511 ? q0 - 511 : 0) >> 6, thi = (q0 + 63) >> 6;
        f32x16 o[2];
#pragma unroll
        for (int dt = 0; dt < 2; ++dt)
#pragma unroll
            for (int i = 0; i < 16; ++i) o[dt][i] = 0.f;
        float m = -1e30f; f32x16 lv;
#pragma unroll
        for (int i = 0; i < 16; ++i) lv[i] = 0.f;
        kv_loop<64, true>(lds, Kw, VwT, 4096, thi - tlo + 1, tlo, inc, [&](int j, const unsigned char* sb) {
            const int k0 = j * 64;
            if (k0 > qb + 31 || k0 + 63 <= qb - 512) return;
            f32x16 s0, s1; attn_scores(sb, qf, r, h, s0, s1);
            if (!(k0 + 63 <= qb && k0 > qb + 31 - 512)) {
#pragma unroll
                for (int i = 0; i < 16; ++i) {
                    const int ka = k0 + crow(i, h), kb2 = ka + 32;
                    if (!(ka <= qpos && ka > qpos - 512)) s0[i] = NEG_INF;
                    if (!(kb2 <= qpos && kb2 > qpos - 512)) s1[i] = NEG_INF;
                }
            }
            attn_softmax_pv<64>(s0, s1, m, lv, o, sb + KT_BYTES, r, h);
        }, probe);
        const float l = xhalf_sum(hsum16(lv));
        const float sc = l > 0.f ? gp[2] / l : 0.f;
#pragma unroll
        for (int dt = 0; dt < 2; ++dt)
#pragma unroll
            for (int i = 0; i < 16; ++i) oacc[dt][i] += sc * o[dt][i];
    }
    if (probe) {
        float chk = 0.f;
#pragma unroll
        for (int dt = 0; dt < 2; ++dt)
#pragma unroll
            for (int i = 0; i < 16; ++i) chk += oacc[dt][i];
        if (chk == 1.2345e-30f) ((float*)(p.ws + OFF_CTL))[33] = chk;
        return;
    }
    bf16_t* O = (bf16_t*)(p.ws + OFF_O) + ((size_t)b * 4096 + qpos) * 1024 + 512 + head * 64;
#pragma unroll
    for (int dt = 0; dt < 2; ++dt)
#pragma unroll
        for (int g4 = 0; g4 < 4; ++g4) {
            u32x2 ov; ov.x = pk_bf16(oacc[dt][4 * g4], oacc[dt][4 * g4 + 1]); ov.y = pk_bf16(oacc[dt][4 * g4 + 2], oacc[dt][4 * g4 + 3]);
            *(u32x2*)(O + dt * 32 + 8 * g4 + 4 * h) = ov;
        }
}
DI void phase4(const Params& p, unsigned char* lds, int rep = 0, int probe = 0, int which = 3) {
    unsigned* counter = (unsigned*)(p.ws + OFF_CTL) + 2 * rep;
    volatile int* su = (volatile int*)(lds + LDS_UNIT);
    if (which & 1) for (;;) {
        if (threadIdx.x == 0) *su = (int)atomicAdd(counter, 1u);
        __syncthreads();
        const int u = *su;
        __syncthreads();
        if (u >= 512) break;
        diff_unit(p, u, lds, probe);
    }
    if (which & 2) for (;;) {
        if (threadIdx.x == 0) *su = (int)atomicAdd(counter + 1, 1u);
        __syncthreads();
        const int u = *su;
        __syncthreads();
        if (u >= 1024) break;
        nsa_unit(p, u, lds, probe);
    }
}
DI void phase5(const Params& p, unsigned char* lds) {
    pg8::Gemm g; g.A = (const bf16_t*)(p.ws + OFF_O); g.Bt = (const bf16_t*)(p.ws + OFF_WOUTT); g.M = T; g.N = 1024; g.K = 1024;
    pg8::StaticOrder S; S.init(T, 1024, (int)gridDim.x, (int)blockIdx.x);
    pg8::EpiPlain E; E.O = (bf16_t*)(p.ws + OFF_MIX); E.ldc = 1024;
    pg8::gemm_phase<pg8::EpiPlain, pg8::StaticOrder, true, true>((PG8_LAS unsigned char*)lds, g, S, E);
    __syncthreads();
}
DI void phase6(const Params& p) {
    const int lane = VTID & 63, w = VTID >> 6;
    const float* x = p.in[0]; const float* gpost = p.in[15]; const float* gffn = p.in[16];
    const bf16_t* MIX = (const bf16_t*)(p.ws + OFF_MIX);
    bf16_t* H = (bf16_t*)(p.ws + OFF_H);
    float* RSTD = (float*)(p.ws + OFF_GATES);
    for (int row = VBLK * 4 + w; row < T; row += VGRID * 4) {
        f32x4 mv[4], xv[4]; float ss = 0.f;
#pragma unroll
        for (int i = 0; i < 4; ++i) {
            const u32x2 u = *(const u32x2*)(MIX + (size_t)row * 1024 + i * 256 + lane * 4);
            mv[i][0] = bflo(u.x); mv[i][1] = bfhi(u.x); mv[i][2] = bflo(u.y); mv[i][3] = bfhi(u.y);
            xv[i] = *(const f32x4*)(x + (size_t)row * 1024 + i * 256 + lane * 4);
            ss += mv[i][0] * mv[i][0] + mv[i][1] * mv[i][1] + mv[i][2] * mv[i][2] + mv[i][3] * mv[i][3];
        }
        ss = wave_sum(ss);
        const float rstd = rsqrtf(ss * (1.f / 1024.f) + NORM_EPS);
        if (lane == 0) RSTD[row] = rstd;
        float ss2 = 0.f;
#pragma unroll
        for (int i = 0; i < 4; ++i) {
            const f32x4 gg = *(const f32x4*)(gpost + i * 256 + lane * 4);
#pragma unroll
            for (int e = 0; e < 4; ++e) { xv[i][e] += mv[i][e] * rstd * gg[e]; ss2 += xv[i][e] * xv[i][e]; }
        }
        ss2 = wave_sum(ss2);
        const float rstd2 = rsqrtf(ss2 * (1.f / 1024.f) + NORM_EPS);
#pragma unroll
        for (int i = 0; i < 4; ++i) {
            const f32x4 gg = *(const f32x4*)(gffn + i * 256 + lane * 4);
            u32x2 o; o.x = pk_bf16(xv[i][0] * rstd2 * gg[0], xv[i][1] * rstd2 * gg[1]); o.y = pk_bf16(xv[i][2] * rstd2 * gg[2], xv[i][3] * rstd2 * gg[3]);
            *(u32x2*)(H + (size_t)row * 1024 + i * 256 + lane * 4) = o;
        }
    }
}
DI void phase7(const Params& p, unsigned char* lds, int probe = 0) {
    pg8::Gemm g; g.A = (const bf16_t*)(p.ws + OFF_H); g.Bt = (const bf16_t*)(p.ws + OFF_WGUT); g.M = T; g.N = 2 * DFF; g.K = 1024;
    pg8::StaticOrder S; S.init(T, 2 * DFF, (int)gridDim.x, (int)blockIdx.x);
    pg8::EpiSwiGLU E; E.ACT = (bf16_t*)(p.ws + OFF_ACT); E.ldc = DFF;
    pg8::gemm_phase<pg8::EpiSwiGLU, pg8::StaticOrder, true, true>((PG8_LAS unsigned char*)lds, g, S, E);
    __syncthreads();
}
DI void phase8(const Params& p, unsigned char* lds) {
    pg8::Gemm g; g.A = (const bf16_t*)(p.ws + OFF_ACT); g.Bt = (const bf16_t*)(p.ws + OFF_WDT); g.M = T; g.N = 1024; g.K = DFF;
    pg8::StaticOrder S; S.init(T, 1024, (int)gridDim.x, (int)blockIdx.x);
    pg8::EpiPlain E; E.O = (bf16_t*)(p.ws + OFF_O); E.ldc = 1024;
    pg8::gemm_phase<pg8::EpiPlain, pg8::StaticOrder, true, true>((PG8_LAS unsigned char*)lds, g, S, E);
    __syncthreads();
}
DI void phase9(const Params& p) {
    const int lane = VTID & 63, w = VTID >> 6;
    const float* x = p.in[0]; const float* g1 = p.in[15]; const float* g2 = p.in[20];
    const bf16_t* MIX = (const bf16_t*)(p.ws + OFF_MIX);
    const bf16_t* F = (const bf16_t*)(p.ws + OFF_O);
    const float* RSTD = (const float*)(p.ws + OFF_GATES);
    for (int row = VBLK * 4 + w; row < T; row += VGRID * 4) {
        f32x4 fv[4], mv[4]; float ss = 0.f;
#pragma unroll
        for (int i = 0; i < 4; ++i) {
            const u32x2 u = *(const u32x2*)(F + (size_t)row * 1024 + i * 256 + lane * 4);
            fv[i][0] = bflo(u.x); fv[i][1] = bfhi(u.x); fv[i][2] = bflo(u.y); fv[i][3] = bfhi(u.y);
            const u32x2 um = *(const u32x2*)(MIX + (size_t)row * 1024 + i * 256 + lane * 4);
            mv[i][0] = bflo(um.x); mv[i][1] = bfhi(um.x); mv[i][2] = bflo(um.y); mv[i][3] = bfhi(um.y);
            ss += fv[i][0] * fv[i][0] + fv[i][1] * fv[i][1] + fv[i][2] * fv[i][2] + fv[i][3] * fv[i][3];
        }
        ss = wave_sum(ss);
        const float rstd = rsqrtf(ss * (1.f / 1024.f) + NORM_EPS);
        const float rstd1 = RSTD[row];
#pragma unroll
        for (int i = 0; i < 4; ++i) {
            const f32x4 ga = *(const f32x4*)(g1 + i * 256 + lane * 4);
            const f32x4 gb = *(const f32x4*)(g2 + i * 256 + lane * 4);
            f32x4 xv = *(const f32x4*)(x + (size_t)row * 1024 + i * 256 + lane * 4);
#pragma unroll
            for (int e = 0; e < 4; ++e) { xv[e] += mv[i][e] * rstd1 * ga[e]; xv[e] += fv[i][e] * rstd * gb[e]; }
            *(f32x4*)(p.out + (size_t)row * 1024 + i * 256 + lane * 4) = xv;
        }
    }
}

__global__ void __launch_bounds__(512, 2) mega(Params p) {
    extern __shared__ __attribute__((aligned(16))) unsigned char lds[];
    cg::grid_group grid = cg::this_grid();
    const bool fused = (p.ph_hi - p.ph_lo) > 1;
    XcdBarrier xb; xb.bar = (unsigned*)(p.ws + OFF_XB); xb.x = 0; xb.st = (volatile LAS unsigned*)(lds + LDS_XB);
    if (fused) {
        if (threadIdx.x == 0) { xb.st[0] = 0u; xb.st[1] = 0u; }
        __syncthreads();
        xb = xcd_barrier_post((unsigned*)(p.ws + OFF_XB), (volatile LAS unsigned*)(lds + LDS_XB));
    }
    if (p.ph_hi > 1000) grid.sync();
#ifndef ONLY_PH
#define ONLY_PH -1
#endif
#define PH_ON(n) (ONLY_PH < 0 || ONLY_PH == (n))
#define RUN_PHASE(n, call) if (p.ph_lo <= (n) && (n) < p.ph_hi) { if (PH_ON(n)) { call; } if ((n) + 1 < p.ph_hi) { xcd_barrier(xb); if (PROBE_MODE == 1) xcd_barrier(xb); } }
    RUN_PHASE(0, phase0(p, lds))
    RUN_PHASE(1, phase1(p, lds))
    RUN_PHASE(2, phase2(p, lds))
    RUN_PHASE(3, phase3(p, lds))
    RUN_PHASE(4, phase4(p, lds))
#if PROBE_MODE == 2
    RUN_PHASE(4, phase4(p, lds, 1))
#endif
#if PROBE_MODE == 8
    RUN_PHASE(4, phase4(p, lds, 1, 0, 1))
#endif
#if PROBE_MODE == 9
    RUN_PHASE(4, phase4(p, lds, 1, 0, 2))
#endif
#if PROBE_MODE == 6
    RUN_PHASE(4, phase4(p, lds, 1, 1))
#endif
#if PROBE_MODE == 7
    RUN_PHASE(4, phase4(p, lds, 1, 2))
#endif
    RUN_PHASE(5, phase5(p, lds))
    RUN_PHASE(6, phase6(p))
    RUN_PHASE(7, phase7(p, lds))
#if PROBE_MODE == 3
    RUN_PHASE(7, phase7(p, lds))
#endif
#if PROBE_MODE == 4
    RUN_PHASE(7, phase7(p, lds, 1))
#endif
#if PROBE_MODE == 5
    RUN_PHASE(7, phase7(p, lds, 2))
#endif
    RUN_PHASE(8, phase8(p, lds))
    RUN_PHASE(9, phase9(p))
}

extern "C" void kernel_launch(void* const* d_in, const int* in_sizes, int n_in, void* d_out, int out_size, void* d_ws, size_t ws_size, hipStream_t stream) {
    static int grid_blocks = 0;
    if (grid_blocks == 0) {
        if (n_in != 21 || ws_size < WS_END) { fprintf(stderr, "kernel_launch: unexpected n_in %d / ws %zu (need %zu)\n", n_in, ws_size, (size_t)WS_END); grid_blocks = -1; return; }
        int dev = 0, cus = 0, per_cu = 0;
        hipGetDevice(&dev);
        hipDeviceGetAttribute(&cus, hipDeviceAttributeMultiprocessorCount, dev);
        if (hipFuncSetAttribute((const void*)mega, hipFuncAttributeMaxDynamicSharedMemorySize, LDS_BYTES) != hipSuccess) { fprintf(stderr, "kernel_launch: hipFuncSetAttribute failed\n"); grid_blocks = -1; return; }
        hipOccupancyMaxActiveBlocksPerMultiprocessor(&per_cu, (const void*)mega, 512, LDS_BYTES);
        if (per_cu < 1) per_cu = 1;
        if (per_cu > 1) per_cu = 1;
        grid_blocks = cus * per_cu;
        if (grid_blocks > 256) grid_blocks = 256;
    }
    if (grid_blocks < 0) return;
    Params p{};
    for (int i = 0; i < 21; ++i) p.in[i] = (const float*)d_in[i];
    p.out = (float*)d_out; p.ws = (unsigned char*)d_ws;
#if MULTI_LAUNCH
    for (int ph = 0; ph < NPH; ++ph) {
        p.ph_lo = ph; p.ph_hi = ph + 1;
        hipLaunchKernelGGL(mega, dim3(grid_blocks), dim3(512), LDS_BYTES, stream, p);
    }
#else
    p.ph_lo = 0; p.ph_hi = NPH;
    if (hipMemsetAsync((unsigned char*)d_ws + OFF_XB, 0, XCD_BAR_WORDS * 4, stream) != hipSuccess) { fprintf(stderr, "kernel_launch: memset of barrier words failed\n"); return; }
    void* args[] = {&p};
    hipError_t e = hipLaunchCooperativeKernel((const void*)mega, dim3(grid_blocks), dim3(512), args, LDS_BYTES, stream);
    if (e != hipSuccess) fprintf(stderr, "cooperative launch failed: %s (grid %d)\n", hipGetErrorString(e), grid_blocks);
#endif
}
```
